# Optimizing an MI355X kernel written in HIP

```python
import math
import jax, jax.numpy as jnp
from jax import lax
import numpy as np

D_MODEL = 2048
BATCH = 4
SEQ = 8192
DEPTH = 4

CHUNK = 64
N_META = 16
Q_BLOCK = 128
HA = 4
A_NOPE = 128
A_ROPE = 64
A_V = 128
Q_LORA = 512
KV_LORA = 256
ROPE_THETA = 10000.0
HB = 4
B_DH = 128
HC = 8
C_DH = 128
IDX_H = 8
IDX_DH = 64
TOPK_MAX = 256
N_BUCKETS = 32
MAX_DIST = 128
N_EXPERTS = 32
TOP_K = 4
D_FF = 512
SWIGLU_LIMIT = 7.0
SWIGLU_ALPHA = 1.702
MOE_BLOCK = 256
N_EVEN = (DEPTH + 1) // 2
N_ODD = DEPTH // 2
DN_ALPHA = (2 * DEPTH) ** 0.25
DN_BETA = (8 * DEPTH) ** -0.25
LN_EPS = 1e-5
RMS_EPS = 1e-6
NEG_INF = -1e30
EV_SPLITS = (Q_LORA, KV_LORA, A_ROPE, HB * B_DH, HB * B_DH, HB * B_DH)
EV_IN = sum(EV_SPLITS)
OD_SPLITS = (HC * C_DH, C_DH, C_DH, IDX_H * IDX_DH, IDX_DH, IDX_H)
OD_IN = sum(OD_SPLITS)
EV_OUT = HA * A_V + HB * B_DH
OD_OUT = HC * C_DH

kernel_name = "hybrid_mla_stickbreak_dsa_moe_trunk"


def layer_norm(x, g, b):
    xf = x.astype(jnp.float32)
    mu = jnp.mean(xf, axis=-1, keepdims=True)
    var = jnp.mean(jnp.square(xf - mu), axis=-1, keepdims=True)
    return ((xf - mu) * lax.rsqrt(var + LN_EPS) * g + b).astype(x.dtype)


def rms_norm(x, g):
    xf = x.astype(jnp.float32)
    return (xf * lax.rsqrt(jnp.mean(xf * xf, axis=-1, keepdims=True) + RMS_EPS) * g).astype(x.dtype)


def split_cols(h, sizes):
    return jnp.split(h, np.cumsum(sizes)[:-1].tolist(), axis=-1)


def chunk_ids(n):
    t = np.arange(n)
    return np.where(t < N_META, 0, (t - N_META) // CHUNK + 1)


def rope(x, pos):
    half = x.shape[-1] // 2
    inv = ROPE_THETA ** (-jnp.arange(half, dtype=jnp.float32) / half)
    ang = pos.astype(jnp.float32)[:, None] * inv[None, :]
    cos = jnp.cos(ang)[None, :, None, :]
    sin = jnp.sin(ang)[None, :, None, :]
    x1, x2 = x[..., :half], x[..., half:]
    return jnp.concatenate([x1 * cos - x2 * sin, x1 * sin + x2 * cos], axis=-1).astype(x.dtype)


def t5_bucket(rel):
    half = N_BUCKETS // 2
    max_exact = half // 2
    base = jnp.where(rel > 0, half, 0)
    n = jnp.abs(rel)
    nf = jnp.maximum(n, 1).astype(jnp.float32)
    large = max_exact + (jnp.log(nf / max_exact) / math.log(MAX_DIST / max_exact)
                         * (half - max_exact)).astype(jnp.int32)
    large = jnp.minimum(large, half - 1)
    return base + jnp.where(n < max_exact, n, large)


def sweep_query_blocks(fn, n, extend):
    outs = []
    for b in range(n // Q_BLOCK):
        start = b * Q_BLOCK
        outs.append(fn(start, min(n, start + Q_BLOCK + extend)))
    return jnp.concatenate(outs, axis=1)


def mla_attention(q, k, v, cid):
    n = q.shape[1]
    scale = (A_NOPE + A_ROPE) ** -0.5

    def block(start, kend):
        qb = q[:, start:start + Q_BLOCK]
        s = jnp.einsum('bqhd,bkhd->bhqk', qb, k[:, :kend]).astype(jnp.float32) * scale
        mask = cid[None, :kend] <= cid[start:start + Q_BLOCK, None]
        p = jax.nn.softmax(jnp.where(mask, s, NEG_INF), axis=-1)
        return jnp.einsum('bhqk,bkhd->bqhd', p.astype(v.dtype), v[:, :kend])

    return sweep_query_blocks(block, n, CHUNK)


def stick_breaking_attention(q, k, v):
    n = q.shape[1]
    scale = B_DH ** -0.5

    def block(start, kend):
        qb = q[:, start:start + Q_BLOCK]
        z = jnp.einsum('bqhd,bkhd->bhqk', qb, k[:, :kend]).astype(jnp.float32) * scale
        mask = np.arange(kend)[None, :] < (start + np.arange(Q_BLOCK))[:, None]
        log_keep = jnp.where(mask, jax.nn.log_sigmoid(-z), 0.0)
        cum = lax.cumsum(log_keep, axis=3, reverse=True)
        a = jnp.where(mask, jnp.exp(z + cum), 0.0)
        return jnp.einsum('bhqk,bkhd->bqhd', a.astype(v.dtype), v[:, :kend])

    return sweep_query_blocks(block, n, 0)


def indexer_sparse_attention(q, k, v, q_idx, k_idx, w_idx, cid, rel_table, k_sel):
    n = q.shape[1]
    cid_j = jnp.asarray(cid)

    def block(start, kend):
        qb = q[:, start:start + Q_BLOCK]
        qib = q_idx[:, start:start + Q_BLOCK]
        wb = w_idx[:, start:start + Q_BLOCK]
        cq = cid[start:start + Q_BLOCK]
        pq = start + np.arange(Q_BLOCK)
        rel_s = jax.nn.relu(jnp.einsum('bqhd,bkd->bqhk', qib, k_idx[:, :kend]).astype(jnp.float32)
                            * IDX_DH ** -0.5)
        score = jnp.einsum('bqh,bqhk->bqk', wb.astype(jnp.float32) * IDX_H ** -0.5, rel_s)
        admissible = cid[None, :kend] <= cq[:, None]
        score = jnp.where(admissible[None], score, NEG_INF)
        _, sel = lax.top_k(score, min(k_sel, kend))
        valid = cid_j[sel] <= cq[None, :, None]
        kg = jax.vmap(lambda kk, ii: kk[ii])(k, sel)
        vg = jax.vmap(lambda vv, ii: vv[ii])(v, sel)
        s = jnp.einsum('bqhd,bqkd->bqhk', qb, kg).astype(jnp.float32) * C_DH ** -0.5
        bias = rel_table[t5_bucket(sel - pq[None, :, None])].astype(jnp.float32)
        s = jnp.where(valid[:, :, None, :], s + jnp.swapaxes(bias, 2, 3), NEG_INF)
        p = jax.nn.softmax(s, axis=-1)
        return jnp.einsum('bqhk,bqkd->bqhd', p.astype(vg.dtype), vg)

    return sweep_query_blocks(block, n, CHUNK)


def even_mixer(h, pos, cid, w_in, q_norm, kv_norm, w_uq, w_ukv, w_out):
    bsz, n, _ = h.shape
    q_lat, kv_lat, k_rope, sb_q, sb_k, sb_v = split_cols(h @ w_in, EV_SPLITS)
    qa = (rms_norm(q_lat, q_norm) @ w_uq).reshape(bsz, n, HA, A_NOPE + A_ROPE)
    kva = (rms_norm(kv_lat, kv_norm) @ w_ukv).reshape(bsz, n, HA, A_NOPE + A_V)
    k_nope, v_a = kva[..., :A_NOPE], kva[..., A_NOPE:]
    k_r = jnp.broadcast_to(rope(k_rope[:, :, None, :], pos), (bsz, n, HA, A_ROPE))
    qa = jnp.concatenate([qa[..., :A_NOPE], rope(qa[..., A_NOPE:], pos)], axis=-1)
    ka = jnp.concatenate([k_nope, k_r], axis=-1)
    out_a = mla_attention(qa, ka, v_a, cid)
    shp = (bsz, n, HB, B_DH)
    out_b = stick_breaking_attention(sb_q.reshape(shp), sb_k.reshape(shp), sb_v.reshape(shp))
    merged = jnp.concatenate([out_a.reshape(bsz, n, HA * A_V), out_b.reshape(bsz, n, HB * B_DH)], axis=-1)
    return merged @ w_out


def odd_mixer(h, cid, w_in, w_out, rel_table, k_sel):
    bsz, n, _ = h.shape
    c_q, c_k, c_v, i_q, i_k, i_w = split_cols(h @ w_in, OD_SPLITS)
    out = indexer_sparse_attention(
        c_q.reshape(bsz, n, HC, C_DH), c_k, c_v,
        i_q.reshape(bsz, n, IDX_H, IDX_DH), i_k, i_w, cid, rel_table, k_sel)
    return out.reshape(bsz, n, HC * C_DH) @ w_out


def moe(h, router_w, router_b, w_in, b_in, w_out, b_out):
    bsz, n, d = h.shape
    n_tok = bsz * n
    t = h.reshape(n_tok, d)
    logits = (t @ router_w).astype(jnp.float32) + router_b
    top_val, top_idx = lax.top_k(logits, TOP_K)
    gates = jax.nn.softmax(top_val, axis=-1)
    n_assign = n_tok * TOP_K
    e_flat = top_idx.reshape(-1)
    order = jnp.argsort(e_flat)
    e_sorted = e_flat[order]
    counts = jnp.zeros((N_EXPERTS,), jnp.int32).at[e_flat].add(1)
    padded = (counts + MOE_BLOCK - 1) // MOE_BLOCK * MOE_BLOCK
    padded_end = jnp.cumsum(padded)
    start_sorted = jnp.cumsum(counts) - counts
    start_padded = padded_end - padded
    dest_sorted = start_padded[e_sorted] + jnp.arange(n_assign) - start_sorted[e_sorted]
    n_blocks = -(-n_assign // MOE_BLOCK) + N_EXPERTS
    row_tok = jnp.full((n_blocks * MOE_BLOCK,), n_tok, jnp.int32).at[dest_sorted].set(
        (order // TOP_K).astype(jnp.int32))
    block_e = jnp.minimum(jnp.searchsorted(padded_end, jnp.arange(n_blocks) * MOE_BLOCK, side='right'),
                          N_EXPERTS - 1)
    t_pad = jnp.concatenate([t, jnp.zeros((1, d), t.dtype)], axis=0)

    def run(args):
        rows, e = args
        hh = t_pad[rows] @ w_in[e] + b_in[e]
        gate, up = jnp.split(hh, 2, axis=-1)
        gate = jnp.minimum(gate, SWIGLU_LIMIT)
        up = jnp.clip(up, -SWIGLU_LIMIT, SWIGLU_LIMIT)
        return (gate * jax.nn.sigmoid(SWIGLU_ALPHA * gate) * (up + 1.0)) @ w_out[e] + b_out[e]

    y_rows = lax.map(run, (row_tok.reshape(n_blocks, MOE_BLOCK), block_e)).reshape(n_blocks * MOE_BLOCK, d)
    dest = jnp.zeros((n_assign,), jnp.int32).at[order].set(dest_sorted.astype(jnp.int32))
    y = y_rows[dest].reshape(n_tok, TOP_K, d)
    out = jnp.einsum('tk,tkd->td', gates.astype(y.dtype), y)
    return out.reshape(bsz, n, d)


def setup_inputs(seed: int = 0) -> dict:
    key = jax.random.key(seed)
    ks = jax.random.split(key, 20)
    f32 = jnp.float32
    D = D_MODEL

    def nrm(k, shape, scale):
        return jax.random.normal(k, shape, f32) * scale

    ev_col_scale = jnp.concatenate([jnp.ones((EV_IN - HB * B_DH,), f32), jnp.full((HB * B_DH,), DN_BETA, f32)])
    od_col_scale = jnp.concatenate([jnp.ones((HC * C_DH + C_DH,), f32),
                                    jnp.full((C_DH,), DN_BETA, f32),
                                    jnp.ones((OD_IN - HC * C_DH - 2 * C_DH,), f32)])
    ukv_col_scale = jnp.tile(jnp.concatenate([jnp.ones((A_NOPE,), f32), jnp.full((A_V,), DN_BETA, f32)]), HA)
    return {
        "x": nrm(ks[0], (BATCH, SEQ, D), 1.0),
        "meta_tokens": nrm(ks[1], (N_META, D), 1.0),
        "rel_bias_table": nrm(ks[2], (N_BUCKETS, HC), 0.2),
        "ev_w_in": nrm(ks[3], (N_EVEN, D, EV_IN), D ** -0.5) * ev_col_scale,
        "mla_q_norm": 1.0 + nrm(ks[4], (N_EVEN, Q_LORA), 0.02),
        "mla_kv_norm": 1.0 + nrm(ks[5], (N_EVEN, KV_LORA), 0.02),
        "mla_w_uq": nrm(ks[6], (N_EVEN, Q_LORA, HA * (A_NOPE + A_ROPE)), Q_LORA ** -0.5),
        "mla_w_ukv": nrm(ks[7], (N_EVEN, KV_LORA, HA * (A_NOPE + A_V)), KV_LORA ** -0.5) * ukv_col_scale,
        "ev_w_out": nrm(ks[8], (N_EVEN, EV_OUT, D), EV_OUT ** -0.5 * DN_BETA),
        "od_w_in": nrm(ks[9], (N_ODD, D, OD_IN), D ** -0.5) * od_col_scale,
        "od_w_out": nrm(ks[10], (N_ODD, OD_OUT, D), OD_OUT ** -0.5 * DN_BETA),
        "ln_g": 1.0 + nrm(ks[11], (DEPTH, 2, D), 0.02),
        "ln_b": nrm(ks[12], (DEPTH, 2, D), 0.02),
        "router_w": nrm(ks[13], (DEPTH, D, N_EXPERTS), D ** -0.5),
        "router_b": nrm(ks[14], (DEPTH, N_EXPERTS), 0.01),
        "exp_w_in": nrm(ks[15], (DEPTH, N_EXPERTS, D, 2 * D_FF), D ** -0.5),
        "exp_b_in": nrm(ks[16], (DEPTH, N_EXPERTS, 2 * D_FF), 0.01),
        "exp_w_out": nrm(ks[17], (DEPTH, N_EXPERTS, D_FF, D), D_FF ** -0.5 * DN_BETA),
        "exp_b_out": nrm(ks[18], (DEPTH, N_EXPERTS, D), 0.01),
    }


def reference(x, meta_tokens, rel_bias_table, ev_w_in, mla_q_norm, mla_kv_norm, mla_w_uq, mla_w_ukv,
              ev_w_out, od_w_in, od_w_out, ln_g, ln_b, router_w, router_b, exp_w_in, exp_b_in,
              exp_w_out, exp_b_out):
    bsz, seq, d = x.shape
    n_tot = seq + N_META
    n = -(-n_tot // Q_BLOCK) * Q_BLOCK
    h = jnp.concatenate([
        jnp.broadcast_to(meta_tokens[None].astype(x.dtype), (bsz, N_META, d)),
        x,
        jnp.zeros((bsz, n - n_tot, d), x.dtype)], axis=1)
    pos = jnp.arange(n)
    cid = chunk_ids(n)
    k_sel = min(TOPK_MAX, seq // 4)
    for i in range(DEPTH):
        j = i // 2
        if i % 2 == 0:
            m = even_mixer(h, pos, cid, ev_w_in[j], mla_q_norm[j], mla_kv_norm[j],
                           mla_w_uq[j], mla_w_ukv[j], ev_w_out[j])
        else:
            m = odd_mixer(h, cid, od_w_in[j], od_w_out[j], rel_bias_table, k_sel)
        h = layer_norm(DN_ALPHA * h + m, ln_g[i, 0], ln_b[i, 0])
        f = moe(h, router_w[i], router_b[i], exp_w_in[i], exp_b_in[i], exp_w_out[i], exp_b_out[i])
        h = layer_norm(DN_ALPHA * h + f, ln_g[i, 1], ln_b[i, 1])
    return h[:, N_META:N_META + seq]
```

```cpp
#include <hip/hip_runtime.h>
#include <cstdio>
#include <cstdint>

#define LAS __attribute__((address_space(3)))
typedef unsigned short bf16_t;
typedef short bf16x8 __attribute__((ext_vector_type(8)));
typedef short s16x4 __attribute__((ext_vector_type(4)));
typedef float f32x2 __attribute__((ext_vector_type(2)));
typedef float f32x4 __attribute__((ext_vector_type(4)));
typedef float f32x16 __attribute__((ext_vector_type(16)));
typedef unsigned u32x2 __attribute__((ext_vector_type(2)));
typedef unsigned u32x4 __attribute__((ext_vector_type(4)));
typedef int i32x4 __attribute__((ext_vector_type(4)));

constexpr int BATCH = 4, NTOK = 8320, MROWS = BATCH * NTOK, DM = 2048, SEQ = 8192, NMETA = 16, DEPTH = 4;
constexpr int NEXP = 32, DFF = 512;
constexpr float DN_ALPHA = 1.6817928305074290f;
constexpr float LN_EPS = 1e-5f, RMS_EPS = 1e-6f;
constexpr int EVP = 2560;
constexpr int ODP = 2048;
constexpr int MAXSLOT = MROWS * 4 + NEXP * 256;
constexpr int EC_QLAT = 0, EC_KVLAT = 512, EC_SBQ = 768, EC_SBK = 1280, EC_SBV = 1792, EC_KROPE = 2304;
constexpr int OC_Q = 0, OC_K = 1024, OC_V = 1152, OC_IQ = 1280, OC_IK = 1792, OC_IW = 1856;

constexpr size_t MiB = 1u << 20;
constexpr size_t alignup(size_t x) { return (x + 4095) & ~(size_t)4095; }
constexpr size_t WS_CTL = 0, CTL_BYTES = 1 * MiB;
constexpr size_t SZ_WINE = (size_t)EVP * DM * 2, SZ_WUQ = 768 * 512 * 2, SZ_WUKV = 1024 * 256 * 2, SZ_WOUT = (size_t)DM * 1024 * 2, SZ_WINO = (size_t)ODP * DM * 2;
constexpr size_t SZ_WEI = (size_t)1024 * DM, SZ_WEO = (size_t)DM * DFF  , SZ_WR = (size_t)32 * DM * 2;
constexpr size_t WS_WINE = WS_CTL + CTL_BYTES;
constexpr size_t WS_WUQ = WS_WINE + 2 * SZ_WINE;
constexpr size_t WS_WUKV = WS_WUQ + 2 * SZ_WUQ;
constexpr size_t WS_WOUTE = WS_WUKV + 2 * SZ_WUKV;
constexpr size_t WS_WINO = WS_WOUTE + 2 * SZ_WOUT;
constexpr size_t WS_WOUTO = WS_WINO + 2 * SZ_WINO;
constexpr size_t WS_WEI = WS_WOUTO + 2 * SZ_WOUT;
constexpr size_t WS_WEO = WS_WEI + (size_t)DEPTH * NEXP * SZ_WEI;
constexpr size_t WS_WRH = WS_WEO + (size_t)DEPTH * NEXP * SZ_WEO;
constexpr size_t WS_WRL = WS_WRH + DEPTH * SZ_WR;
constexpr size_t WS_ROPE = WS_WRL + DEPTH * SZ_WR;
constexpr size_t WS_H = alignup(WS_ROPE + (size_t)NTOK * 64 * 4);
constexpr size_t WS_HB8 = WS_H;
constexpr size_t WS_HB = WS_H + (size_t)MROWS * DM * 4;
constexpr size_t WS_Y = WS_HB + (size_t)MROWS * DM * 2;
constexpr size_t WS_STAT = WS_Y + (size_t)MROWS * DM * 4;
constexpr size_t WS_P = WS_STAT + (size_t)MROWS * 64 * 4;
constexpr size_t WS_QN = WS_P + (size_t)MROWS * EVP * 2;
constexpr size_t WS_KVN = WS_QN + (size_t)MROWS * 512 * 2;
constexpr size_t WS_QM = WS_KVN + (size_t)MROWS * 256 * 2;
constexpr size_t WS_KN = WS_QM + (size_t)MROWS * 768 * 2;
constexpr size_t WS_VM = WS_KN + (size_t)MROWS * 512 * 2;
constexpr size_t WS_KR = WS_VM + (size_t)MROWS * 512 * 2;
constexpr size_t WS_OM = WS_KR + (size_t)MROWS * 64 * 2;
constexpr size_t WS_TOPE = WS_OM + (size_t)MROWS * 1024 * 2;
constexpr size_t WS_TOPP = WS_TOPE + (size_t)MROWS * 16;
constexpr size_t WS_TOPG = WS_TOPP + (size_t)MROWS * 16;
constexpr size_t WS_ROWTOK = WS_TOPG + (size_t)MROWS * 16;
constexpr size_t WS_BIG = alignup(WS_ROWTOK + (size_t)NEXP * MROWS * 4);
constexpr size_t SZ_SCORES = (size_t)BATCH * NTOK * NTOK * 4;
constexpr size_t WS_ACT = WS_BIG, WS_YEXP = WS_BIG + alignup((size_t)MAXSLOT * DFF * 2);
constexpr size_t WS_END = WS_BIG + SZ_SCORES;
static_assert(WS_YEXP + (size_t)MAXSLOT * DM * 2 <= WS_END, "alias region");
constexpr size_t WS_ARGTAB = 512 * 1024;
constexpr int CW_BAR = 4096, CW_CNT = 16384  , CW_Q = 32768  , CW_ERR = 65536;

constexpr int LDS_BYTES = 147456, LDS_CTL = 131072, MISC_OFF = LDS_CTL + 320, TBL_OFF = LDS_CTL + 1024;

#define LDS_WAIT() asm volatile("s_waitcnt lgkmcnt(0)" ::: "memory")
#define VM_WAIT() asm volatile("s_waitcnt vmcnt(0)" ::: "memory")
#define SBAR() __builtin_amdgcn_sched_barrier(0)

__device__ __forceinline__ unsigned cvtpk(float lo, float hi) { unsigned r; asm volatile("v_cvt_pk_bf16_f32 %0, %1, %2" : "=v"(r) : "v"(lo), "v"(hi)); return r; }
typedef int i32x8 __attribute__((ext_vector_type(8)));
__device__ __forceinline__ unsigned cvt4_fp8(float a, float b, float c, float d) { int w = __builtin_amdgcn_cvt_pk_fp8_f32(a, b, 0, false); w = __builtin_amdgcn_cvt_pk_fp8_f32(c, d, w, true); return (unsigned)w; }
constexpr float OM_SCALE = 64.0f;
__device__ __forceinline__ unsigned char om_fp8(float v) { v = fminf(fmaxf(v * OM_SCALE, -448.0f), 448.0f); return (unsigned char)(__builtin_amdgcn_cvt_pk_fp8_f32(v, v, 0, false) & 0xff); }
constexpr float FP8_WSCALE = 32.0f;
__device__ __forceinline__ float bf2f(unsigned short b) { return __uint_as_float(((unsigned)b) << 16); }
__device__ __forceinline__ float bflo(unsigned w) { return __uint_as_float(w << 16); }
__device__ __forceinline__ float bfhi(unsigned w) { return __uint_as_float(w & 0xffff0000u); }
__device__ __forceinline__ float wave_sum(float v) {
#pragma unroll
    for (int o = 1; o < 64; o <<= 1) v += __shfl_xor(v, o);
    return v;
}
typedef __attribute__((address_space(1))) unsigned char gu8_t;
__device__ __forceinline__ int opaque_tid() { int t = (int)threadIdx.x; asm volatile("" : "+v"(t)); return t; }
__device__ __forceinline__ unsigned char* opaque_ws(unsigned char* p) { size_t z = 0; asm volatile("" : "+s"(z)); return p + z; }
__device__ __forceinline__ int chunk_end(int t) { return t < NMETA ? NMETA : NMETA + 64 * ((t - NMETA) / 64 + 1); }

#define XB_TMO      128
#define XB_XCNT(j)  (256  + 64 * (j))
#define XB_XSUB(j)  (1280 + 64 * (j))
#define XB_XGEN(j)  (2304 + 64 * (j))
#define XB_TOP      3328
#define XB_TOPGEN   3392
#define XCD_BAR_WORDS 3456
#define XB_SPIN_CAP (1u << 18)
__device__ __forceinline__ unsigned xb_ld(unsigned* p)              { return __hip_atomic_load(p, __ATOMIC_RELAXED, __HIP_MEMORY_SCOPE_AGENT); }
__device__ __forceinline__ unsigned xb_add(unsigned* p, unsigned v) { return __hip_atomic_fetch_add(p, v, __ATOMIC_RELAXED, __HIP_MEMORY_SCOPE_AGENT); }
__device__ __forceinline__ unsigned xb_xcc_id() { return (unsigned)__builtin_amdgcn_s_getreg((3 << 11) | 20) & 0xFu; }
#define XB_SPIN(cond, bar) do { unsigned _sp = 0; while (cond) { __builtin_amdgcn_s_sleep(1); \
    if ((++_sp & 255u) == 0u) { if (xb_ld(&(bar)[XB_TMO])) break; if (_sp > XB_SPIN_CAP) { atomicAdd(&(bar)[XB_TMO], 1u); break; } } } } while (0)
struct XcdBarrier { unsigned* bar; unsigned x; volatile LAS unsigned* st; };
__device__ __forceinline__ XcdBarrier xcd_barrier_post(unsigned* bar, volatile LAS unsigned* st) {
    XcdBarrier b; b.bar = bar; b.x = xb_xcc_id(); b.st = st;
    if (threadIdx.x == 0) (void)xb_add(&bar[XB_XCNT(b.x)], 1u);
    return b;
}
__device__ __forceinline__ void xcd_barrier_complete(unsigned* bar, unsigned x, unsigned& nloc, unsigned& nx) {
    const unsigned G = gridDim.x * gridDim.y * gridDim.z;
    unsigned sum, cnt, mine, sp = 0u;
    for (;;) {
        sum = 0u; cnt = 0u; mine = 0u;
#pragma unroll
        for (unsigned j = 0; j < 16; ++j) { const unsigned c = xb_ld(&bar[XB_XCNT(j)]); sum += c; cnt += (c > 0u) ? 1u : 0u; mine = (j == x) ? c : mine; }
        if (sum == G) break;
        __builtin_amdgcn_s_sleep(1);
        if ((++sp & 255u) == 0u) { if (xb_ld(&bar[XB_TMO])) break; if (sp > XB_SPIN_CAP) { atomicAdd(&bar[XB_TMO], 1u); break; } }
    }
    nloc = mine > 0u ? mine : 1u; nx = cnt > 0u ? cnt : 1u;
}
typedef __attribute__((address_space(1))) unsigned gu32_t;
__device__ __forceinline__ void xcd_barrier_body(const XcdBarrier& b) {
    asm volatile("s_waitcnt vmcnt(0)" ::: "memory");
    __syncthreads();
    if (opaque_tid() == 0) {
        size_t z_ = 0; asm volatile("" : "+s"(z_));
        unsigned* bar = b.bar + z_; unsigned bxx = b.x; asm volatile("" : "+s"(bxx));
        __builtin_amdgcn_s_waitcnt(0);
        unsigned nloc = b.st[0], nx = b.st[1];
        if (nloc == 0u) { xcd_barrier_complete(bar, bxx, nloc, nx); b.st[0] = nloc; b.st[1] = nx; }
        const unsigned old = xb_add(&bar[XB_XSUB(bxx)], 1u);
        const unsigned gen = old / nloc;
        if (old + 1u == (gen + 1u) * nloc) {
            __builtin_amdgcn_fence(__ATOMIC_RELEASE, "agent");
            asm volatile("s_waitcnt vmcnt(0)" ::: "memory");
            const unsigned og = xb_add(&bar[XB_TOP], 1u);
            const unsigned tg = og / nx;
            if (og + 1u == (tg + 1u) * nx) xb_add(&bar[XB_TOPGEN], 1u);
            else XB_SPIN(xb_ld(&bar[XB_TOPGEN]) == tg, bar);
            __builtin_amdgcn_fence(__ATOMIC_ACQUIRE, "agent");
            xb_add(&bar[XB_XGEN(bxx)], 1u);
            asm volatile("s_waitcnt vmcnt(0)" ::: "memory");
        } else {
            XB_SPIN(xb_ld(&bar[XB_XGEN(bxx)]) == gen, bar);
            __builtin_amdgcn_fence(__ATOMIC_ACQUIRE, "agent");
            asm volatile("s_waitcnt vmcnt(0)" ::: "memory");
        }
    }
    __syncthreads();
}

__device__ __forceinline__ void xcd_barrier(gu32_t* barg, unsigned x, unsigned st_off) {
    XcdBarrier b; b.bar = (unsigned*)barg; b.x = x; b.st = (volatile LAS unsigned*)(uintptr_t)st_off;
    xcd_barrier_body(b);
}

namespace pg8 {
constexpr int BM = 256, BK = 64, HALF = 128, HTB = HALF * BK * 2, STAGE_BYTES = 8 * HTB, NXCD = 8, WGM = 8;
__device__ __forceinline__ int lds_byte(int r, int c) { const int st = (r >> 4) * 2 + (c >> 5), rr = r & 15, cc = c & 31, ob = rr * 64 + cc * 2; return st * 1024 + (ob ^ (((ob >> 9) & 1) << 5)); }
__device__ __forceinline__ void stage_rc(int b, int& R, int& C) { const int st = b / 1024, sb = b % 1024, swz = sb ^ (((sb >> 9) & 1) << 5); R = (st >> 1) * 16 + swz / 64; C = (st & 1) * 32 + (swz % 64) / 2; }
__device__ __forceinline__ int perm16(int R) { return (R >> 5) * 64 + ((R >> 2) & 3) * 16 + ((R >> 4) & 1) * 4 + (R & 3); }
__device__ __forceinline__ int perm32(int rho) { const int n = rho >> 4, i = rho & 15; return 8 * (i >> 2) + 4 * n + (i & 3); }
struct Unit { int pm, pn, pb, e, j, half; };

struct DenseOrder {
    int nM, nN, nwg, G, c;
    __device__ __forceinline__ void init(int M, int N, int G_, int c_) { nM = M / BM; nN = N / BM; nwg = nM * nN; G = G_; c = c_; }
    __device__ __forceinline__ bool next(int i, Unit& u) const {
        const long L = (long)i * G + c; if (L >= nwg) return false;
        int wgid = (int)L; { const int q = nwg / NXCD, r = nwg % NXCD, xcd = wgid % NXCD, off = wgid / NXCD; wgid = (xcd < r ? xcd * (q + 1) : r * (q + 1) + (xcd - r) * q) + off; }
        const int nig = WGM * nN, gid = wgid / nig, fm = gid * WGM, gsz = (nM - fm) < WGM ? (nM - fm) : WGM;
        u.pm = fm + ((wgid % nig) % gsz); u.pn = (wgid % nig) / gsz; u.pb = u.pn; u.e = 0; u.j = 0; u.half = 0; return true;
    }
    __device__ __forceinline__ int arow(const Unit& u, int r) const { return u.pm * BM + r; }
    __device__ __forceinline__ void arow4(const Unit& u, const int (&r)[4], int (&o)[4]) const { for (int q = 0; q < 4; ++q) o[q] = u.pm * BM + r[q]; }
    __device__ __forceinline__ void arow4_issue(const Unit&, const int (&)[4], int (&)[4]) const {}
    __device__ __forceinline__ int arow4_fin(const Unit& u, int r, int) const { return u.pm * BM + r; }
};

template <class Epi, class Sched, bool FP8 = false>
__device__ __forceinline__ void gemm_phase(LAS unsigned char* lds, const bf16_t* Ag, int lda, const bf16_t* Btg, int K, const Sched& S, const Epi& E) {
    const int tid = opaque_tid(), wid = __builtin_amdgcn_readfirstlane(tid >> 6), lane = tid & 63, wr = wid >> 2, wc = wid & 3, fr = lane & 15, fq = lane >> 4;
    const int nt = K / BK;
    unsigned voffB[2];
#pragma unroll
    for (int i = 0; i < 2; ++i) { int R, C; stage_rc(tid * 16 + i * 8192, R, C); const int Rb = (int)Epi::PERM == 2 ? perm16(R) : Epi::PERM ? ((R & ~31) + perm32(R & 31)) : R; voffB[i] = (unsigned)(Rb * K + C) * 2u; }
    const size_t kstep = (size_t)(BK * 2);
    const size_t tstep = (size_t)2 * HALF * K * 2;
    const size_t hstep = (size_t)((int)Epi::PERM == 2 ? 8 : HALF) * K * 2;
    const unsigned ldsw = (unsigned)wid * 1024u;
    const int aoff = lds_byte(wr * 64 + fr, fq * 8), boff = lds_byte(wc * 32 + fr, fq * 8);
#define PG8_SA(b, h) (((b) * 2 + (h)) * HTB)
#define PG8_SB(b, h) ((4 + (b) * 2 + (h)) * HTB)
#define PG8_STAGE(bufoff, gbase, voff) do { _Pragma("unroll") for (int _i = 0; _i < 2; ++_i) \
        __builtin_amdgcn_global_load_lds((const unsigned*)((const char*)(gbase) + (voff)[_i]), (LAS unsigned*)(lds + (bufoff) + ldsw + _i * 8192), 16, 0, 0); } while (0)
#define PG8_LDA(dst, b, h) do { _Pragma("unroll") for (int m = 0; m < 4; ++m) _Pragma("unroll") for (int k = 0; k < 2; ++k) dst[m][k] = *(const LAS bf16x8*)(lds + PG8_SA(b, h) + aoff + m * 2048 + k * 1024); } while (0)
#define PG8_LDB(dst, b, h) do { _Pragma("unroll") for (int n = 0; n < 2; ++n) _Pragma("unroll") for (int k = 0; k < 2; ++k) dst[n][k] = *(const LAS bf16x8*)(lds + PG8_SB(b, h) + boff + n * 2048 + k * 1024); } while (0)
#define PG8_MMA(ai, bj, At, Bt) do { __builtin_amdgcn_s_setprio(1); _Pragma("unroll") for (int m = 0; m < 4; ++m) _Pragma("unroll") for (int n = 0; n < 2; ++n) { \
        if constexpr (FP8) { const i32x4 a0_ = __builtin_bit_cast(i32x4, At[m][0]), a1_ = __builtin_bit_cast(i32x4, At[m][1]), b0_ = __builtin_bit_cast(i32x4, Bt[n][0]), b1_ = __builtin_bit_cast(i32x4, Bt[n][1]); \
            const i32x8 a8_ = __builtin_shufflevector(a0_, a1_, 0, 1, 2, 3, 4, 5, 6, 7), b8_ = __builtin_shufflevector(b0_, b1_, 0, 1, 2, 3, 4, 5, 6, 7); \
            acc[ai][bj][m][n] = __builtin_amdgcn_mfma_scale_f32_16x16x128_f8f6f4(b8_, a8_, acc[ai][bj][m][n], 0, 0, 0, sc1_, 0, sc1_); } \
        else { _Pragma("unroll") for (int k = 0; k < 2; ++k) acc[ai][bj][m][n] = __builtin_amdgcn_mfma_f32_16x16x32_bf16(Bt[n][k], At[m][k], acc[ai][bj][m][n], 0, 0, 0); } } \
        __builtin_amdgcn_s_setprio(0); } while (0)
#define PG8_WAIT_V(n) asm volatile("s_waitcnt vmcnt(" #n ")" ::: "memory")
#define PG8_WAIT_L(n) asm volatile("s_waitcnt lgkmcnt(" #n ")" ::: "memory")
#define PG8_BAR __builtin_amdgcn_s_barrier()
#define PG8_SCHED __builtin_amdgcn_sched_barrier(0)
#define PG8_AOFF(dst, u) do { int _t = tid; asm volatile("" : "+v"(_t)); int _rw[4], _cc[4]; _Pragma("unroll") for (int _h = 0; _h < 2; ++_h) _Pragma("unroll") for (int _i = 0; _i < 2; ++_i) { int _R, _C; stage_rc(_t * 16 + _i * 8192, _R, _C); \
        _rw[_h * 2 + _i] = _h * HALF + _R; _cc[_h * 2 + _i] = _C; } \
        int _ar[4]; S.arow4(u, _rw, _ar);                                        \
        _Pragma("unroll") for (int _q = 0; _q < 4; ++_q) dst[_q >> 1][_q & 1] = (unsigned)(_ar[_q] * lda + _cc[_q]) * 2u; } while (0)
#define PG8_AOFF_ISSUE(raw, u) do { int _t = tid; asm volatile("" : "+v"(_t)); int _rw[4]; _Pragma("unroll") for (int _h = 0; _h < 2; ++_h) _Pragma("unroll") for (int _i = 0; _i < 2; ++_i) { int _R, _C; stage_rc(_t * 16 + _i * 8192, _R, _C); _rw[_h * 2 + _i] = _h * HALF + _R; } \
        S.arow4_issue(u, _rw, raw); } while (0)
#define PG8_AOFF_FIN(dst, raw, u) do { int _t = tid; asm volatile("" : "+v"(_t)); _Pragma("unroll") for (int _h = 0; _h < 2; ++_h) _Pragma("unroll") for (int _i = 0; _i < 2; ++_i) { int _R, _C; stage_rc(_t * 16 + _i * 8192, _R, _C); \
        dst[_h][_i] = (unsigned)(S.arow4_fin(u, _h * HALF + _R, raw[_h * 2 + _i]) * lda + _C) * 2u; } } while (0)
    Unit cur, nxt; int ui = 0; cur.e = 0;
    if (!S.next(0, cur)) return;
    f32x4 acc[2][2][4][2];
    int sc1_ = 0x7f7f7f7f; float z0_ = 0.f; asm volatile("" : "+v"(sc1_), "+v"(z0_));
    (void)sc1_;
#pragma unroll
    for (int a = 0; a < 2; ++a)
#pragma unroll
        for (int b = 0; b < 2; ++b)
#pragma unroll
            for (int m = 0; m < 4; ++m)
#pragma unroll
                for (int n = 0; n < 2; ++n) acc[a][b][m][n] = (f32x4){z0_, z0_, z0_, z0_};
    bf16x8 At[4][2], B0[2][2], B1[2][2];
    unsigned vA[2][2];
    PG8_AOFF(vA, cur);
    const char* cA = (const char*)Ag;
    const char* cB = (const char*)Btg + (size_t)cur.pb * tstep;
    PG8_STAGE(PG8_SB(0, 0), cB, voffB); PG8_STAGE(PG8_SB(0, 1), cB + hstep, voffB); PG8_STAGE(PG8_SA(0, 0), cA, vA[0]); PG8_STAGE(PG8_SA(0, 1), cA, vA[1]);
    if (wr == 1) PG8_BAR;
    PG8_WAIT_V(2); PG8_BAR;
    PG8_STAGE(PG8_SB(1, 0), cB + kstep, voffB); PG8_STAGE(PG8_SA(1, 0), cA + kstep, vA[0]); PG8_STAGE(PG8_SB(1, 1), cB + hstep + kstep, voffB);
    PG8_WAIT_V(6); PG8_BAR;
    for (;;) {
        nxt.e = cur.e;
        const bool has_next = S.next(ui + 1, nxt);
        const char* nB = has_next ? (const char*)Btg + (size_t)nxt.pb * tstep : cB;
        int rawn[4] = {0, 0, 0, 0}; if (has_next) PG8_AOFF_ISSUE(rawn, nxt);
#pragma unroll 1
        for (int t = 0; t < nt; t += 2) {
            const bool last = (t == nt - 2);
            const char* a1 = cA + (size_t)(t + 1) * kstep;
            const char* a2 = last ? cA : cA + (size_t)(t + 2) * kstep; const char* b2 = last ? nB : cB + (size_t)(t + 2) * kstep;
            const char* a3 = a2 + kstep; const char* b3 = b2 + kstep;
            PG8_LDB(B0, 0, 0); PG8_LDB(B1, 0, 1); PG8_SCHED; PG8_LDA(At, 0, 0); PG8_STAGE(PG8_SA(1, 1), a1, vA[1]);
            if (last && has_next) { PG8_AOFF_FIN(vA, rawn, nxt); }
            PG8_WAIT_V(8); PG8_WAIT_L(0); PG8_BAR; PG8_MMA(0, 0, At, B0); PG8_MMA(0, 1, At, B1); PG8_BAR; PG8_SCHED;
            PG8_LDA(At, 0, 1); PG8_STAGE(PG8_SB(0, 0), b2, voffB); PG8_STAGE(PG8_SB(0, 1), b2 + hstep, voffB); PG8_STAGE(PG8_SA(0, 0), a2, vA[0]);
            PG8_WAIT_V(8); PG8_WAIT_L(0); PG8_BAR; PG8_MMA(1, 0, At, B0); PG8_MMA(1, 1, At, B1); PG8_BAR; PG8_SCHED;
            PG8_LDB(B0, 1, 0); PG8_LDB(B1, 1, 1); PG8_SCHED; PG8_LDA(At, 1, 0); PG8_STAGE(PG8_SA(0, 1), a2, vA[1]);
            PG8_WAIT_V(8); PG8_WAIT_L(0); PG8_BAR; PG8_MMA(0, 0, At, B0); PG8_MMA(0, 1, At, B1); PG8_BAR; PG8_SCHED;
            PG8_LDA(At, 1, 1); PG8_STAGE(PG8_SB(1, 0), b3, voffB); PG8_STAGE(PG8_SB(1, 1), b3 + hstep, voffB); PG8_STAGE(PG8_SA(1, 0), a3, vA[0]);
            PG8_WAIT_V(8); PG8_WAIT_L(0); PG8_BAR; PG8_MMA(1, 0, At, B0); PG8_MMA(1, 1, At, B1); PG8_BAR; PG8_SCHED;
        }
        if (wr == 0) PG8_BAR;
        { const int l_ = opaque_tid() & 63; E(acc, cur, wr, wc, l_ & 15, l_ >> 4); }
        if (!has_next) break;
#pragma unroll
        for (int a = 0; a < 2; ++a)
#pragma unroll
            for (int b = 0; b < 2; ++b)
#pragma unroll
                for (int m = 0; m < 4; ++m)
#pragma unroll
                    for (int n = 0; n < 2; ++n) acc[a][b][m][n] = (f32x4){z0_, z0_, z0_, z0_};
        cur = nxt; cB = nB; ++ui;
        if (wr == 1) PG8_BAR;
    }
    PG8_WAIT_V(0);
    PG8_BAR;
#undef PG8_SA
#undef PG8_SB
#undef PG8_STAGE
#undef PG8_LDA
#undef PG8_LDB
#undef PG8_MMA
#undef PG8_WAIT_V
#undef PG8_WAIT_L
#undef PG8_BAR
#undef PG8_SCHED
#undef PG8_AOFF
#undef PG8_AOFF_ISSUE
#undef PG8_AOFF_FIN
}
}
namespace pg8 {
#define ST16(base, boff, v) __builtin_nontemporal_store((v), (u32x4*)((char*)(base) + (boff)))
#define PACK8(v0, v1) ({ u32x4 w_; w_.x = cvtpk((v0)[0], (v0)[1]); w_.y = cvtpk((v0)[2], (v0)[3]); w_.z = cvtpk((v1)[0], (v1)[1]); w_.w = cvtpk((v1)[2], (v1)[3]); w_; })
struct EpiBf16 {
    static constexpr bool PERM = true;
    bf16_t* O; int ldc; float sc;
    __device__ __forceinline__ void operator()(const f32x4 (&acc)[2][2][4][2], const Unit& u, int wr, int wc, int fr, int fq) const {
        const unsigned o0 = (unsigned)((u.pm * BM + wr * 64 + fr) * ldc + u.pn * BM + wc * 32 + 8 * fq) * 2u;
#pragma unroll
        for (int ai = 0; ai < 2; ++ai)
#pragma unroll
            for (int m = 0; m < 4; ++m) { const unsigned ro = o0 + (unsigned)((ai * HALF + m * 16) * ldc) * 2u;
#pragma unroll
                for (int bj = 0; bj < 2; ++bj) ST16(O, ro + bj * HALF * 2, PACK8(acc[ai][bj][m][0] * sc, acc[ai][bj][m][1] * sc)); }
    }
};
struct EpiQ {
    static constexpr bool PERM = true;
    bf16_t* QM; const float* rope;
    __device__ __forceinline__ void operator()(const f32x4 (&acc)[2][2][4][2], const Unit& u, int wr, int wc, int fr, int fq) const {
        const int row0 = u.pm * BM + wr * 64 + fr;
        if (u.pn < 2) {
            const unsigned o0 = (unsigned)(row0 * 768 + 2 * u.pn * 192 + wc * 32 + 8 * fq) * 2u;
#pragma unroll
            for (int ai = 0; ai < 2; ++ai)
#pragma unroll
                for (int m = 0; m < 4; ++m) { const unsigned ro = o0 + (unsigned)((ai * HALF + m * 16) * 768) * 2u;
#pragma unroll
                    for (int bj = 0; bj < 2; ++bj) ST16(QM, ro + bj * 192 * 2, PACK8(acc[ai][bj][m][0], acc[ai][bj][m][1])); }
        } else {
            const int g8 = 4 * (wc & 1) + fq;
            const unsigned o0 = (unsigned)(row0 * 768 + (wc >> 1) * 192 + 128 + 4 * g8) * 2u;
#pragma unroll
            for (int ai = 0; ai < 2; ++ai) {
                f32x4 csa[4], csb[4];
#pragma unroll
                for (int m = 0; m < 4; ++m) { const int t_ = (row0 + ai * HALF + m * 16) % NTOK; const unsigned co_ = (unsigned)(t_ * 32 + 4 * g8) * 8u;
                    csa[m] = *(const f32x4*)((const char*)rope + co_); csb[m] = *(const f32x4*)((const char*)rope + co_ + 16); }
                asm volatile("" ::: "memory");
#pragma unroll
                for (int m = 0; m < 4; ++m) {
                    const f32x4 cs0 = csa[m], cs1 = csb[m];
                    const float c[4] = {cs0[0], cs0[2], cs1[0], cs1[2]}, s[4] = {cs0[1], cs0[3], cs1[1], cs1[3]};
                    const unsigned ro = o0 + (unsigned)((ai * HALF + m * 16) * 768) * 2u;
#pragma unroll
                    for (int bj = 0; bj < 2; ++bj) { const f32x4 x1 = acc[ai][bj][m][0], x2 = acc[ai][bj][m][1];
                        float o1[4], o2[4];
#pragma unroll
                        for (int i = 0; i < 4; ++i) { o1[i] = x1[i] * c[i] - x2[i] * s[i]; o2[i] = x1[i] * s[i] + x2[i] * c[i]; }
                        u32x2 w1, w2; w1.x = cvtpk(o1[0], o1[1]); w1.y = cvtpk(o1[2], o1[3]); w2.x = cvtpk(o2[0], o2[1]); w2.y = cvtpk(o2[2], o2[3]);
                        *(u32x2*)((char*)QM + ro + bj * 2 * 192 * 2) = w1; *(u32x2*)((char*)QM + ro + bj * 2 * 192 * 2 + 64) = w2; }
                    asm volatile("" ::: "memory"); }
            }
        }
    }
};
struct EpiKV {
    static constexpr bool PERM = true;
    bf16_t* KN; bf16_t* VM;
    __device__ __forceinline__ void operator()(const f32x4 (&acc)[2][2][4][2], const Unit& u, int wr, int wc, int fr, int fq) const {
        const unsigned o0 = (unsigned)((u.pm * BM + wr * 64 + fr) * 512 + u.pn * 128 + wc * 32 + 8 * fq) * 2u;
#pragma unroll
        for (int ai = 0; ai < 2; ++ai)
#pragma unroll
            for (int m = 0; m < 4; ++m) { const unsigned ro = o0 + (unsigned)((ai * HALF + m * 16) * 512) * 2u;
                ST16(KN, ro, PACK8(acc[ai][0][m][0], acc[ai][0][m][1])); ST16(VM, ro, PACK8(acc[ai][1][m][0], acc[ai][1][m][1])); }
    }
};
struct EpiOut {
    static constexpr bool PERM = false;
    const bf16_t* HB; bf16_t* Y; float* STAT;
    __device__ __forceinline__ void operator()(const f32x4 (&acc)[2][2][4][2], const Unit& u, int wr, int wc, int fr, int fq) const {
        const int row0 = u.pm * BM + wr * 64 + fr, col0 = u.pn * BM + wc * 32 + 4 * fq;
#pragma unroll
        for (int ai = 0; ai < 2; ++ai) {
            u32x2 hres[4][2][2];
#pragma unroll
            for (int m = 0; m < 4; ++m) { const unsigned off = (unsigned)((row0 + ai * HALF + m * 16) * DM + col0) * 4u;
#pragma unroll
                for (int bj = 0; bj < 2; ++bj)
#pragma unroll
                    for (int n = 0; n < 2; ++n) hres[m][bj][n] = *(const u32x2*)((const char*)HB + ((off + (bj * HALF + n * 16) * 4) >> 1)); }
            asm volatile("" ::: "memory");
#pragma unroll
            for (int m = 0; m < 4; ++m) { const int row = row0 + ai * HALF + m * 16; float s = 0.f, q = 0.f;
                const unsigned yb = (unsigned)((((row >> 5) * 128 + (col0 >> 4)) * 32 + (row & 31)) * 16 + (col0 & 15)) * 2u;
#pragma unroll
                for (int bj = 0; bj < 2; ++bj)
#pragma unroll
                    for (int n = 0; n < 2; ++n) { const u32x2 hw = hres[m][bj][n]; const f32x4 hv = {bflo(hw.x), bfhi(hw.x), bflo(hw.y), bfhi(hw.y)}; const f32x4 y = acc[ai][bj][m][n] * (1.0f / (FP8_WSCALE * OM_SCALE)) + hv * DN_ALPHA;
                        { u32x2 yw; yw.x = cvtpk(y[0], y[1]); yw.y = cvtpk(y[2], y[3]); *(u32x2*)((char*)Y + yb + (unsigned)(((bj * HALF + n * 16) >> 4) * 32 * 16) * 2u) = yw; } s += (y[0] + y[1]) + (y[2] + y[3]); q += (y[0] * y[0] + y[1] * y[1]) + (y[2] * y[2] + y[3] * y[3]); }
                s += __shfl_xor(s, 16); s += __shfl_xor(s, 32); q += __shfl_xor(q, 16); q += __shfl_xor(q, 32);
                if (fq == 0) *(f32x2*)((char*)STAT + (unsigned)(row * 32 + u.pn * 4 + wc) * 8u) = (f32x2){s, q}; }
        }
    }
};
struct EpiSwiglu {
    static constexpr bool PERM = true;
    bf16_t* ACT; const float* b_in;
    __device__ __forceinline__ void operator()(const f32x4 (&acc)[2][2][4][2], const Unit& u, int wr, int wc, int fr, int fq) const {
        const int col = u.pn * 128 + wc * 32 + 8 * fq;
        const unsigned o0 = (unsigned)((u.pm * BM + wr * 64 + fr) * DFF + col);
        const float* bg = b_in + (size_t)u.e * 1024 + col; const float* bu = bg + 512;
        const f32x4 bg0 = *(const f32x4*)bg, bg1 = *(const f32x4*)(bg + 4), bu0 = *(const f32x4*)bu, bu1 = *(const f32x4*)(bu + 4);
#pragma unroll
        for (int ai = 0; ai < 2; ++ai)
#pragma unroll
            for (int m = 0; m < 4; ++m) { float a[8];
#pragma unroll
                for (int n = 0; n < 2; ++n) { const f32x4 g4 = acc[ai][0][m][n] * (1.0f / FP8_WSCALE) + (n ? bg1 : bg0), u4 = acc[ai][1][m][n] * (1.0f / FP8_WSCALE) + (n ? bu1 : bu0);
#pragma unroll
                    for (int i = 0; i < 4; ++i) { const float g = fminf(g4[i], 7.0f), up = fminf(fmaxf(u4[i], -7.0f), 7.0f);
                        const float sg = __builtin_amdgcn_rcpf(1.0f + __builtin_amdgcn_exp2f(-1.702f * 1.4426950408889634f * g));
                        a[4 * n + i] = g * sg * (up + 1.0f); } }
                u32x2 w; w.x = cvt4_fp8(a[0], a[1], a[2], a[3]); w.y = cvt4_fp8(a[4], a[5], a[6], a[7]);
                *(u32x2*)((char*)ACT + o0 + (unsigned)((ai * HALF + m * 16) * DFF)) = w;
                asm volatile("" ::: "memory"); }
    }
};
struct EpiDown {
    static constexpr int PERM = 2;
    unsigned char* YE; const float* b_out;
    __device__ __forceinline__ void operator()(const f32x4 (&acc)[2][2][4][2], const Unit& u, int wr, int wc, int fr, int fq) const {
        const int col0 = u.pn * BM + wc * 64 + 16 * fq;
        const unsigned o0 = (unsigned)((u.pm * BM + wr * 64 + fr) * DM + col0);
        const unsigned bo = (unsigned)(u.e * DM + col0) * 4u;
        f32x4 bb[2][2];
#pragma unroll
        for (int bj = 0; bj < 2; ++bj)
#pragma unroll
            for (int n = 0; n < 2; ++n) bb[bj][n] = *(const f32x4*)((const char*)b_out + bo + (bj * 8 + n * 4) * 4);
#pragma unroll
        for (int ai = 0; ai < 2; ++ai)
#pragma unroll
            for (int m = 0; m < 4; ++m) { u32x4 w;
                { const f32x4 v = acc[ai][0][m][0] * (1.0f / FP8_WSCALE) + bb[0][0]; w.x = cvt4_fp8(v[0], v[1], v[2], v[3]); }
                { const f32x4 v = acc[ai][0][m][1] * (1.0f / FP8_WSCALE) + bb[0][1]; w.y = cvt4_fp8(v[0], v[1], v[2], v[3]); }
                { const f32x4 v = acc[ai][1][m][0] * (1.0f / FP8_WSCALE) + bb[1][0]; w.z = cvt4_fp8(v[0], v[1], v[2], v[3]); }
                { const f32x4 v = acc[ai][1][m][1] * (1.0f / FP8_WSCALE) + bb[1][1]; w.w = cvt4_fp8(v[0], v[1], v[2], v[3]); }
                __builtin_nontemporal_store(w, (u32x4*)(YE + o0 + (unsigned)((ai * HALF + m * 16) * DM))); }
    }
};
struct MoeOrder {
    const LAS int* tstart; const unsigned* cnt; const int* rowtok; int nN, G, c; bool gather; bool runs;
    __device__ __forceinline__ bool next(int i, Unit& u) const {
        const int total = tstart[NEXP];
        const int per = (total * nN + G - 1) / G;
        const long L = runs ? (long)c * per + i : (long)i * G + c; if (L >= (long)total * nN || (runs && i >= per)) return false;
        const int mt = (int)(L / nN), pn = (int)(L % nN);
        int e = (u.e > 0 && u.e < NEXP && tstart[u.e] <= mt) ? u.e : 0;
#pragma unroll 1
        while (e + 1 < NEXP && tstart[e + 1] <= mt) ++e;
        u.pm = mt; u.pn = pn; u.e = e; u.j = mt - tstart[e]; u.pb = e * nN + pn; u.half = 0; return true;
    }
    __device__ __forceinline__ int arow(const Unit& u, int r) const {
        if (!gather) return u.pm * BM + r;
        const int p = u.j * BM + r; const int n = tstart[64 + u.e];
        const int v = rowtok[(size_t)u.e * MROWS + (p < n ? p : 0)];
        return (p < n) ? v : 0;
    }
    __device__ __forceinline__ void arow4_issue(const Unit& u, const int (&r)[4], int (&raw)[4]) const {
        if (!gather) return;
        const int n = tstart[64 + u.e];
#pragma unroll
        for (int q = 0; q < 4; ++q) { const int p = u.j * BM + r[q]; raw[q] = rowtok[(size_t)u.e * MROWS + (p < n ? p : 0)]; }
    }
    __device__ __forceinline__ int arow4_fin(const Unit& u, int r, int raw) const {
        if (!gather) return u.pm * BM + r;
        const int p = u.j * BM + r; const int n = tstart[64 + u.e]; return (p < n) ? raw : 0;
    }
    __device__ __forceinline__ void arow4(const Unit& u, const int (&r)[4], int (&o)[4]) const {
        if (!gather) { for (int q = 0; q < 4; ++q) o[q] = u.pm * BM + r[q]; return; }
        const int n = tstart[64 + u.e]; int v[4];
#pragma unroll
        for (int q = 0; q < 4; ++q) { const int p = u.j * BM + r[q]; v[q] = rowtok[(size_t)u.e * MROWS + (p < n ? p : 0)]; }
        asm volatile("" ::: "memory");
#pragma unroll
        for (int q = 0; q < 4; ++q) { const int p = u.j * BM + r[q]; o[q] = (p < n) ? v[q] : 0; }
    }
};
}
struct KArgs { const float* in[19]; float* out; unsigned char* ws; };
struct PArgs { const KArgs& k; unsigned char* ws;
    __device__ __forceinline__ const float* in(int i) const { return k.in[i]; }
    __device__ __forceinline__ float* out() const { return k.out; } };
enum { I_X = 0, I_META, I_REL, I_EVWIN, I_QNORM, I_KVNORM, I_WUQ, I_WUKV, I_EVWOUT, I_ODWIN, I_ODWOUT, I_LNG, I_LNB, I_RW, I_RB, I_EWIN, I_EBIN, I_EWOUT, I_EBOUT };

__device__ __forceinline__ int rowmap(int kind, int n) {
    switch (kind) {
    case 0: {
        if (n < 768) return n; if (n < 832) return EC_KROPE + (n - 768); if (n < 2368) return n - 64; return n; }
    case 1: {
        const int head = n / 192, d = n % 192; if (d < 128) return head * 128 + d;
        const int i = d - 128; if (i < 32) return 512 + head * 64 + 8 * (i >> 2) + (i & 3); const int i2 = i - 32; return 512 + head * 64 + 8 * (i2 >> 2) + 4 + (i2 & 3); }
    case 2: {
        if (n < 512) return 256 * (n >> 7) + (n & 127); const int j = n - 512; return 256 * (j >> 7) + 128 + (j & 127); }
    default: return n;
    }
}
__device__ __forceinline__ void ti_load(f32x4 (&v)[8], const float* W, int Nsrc, int nblk, int item, int lane) {
    const int kb = item / nblk, nb = item % nblk, k0 = 64 * kb, n0 = 32 * nb; const int nq = n0 + 4 * (lane & 7);
#pragma unroll
    for (int i = 0; i < 8; ++i) { const int kk = 8 * i + (lane >> 3); v[i] = (nq < Nsrc) ? *(const f32x4*)(W + (size_t)(k0 + kk) * Nsrc + nq) : (f32x4){0.f, 0.f, 0.f, 0.f}; }
}
__device__ __forceinline__ void ti_finish(const f32x4 (&v)[8], int K, int nblk, bf16_t* WT, int kind, LAS float* scr, int item, int lane) {
    const int kb = item / nblk, nb = item % nblk, k0 = 64 * kb, n0 = 32 * nb;
#pragma unroll
    for (int i = 0; i < 8; ++i) { const int kk = 8 * i + (lane >> 3); LAS float* d = scr + kk * 33 + 4 * (lane & 7); d[0] = v[i][0]; d[1] = v[i][1]; d[2] = v[i][2]; d[3] = v[i][3]; }
    LDS_WAIT(); asm volatile("" ::: "memory");
    const int c = lane & 7;
#pragma unroll
    for (int j = 0; j < 4; ++j) { const int n = (lane >> 3) + 8 * j; const LAS float* s = scr + (8 * c) * 33 + n;
        u32x4 o; o.x = cvtpk(s[0 * 33], s[1 * 33]); o.y = cvtpk(s[2 * 33], s[3 * 33]); o.z = cvtpk(s[4 * 33], s[5 * 33]); o.w = cvtpk(s[6 * 33], s[7 * 33]);
        *(u32x4*)(WT + (size_t)rowmap(kind, n0 + n) * K + k0 + 8 * c) = o; }
    LDS_WAIT(); asm volatile("" ::: "memory");
}
__device__ __forceinline__ void ti_finish8(const f32x4 (&v)[8], int K, int nblk, unsigned char* WT8, int kind, LAS float* scr, int item, int lane) {
    const int kb = item / nblk, nb = item % nblk, k0 = 64 * kb, n0 = 32 * nb;
#pragma unroll
    for (int i = 0; i < 8; ++i) { const int kk = 8 * i + (lane >> 3); LAS float* d = scr + kk * 33 + 4 * (lane & 7); d[0] = v[i][0]; d[1] = v[i][1]; d[2] = v[i][2]; d[3] = v[i][3]; }
    LDS_WAIT(); asm volatile("" ::: "memory");
    const int c = lane & 7;
#pragma unroll
    for (int j = 0; j < 4; ++j) { const int n = (lane >> 3) + 8 * j; const LAS float* s = scr + (8 * c) * 33 + n;
        u32x2 o; o.x = cvt4_fp8(s[0 * 33] * FP8_WSCALE, s[1 * 33] * FP8_WSCALE, s[2 * 33] * FP8_WSCALE, s[3 * 33] * FP8_WSCALE);
        o.y = cvt4_fp8(s[4 * 33] * FP8_WSCALE, s[5 * 33] * FP8_WSCALE, s[6 * 33] * FP8_WSCALE, s[7 * 33] * FP8_WSCALE);
        *(u32x2*)(WT8 + (size_t)rowmap(kind, n0 + n) * K + k0 + 8 * c) = o; }
    LDS_WAIT(); asm volatile("" ::: "memory");
}
__device__ __forceinline__ void transpose_item8(const float* W, int K, int Nsrc, int nblk, unsigned char* WT8, int kind, LAS float* scr, int item, int lane) {
    f32x4 v[8]; ti_load(v, W, Nsrc, nblk, item, lane); ti_finish8(v, K, nblk, WT8, kind, scr, item, lane);
}
__device__ __forceinline__ void transpose_item(const float* W, int K, int Nsrc, int nblk, bf16_t* WT, int kind, LAS float* scr, int item, int lane) {
    f32x4 v[8]; ti_load(v, W, Nsrc, nblk, item, lane); ti_finish(v, K, nblk, WT, kind, scr, item, lane);
}
__device__ __forceinline__ void phase_prologue(const PArgs& a, LAS unsigned char* lds, int vcu, int G) {
    const int tid = opaque_tid(), lane = tid & 63, wave = __builtin_amdgcn_readfirstlane(tid >> 6);
    LAS float* scr = (LAS float*)(lds + wave * 16384);
    const int gw = vcu * 8 + wave, NGW = G * 8;
    unsigned char* ws = a.ws;
    constexpr int I_EVIN = (DM / 64) * (EVP / 32), I_UQ = (512 / 64) * (768 / 32), I_UKV = (256 / 64) * (1024 / 32), I_OUT = (1024 / 64) * (DM / 32), I_ODIN = (DM / 64) * (ODP / 32);
    constexpr int I_EI = (DM / 64) * (1024 / 32), I_EO = (DFF / 64) * (DM / 32);
    constexpr int N_SMALL = 2 * (I_EVIN + I_UQ + I_UKV + I_OUT + I_ODIN + I_OUT);
    constexpr long N_ALL = (long)N_SMALL;
    for (long it = gw; it < N_ALL; it += NGW) {
        long r = it;
        if (r < N_SMALL) {
            const int j = (int)(r & 1); r >>= 1;
            if (r < I_EVIN) { transpose_item8(a.in(I_EVWIN) + (size_t)j * DM * 2368, DM, 2368, EVP / 32, ws + WS_WINE + j * SZ_WINE, 0, scr, (int)r, lane); continue; } r -= I_EVIN;
            if (r < I_UQ) { transpose_item(a.in(I_WUQ) + (size_t)j * 512 * 768, 512, 768, 768 / 32, (bf16_t*)(ws + WS_WUQ + j * SZ_WUQ), 1, scr, (int)r, lane); continue; } r -= I_UQ;
            if (r < I_UKV) { transpose_item(a.in(I_WUKV) + (size_t)j * 256 * 1024, 256, 1024, 1024 / 32, (bf16_t*)(ws + WS_WUKV + j * SZ_WUKV), 3, scr, (int)r, lane); continue; } r -= I_UKV;
            if (r < I_OUT) { transpose_item8(a.in(I_EVWOUT) + (size_t)j * 1024 * DM, 1024, DM, DM / 32, ws + WS_WOUTE + j * SZ_WOUT, 3, scr, (int)r, lane); continue; } r -= I_OUT;
            if (r < I_ODIN) { transpose_item8(a.in(I_ODWIN) + (size_t)j * DM * 1864, DM, 1864, ODP / 32, ws + WS_WINO + j * SZ_WINO, 3, scr, (int)r, lane); continue; } r -= I_ODIN;
            transpose_item8(a.in(I_ODWOUT) + (size_t)j * 1024 * DM, 1024, DM, DM / 32, ws + WS_WOUTO + j * SZ_WOUT, 3, scr, (int)r, lane); continue;
        }
    }
    {   constexpr int PER = I_EI + I_EO; constexpr long NEXI = (long)DEPTH * NEXP * PER;
#define EXP_DESC(idx, Wp, Kd, Ns, nb, Tp, kd, qi) const int le_ = (int)((idx) / PER), q_ = (int)((idx) % PER); const bool ei_ = q_ < I_EI; \
        const float* Wp = ei_ ? a.in(I_EWIN) + (size_t)le_ * DM * 1024 : a.in(I_EWOUT) + (size_t)le_ * DFF * DM; const int Kd = ei_ ? DM : DFF, Ns = ei_ ? 1024 : DM, nb = ei_ ? 1024 / 32 : DM / 32; \
        unsigned char* Tp = ei_ ? (ws + WS_WEI + (size_t)le_ * SZ_WEI) : (ws + WS_WEO + (size_t)le_ * SZ_WEO); const int kd = ei_ ? 2 : 3, qi = ei_ ? q_ : q_ - I_EI
        f32x4 va[8], vb[8];
        long it = gw;
        if (it < NEXI) { EXP_DESC(it, W0, K0, N0, B0, T0, D0, Q0); (void)K0; (void)T0; (void)D0; ti_load(va, W0, N0, B0, Q0, lane); }
        for (; it < NEXI; it += 2 * NGW) {
            const long i1 = it + NGW, i2 = it + 2 * NGW;
            if (i1 < NEXI) { EXP_DESC(i1, W1, K1, N1, B1, T1, D1, Q1); (void)K1; (void)T1; (void)D1; ti_load(vb, W1, N1, B1, Q1, lane); }
            { EXP_DESC(it, W0, K0, N0, B0, T0, D0, Q0); (void)W0; (void)N0; ti_finish8(va, K0, B0, T0, D0, scr, Q0, lane); }
            if (i2 < NEXI) { EXP_DESC(i2, W2, K2, N2, B2, T2, D2, Q2); (void)K2; (void)T2; (void)D2; ti_load(va, W2, N2, B2, Q2, lane); }
            if (i1 < NEXI) { EXP_DESC(i1, W1, K1, N1, B1, T1, D1, Q1); (void)W1; (void)N1; ti_finish8(vb, K1, B1, T1, D1, scr, Q1, lane); }
        }
#undef EXP_DESC
    }
    for (int i = gw * 64 + lane; i < DEPTH * 32 * DM; i += NGW * 64) {
        const int l = i / (32 * DM), e = (i / DM) % 32, k = i % DM;
        const float w = a.in(I_RW)[((size_t)l * DM + k) * 32 + e];
        const unsigned hi = cvtpk(w, 0.f) & 0xffffu; const float lo = w - bflo(hi);
        ((bf16_t*)(ws + WS_WRH))[i] = (bf16_t)hi; ((bf16_t*)(ws + WS_WRL))[i] = (bf16_t)(cvtpk(lo, 0.f) & 0xffffu);
    }
    for (int i = gw * 64 + lane; i < NTOK * 32; i += NGW * 64) {
        const int t = i >> 5, k = i & 31;
        const float inv = powf(10000.0f, -(float)k / 32.0f); const float ang = (float)t * inv;
        float sn, cs; sincosf(ang, &sn, &cs);
        *(f32x2*)((float*)(ws + WS_ROPE) + (size_t)i * 2) = (f32x2){cs, sn};
    }
    bf16_t* HB = (bf16_t*)(ws + WS_HB);
    for (int m = gw; m < MROWS; m += NGW) {
        const int b = m / NTOK, t = m % NTOK;
        const float* src = (t < NMETA) ? a.in(I_META) + (size_t)t * DM : a.in(I_X) + ((size_t)b * SEQ + (t - NMETA)) * DM;
        const bool zero = t >= NMETA + SEQ;
        f32x4 v8[8];
#pragma unroll
        for (int j = 0; j < 8; ++j) v8[j] = zero ? (f32x4){0.f, 0.f, 0.f, 0.f} : *(const f32x4*)(src + 4 * lane + 256 * j);
        asm volatile("" ::: "memory");
#pragma unroll
        for (int j = 0; j < 8; ++j) { const int c = 4 * lane + 256 * j; const f32x4 v = v8[j];
            u32x2 w; w.x = cvtpk(v[0], v[1]); w.y = cvtpk(v[2], v[3]); *(u32x2*)(HB + (size_t)m * DM + c) = w;
            *(unsigned*)(ws + WS_HB8 + (size_t)m * DM + c) = cvt4_fp8(v[0], v[1], v[2], v[3]); }
    }
}

__device__ __forceinline__ void phase_latent_norm(const PArgs& a, int jl, int vcu, int G) {
    const int tid = opaque_tid(), lane = tid & 63, wave = __builtin_amdgcn_readfirstlane(tid >> 6);
    const int gw = vcu * 8 + wave, NGW = G * 8;
    unsigned char* ws = a.ws;
    const bf16_t* P = (const bf16_t*)(ws + WS_P); bf16_t* QN = (bf16_t*)(ws + WS_QN); bf16_t* KVN = (bf16_t*)(ws + WS_KVN); bf16_t* KR = (bf16_t*)(ws + WS_KR);
    const float* rope = (const float*)(ws + WS_ROPE);
    const float* gq = a.in(I_QNORM) + jl * 512; const float* gkv = a.in(I_KVNORM) + jl * 256;
    f32x4 g0 = *(const f32x4*)(gq + 8 * lane), g1 = *(const f32x4*)(gq + 8 * lane + 4), gk = *(const f32x4*)(gkv + 4 * lane);
    const int lr = lane & 31;
#define LAT_LOAD(m_, qv_, kv_, x1_, x2_, cs_) do { const bf16_t* pr_ = P + (size_t)(m_) * EVP; qv_ = *(const u32x4*)(pr_ + EC_QLAT + 8 * lane); kv_ = *(const u32x2*)(pr_ + EC_KVLAT + 4 * lane); \
        x1_ = pr_[EC_KROPE + lr]; x2_ = pr_[EC_KROPE + 32 + lr]; cs_ = *(const f32x2*)(rope + ((size_t)((m_) % NTOK) * 32 + lr) * 2); } while (0)
    u32x4 qv = {0u, 0u, 0u, 0u}, qvn = qv; u32x2 kv = {0u, 0u}, kvn = kv; bf16_t x1b = 0, x2b = 0, x1n = 0, x2n = 0; f32x2 cs = {0.f, 0.f}, csn = cs;
    if (gw < MROWS) LAT_LOAD(gw, qv, kv, x1b, x2b, cs);
    for (int m = gw; m < MROWS; m += NGW) {
        const int mn = (m + NGW < MROWS) ? m + NGW : m;
        LAT_LOAD(mn, qvn, kvn, x1n, x2n, csn);
        asm volatile("" ::: "memory");
        float q[8] = {bflo(qv.x), bfhi(qv.x), bflo(qv.y), bfhi(qv.y), bflo(qv.z), bfhi(qv.z), bflo(qv.w), bfhi(qv.w)};
        float k[4] = {bflo(kv.x), bfhi(kv.x), bflo(kv.y), bfhi(kv.y)};
        float sq = 0.f, sk = 0.f;
#pragma unroll
        for (int i = 0; i < 8; ++i) sq += q[i] * q[i];
#pragma unroll
        for (int i = 0; i < 4; ++i) sk += k[i] * k[i];
        sq = wave_sum(sq); sk = wave_sum(sk);
        const float rq = 1.0f / sqrtf(sq * (1.0f / 512.0f) + RMS_EPS), rk = 1.0f / sqrtf(sk * (1.0f / 256.0f) + RMS_EPS);
        u32x4 wq; wq.x = cvtpk(q[0] * rq * g0[0], q[1] * rq * g0[1]); wq.y = cvtpk(q[2] * rq * g0[2], q[3] * rq * g0[3]);
        wq.z = cvtpk(q[4] * rq * g1[0], q[5] * rq * g1[1]); wq.w = cvtpk(q[6] * rq * g1[2], q[7] * rq * g1[3]);
        *(u32x4*)(QN + (size_t)m * 512 + 8 * lane) = wq;
        u32x2 wk; wk.x = cvtpk(k[0] * rk * gk[0], k[1] * rk * gk[1]); wk.y = cvtpk(k[2] * rk * gk[2], k[3] * rk * gk[3]);
        *(u32x2*)(KVN + (size_t)m * 256 + 4 * lane) = wk;
        if (lane < 32) {
            const float x1 = bf2f(x1b), x2 = bf2f(x2b);
            KR[(size_t)m * 64 + lane] = (bf16_t)(cvtpk(x1 * cs[0] - x2 * cs[1], 0.f) & 0xffffu);
            KR[(size_t)m * 64 + 32 + lane] = (bf16_t)(cvtpk(x1 * cs[1] + x2 * cs[0], 0.f) & 0xffffu);
        }
        qv = qvn; kv = kvn; x1b = x1n; x2b = x2n; cs = csn;
    }
#undef LAT_LOAD
}

__device__ __forceinline__ void phase_ln_route(const PArgs& a, int layer, int cslot, LAS unsigned char* lds, int vcu, int G) {
    const int tid = opaque_tid(), lane = tid & 63, wave = __builtin_amdgcn_readfirstlane(tid >> 6);
    const int r32 = lane & 31, hh = lane >> 5;
    unsigned char* ws = a.ws;
    const bf16_t* Y = (const bf16_t*)(ws + WS_Y); const float* STAT = (const float*)(ws + WS_STAT);
    bf16_t* HB = (bf16_t*)(ws + WS_HB);
    const bf16_t* WRH = (const bf16_t*)(ws + WS_WRH) + (size_t)layer * 32 * DM; const bf16_t* WRL = (const bf16_t*)(ws + WS_WRL) + (size_t)layer * 32 * DM;
    const float* g = a.in(I_LNG) + (size_t)(layer * 2 + 0) * DM; const float* bta = a.in(I_LNB) + (size_t)(layer * 2 + 0) * DM;
    const float* rb = a.in(I_RB) + layer * 32;
    unsigned* cnt = (unsigned*)(ws + WS_CTL) + CW_CNT + 2048 * cslot;
    int* TOPE = (int*)(ws + WS_TOPE); int* TOPP = (int*)(ws + WS_TOPP); float* TOPG = (float*)(ws + WS_TOPG); int* ROWTOK = (int*)(ws + WS_ROWTOK);
    LAS float* part = (LAS float*)lds;
    LAS float* tot = part + 8 * 16 * 64;
    LAS float* gbl = tot + 16 * 64 + wave * 512;
    LAS unsigned* lcnt = (LAS unsigned*)(tot + 16 * 64 + 8 * 512);
    LAS unsigned char* stg = lds + 57344 + wave * 7168;
    const int cbase = 256 * wave, lcol = 16 * hh;
    bf16x8 whf[16], wlf[16];
#pragma unroll
    for (int s = 0; s < 16; ++s) { const int col = cbase + 32 * (s >> 1) + lcol + 8 * (s & 1);
        whf[s] = *(const bf16x8*)(WRH + (size_t)r32 * DM + col); wlf[s] = *(const bf16x8*)(WRL + (size_t)r32 * DM + col); }
    { const f32x4 gv = *(const f32x4*)(g + cbase + 4 * lane), bv = *(const f32x4*)(bta + cbase + 4 * lane);
      *(LAS f32x4*)(gbl + 4 * lane) = gv; *(LAS f32x4*)(gbl + 256 + 4 * lane) = bv; }
    LDS_WAIT(); asm volatile("" ::: "memory");
    for (int grp = vcu; grp < MROWS / 32; grp += G) {
        const int row = grp * 32 + r32;
        float s = 0.f, q = 0.f;
        { const f32x4* st = (const f32x4*)(STAT + (size_t)row * 64);
#pragma unroll
          for (int i = 0; i < 16; ++i) { const f32x4 v = st[i]; s += v[0] + v[2]; q += v[1] + v[3]; } }
        const float mean = s * (1.0f / DM); const float var = fmaxf(q * (1.0f / DM) - mean * mean, 0.f); const float rstd = 1.0f / sqrtf(var + LN_EPS);
        f32x16 acc;
#pragma unroll
        for (int i = 0; i < 16; ++i) acc[i] = 0.f;
        const size_t ro = (size_t)row * DM + cbase + lcol;
        u32x4 yAv[4], yBv[4];
#pragma unroll
        for (int p = 0; p < 8; ++p) {
            if ((p & 3) == 0) {
#pragma unroll
                for (int pp = 0; pp < 4; ++pp) { const bf16_t* yp = Y + ((size_t)(grp * 128 + 16 * wave + 2 * (p + pp) + hh) * 32 + r32) * 16;
                    yAv[pp] = *(const u32x4*)(yp); yBv[pp] = *(const u32x4*)(yp + 8); }
                asm volatile("" ::: "memory"); }
            const u32x4 yA = yAv[p & 3], yB = yBv[p & 3];
            const f32x4 y0 = {bflo(yA.x), bfhi(yA.x), bflo(yA.y), bfhi(yA.y)}, y1 = {bflo(yA.z), bfhi(yA.z), bflo(yA.w), bfhi(yA.w)}, y2 = {bflo(yB.x), bfhi(yB.x), bflo(yB.y), bfhi(yB.y)}, y3 = {bflo(yB.z), bfhi(yB.z), bflo(yB.w), bfhi(yB.w)};
            const LAS float* gp = gbl + 32 * p + lcol;
            const f32x4 g0 = *(const LAS f32x4*)(gp), g1 = *(const LAS f32x4*)(gp + 4), g2 = *(const LAS f32x4*)(gp + 8), g3 = *(const LAS f32x4*)(gp + 12);
            const f32x4 b0 = *(const LAS f32x4*)(gp + 256), b1 = *(const LAS f32x4*)(gp + 260), b2 = *(const LAS f32x4*)(gp + 264), b3 = *(const LAS f32x4*)(gp + 268);
            const f32x4 h0 = (y0 - mean) * rstd * g0 + b0, h1 = (y1 - mean) * rstd * g1 + b1, h2 = (y2 - mean) * rstd * g2 + b2, h3 = (y3 - mean) * rstd * g3 + b3;
            u32x4 hiA, hiB; hiA.x = cvtpk(h0[0], h0[1]); hiA.y = cvtpk(h0[2], h0[3]); hiA.z = cvtpk(h1[0], h1[1]); hiA.w = cvtpk(h1[2], h1[3]);
            hiB.x = cvtpk(h2[0], h2[1]); hiB.y = cvtpk(h2[2], h2[3]); hiB.z = cvtpk(h3[0], h3[1]); hiB.w = cvtpk(h3[2], h3[3]);
            { LAS unsigned char* sH = stg + r32 * 144 + (p & 1) * 64 + hh * 32; *(LAS u32x4*)(sH) = hiA; *(LAS u32x4*)(sH + 16) = hiB;
              u32x4 q8; q8.x = cvt4_fp8(h0[0], h0[1], h0[2], h0[3]); q8.y = cvt4_fp8(h1[0], h1[1], h1[2], h1[3]); q8.z = cvt4_fp8(h2[0], h2[1], h2[2], h2[3]); q8.w = cvt4_fp8(h3[0], h3[1], h3[2], h3[3]);
              *(LAS u32x4*)(stg + 4608 + r32 * 80 + (p & 1) * 32 + hh * 16) = q8; }
            if (p & 1) {
                LDS_WAIT(); asm volatile("" ::: "memory");
                int ln_ = lane; asm volatile("" : "+v"(ln_));
                const size_t cq = (size_t)cbase + 64 * (p >> 1);
#pragma unroll
                for (int i = 0; i < 4; ++i) { const int id = i * 64 + ln_, rw = id >> 3, c = id & 7; const u32x4 w = *(const LAS u32x4*)(stg + rw * 144 + c * 16);
                    *(u32x4*)((unsigned char*)HB + ((size_t)(grp * 32 + rw) * DM + cq) * 2 + c * 16) = w; }
#pragma unroll
                for (int i = 0; i < 2; ++i) { const int id = i * 64 + ln_, rw = id >> 2, c = id & 3; const u32x4 w = *(const LAS u32x4*)(stg + 4608 + rw * 80 + c * 16);
                    *(u32x4*)((unsigned char*)(ws + WS_HB8) + (size_t)(grp * 32 + rw) * DM + cq + c * 16) = w; }
                asm volatile("" ::: "memory");
            }
            u32x4 loA, loB; loA.x = cvtpk(h0[0] - bflo(hiA.x), h0[1] - bfhi(hiA.x)); loA.y = cvtpk(h0[2] - bflo(hiA.y), h0[3] - bfhi(hiA.y));
            loA.z = cvtpk(h1[0] - bflo(hiA.z), h1[1] - bfhi(hiA.z)); loA.w = cvtpk(h1[2] - bflo(hiA.w), h1[3] - bfhi(hiA.w));
            loB.x = cvtpk(h2[0] - bflo(hiB.x), h2[1] - bfhi(hiB.x)); loB.y = cvtpk(h2[2] - bflo(hiB.y), h2[3] - bfhi(hiB.y));
            loB.z = cvtpk(h3[0] - bflo(hiB.z), h3[1] - bfhi(hiB.z)); loB.w = cvtpk(h3[2] - bflo(hiB.w), h3[3] - bfhi(hiB.w));
            const bf16x8 hiAf = __builtin_bit_cast(bf16x8, hiA), hiBf = __builtin_bit_cast(bf16x8, hiB), loAf = __builtin_bit_cast(bf16x8, loA), loBf = __builtin_bit_cast(bf16x8, loB);
            acc = __builtin_amdgcn_mfma_f32_32x32x16_bf16(whf[2 * p], hiAf, acc, 0, 0, 0);
            acc = __builtin_amdgcn_mfma_f32_32x32x16_bf16(whf[2 * p], loAf, acc, 0, 0, 0);
            acc = __builtin_amdgcn_mfma_f32_32x32x16_bf16(wlf[2 * p], hiAf, acc, 0, 0, 0);
            acc = __builtin_amdgcn_mfma_f32_32x32x16_bf16(whf[2 * p + 1], hiBf, acc, 0, 0, 0);
            acc = __builtin_amdgcn_mfma_f32_32x32x16_bf16(whf[2 * p + 1], loBf, acc, 0, 0, 0);
            acc = __builtin_amdgcn_mfma_f32_32x32x16_bf16(wlf[2 * p + 1], hiBf, acc, 0, 0, 0);
        }
#pragma unroll
        for (int r = 0; r < 16; ++r) part[(wave * 16 + r) * 64 + lane] = acc[r];
        LDS_WAIT(); __syncthreads();
#pragma unroll
        for (int rr = 0; rr < 2; ++rr) { const int r = 2 * wave + rr; float t = 0.f;
#pragma unroll
            for (int w = 0; w < 8; ++w) t += part[(w * 16 + r) * 64 + lane];
            tot[r * 64 + lane] = t; }
        LDS_WAIT(); __syncthreads();
        if (wave == 0) {
            float v[16];
#pragma unroll
            for (int r = 0; r < 16; ++r) v[r] = tot[r * 64 + lane] + rb[(r & 3) + 8 * (r >> 2) + 4 * hh];
            float bv[4]; int bi[4];
#pragma unroll
            for (int k = 0; k < 4; ++k) { float best = -3.0e38f; int br = 0;
#pragma unroll
                for (int r = 0; r < 16; ++r) { const bool gt = v[r] > best; best = gt ? v[r] : best; br = gt ? r : br; }
#pragma unroll
                for (int r = 0; r < 16; ++r) v[r] = (r == br) ? -3.0e38f : v[r];
                bv[k] = best; bi[k] = (br & 3) + 8 * (br >> 2) + 4 * hh; }
            float ov[4]; int oi[4];
#pragma unroll
            for (int k = 0; k < 4; ++k) { ov[k] = __shfl_xor(bv[k], 32); oi[k] = __shfl_xor(bi[k], 32); }
            float tv[4]; int ti[4]; int pa = 0, pb = 0;
#pragma unroll
            for (int k = 0; k < 4; ++k) {
                float av = bv[0], ovv = ov[0]; int ai = bi[0], oii = oi[0];
#pragma unroll
                for (int z = 1; z < 4; ++z) { av = (pa == z) ? bv[z] : av; ai = (pa == z) ? bi[z] : ai; ovv = (pb == z) ? ov[z] : ovv; oii = (pb == z) ? oi[z] : oii; }
                const bool takeA = (av > ovv) || (av == ovv && ai < oii);
                tv[k] = takeA ? av : ovv; ti[k] = takeA ? ai : oii; pa += takeA ? 1 : 0; pb += takeA ? 0 : 1; }
            if (hh == 0) {
                const float e1 = __expf(tv[1] - tv[0]), e2 = __expf(tv[2] - tv[0]), e3 = __expf(tv[3] - tv[0]); const float inv = 1.0f / (1.0f + e1 + e2 + e3);
                const float gt[4] = {inv, e1 * inv, e2 * inv, e3 * inv};
                lcnt[lane] = 0u; LDS_WAIT(); asm volatile("" ::: "memory");
                unsigned lr[4];
#pragma unroll
                for (int k = 0; k < 4; ++k) lr[k] = __hip_atomic_fetch_add(lcnt + ti[k], 1u, __ATOMIC_RELAXED, __HIP_MEMORY_SCOPE_WORKGROUP);
                LDS_WAIT(); asm volatile("" ::: "memory");
                { const unsigned n = lcnt[lane]; unsigned bs = 0u; if (n) bs = __hip_atomic_fetch_add(cnt + 64 * lane, n, __ATOMIC_RELAXED, __HIP_MEMORY_SCOPE_AGENT); lcnt[32 + lane] = bs; }
                LDS_WAIT(); asm volatile("" ::: "memory");
                int ps[4];
#pragma unroll
                for (int k = 0; k < 4; ++k) { ps[k] = (int)(lcnt[32 + ti[k]] + lr[k]); ROWTOK[(size_t)ti[k] * MROWS + ps[k]] = row; }
                *(i32x4*)(TOPE + (size_t)row * 4) = (i32x4){ti[0], ti[1], ti[2], ti[3]};
                *(i32x4*)(TOPP + (size_t)row * 4) = (i32x4){ps[0], ps[1], ps[2], ps[3]};
                *(f32x4*)(TOPG + (size_t)row * 4) = (f32x4){gt[0], gt[1], gt[2], gt[3]};
            }
        }
    }
    __syncthreads();
}

__device__ __forceinline__ void build_tile_table(const unsigned* cnt, LAS int* tstart) {
    const int tid_ = opaque_tid();
    if (tid_ < 64) {
        const int lane = tid_; const int n = (lane < NEXP) ? (int)__hip_atomic_load(cnt + 64 * lane, __ATOMIC_RELAXED, __HIP_MEMORY_SCOPE_AGENT) : 0;
        const int tiles = (n + 255) >> 8; int incl = tiles;
#pragma unroll
        for (int o = 1; o < 64; o <<= 1) { const int v = __shfl_up(incl, o); if (lane >= o) incl += v; }
        if (lane <= NEXP) tstart[lane] = incl - tiles;
        if (lane < NEXP) tstart[64 + lane] = n;
    }
    LDS_WAIT(); __syncthreads();
}

struct CombRow { f32x4 z[8]; };
template <bool last>
__device__ __forceinline__ void phase_combine_ln(const PArgs& a, int layer, const LAS int* tstart, int vcu, int G, bool dummy) {
    const int tid = opaque_tid(), lane = tid & 63, wave = __builtin_amdgcn_readfirstlane(tid >> 6);
    LAS unsigned char* lds_b = (LAS unsigned char*)tstart - TBL_OFF;
    const int gw = vcu * 8 + wave, NGW = G * 8;
    unsigned char* ws = a.ws;
    const bf16_t* HBin = (const bf16_t*)(ws + WS_HB); const unsigned char* YE = (const unsigned char*)(ws + WS_YEXP);
    bf16_t* HB = dummy ? (bf16_t*)(ws + WS_P) : (bf16_t*)(ws + WS_HB);
    unsigned char* H8 = ws + WS_HB8;
    const int* TOPE = (const int*)(ws + WS_TOPE); const int* TOPP = (const int*)(ws + WS_TOPP); const float* TOPG = (const float*)(ws + WS_TOPG);
    const float* g = a.in(I_LNG) + (size_t)(layer * 2 + 1) * DM; const float* bta = a.in(I_LNB) + (size_t)(layer * 2 + 1) * DM;
    float* outp = dummy ? (float*)(ws + WS_Y) : a.out();
    LAS float* gl = (LAS float*)(lds_b);
    { const int tid_ = tid; *(LAS f32x4*)(gl + 4 * tid_) = *(const f32x4*)(g + 4 * tid_); *(LAS f32x4*)(gl + 2048 + 4 * tid_) = *(const f32x4*)(bta + 4 * tid_); }
    LDS_WAIT(); __syncthreads();
#define IDX_LOAD(te_, tp_, tg_, m) do { te_ = *(const i32x4*)(TOPE + (size_t)(m) * 4); tp_ = *(const i32x4*)(TOPP + (size_t)(m) * 4); tg_ = *(const f32x4*)(TOPG + (size_t)(m) * 4); } while (0)
#define RAW_ISSUE(m, te_, tp_) do { \
        const unsigned o0_ = (unsigned)((tstart[te_[0]] * 256 + tp_[0])) , o1_ = (unsigned)((tstart[te_[1]] * 256 + tp_[1])), o2_ = (unsigned)((tstart[te_[2]] * 256 + tp_[2])), o3_ = (unsigned)((tstart[te_[3]] * 256 + tp_[3])); \
        _Pragma("unroll") for (int j = 0; j < 8; ++j) { const int c = 4 * lane + 256 * j; hwv[j] = *(const u32x2*)(HBin + (size_t)(m) * DM + c); \
            wv[j][0] = *(const unsigned*)(YE + (size_t)o0_ * DM + c); wv[j][1] = *(const unsigned*)(YE + (size_t)o1_ * DM + c); wv[j][2] = *(const unsigned*)(YE + (size_t)o2_ * DM + c); wv[j][3] = *(const unsigned*)(YE + (size_t)o3_ * DM + c); } } while (0)
#define COMB_CONVERT(R, tg_) do { _Pragma("unroll") for (int j = 0; j < 8; ++j) { const u32x2 hw_ = hwv[j]; f32x4 v_ = (f32x4){bflo(hw_.x), bfhi(hw_.x), bflo(hw_.y), bfhi(hw_.y)} * DN_ALPHA; \
            const unsigned w0_ = wv[j][0], w1_ = wv[j][1], w2_ = wv[j][2], w3_ = wv[j][3]; \
            const f32x2 a0_ = __builtin_amdgcn_cvt_pk_f32_fp8((int)w0_, false), c0_ = __builtin_amdgcn_cvt_pk_f32_fp8((int)w0_, true), a1_ = __builtin_amdgcn_cvt_pk_f32_fp8((int)w1_, false), c1_ = __builtin_amdgcn_cvt_pk_f32_fp8((int)w1_, true); \
            const f32x2 a2_ = __builtin_amdgcn_cvt_pk_f32_fp8((int)w2_, false), c2_ = __builtin_amdgcn_cvt_pk_f32_fp8((int)w2_, true), a3_ = __builtin_amdgcn_cvt_pk_f32_fp8((int)w3_, false), c3_ = __builtin_amdgcn_cvt_pk_f32_fp8((int)w3_, true); \
            v_[0] += tg_[0] * a0_[0] + tg_[1] * a1_[0] + tg_[2] * a2_[0] + tg_[3] * a3_[0]; \
            v_[1] += tg_[0] * a0_[1] + tg_[1] * a1_[1] + tg_[2] * a2_[1] + tg_[3] * a3_[1]; \
            v_[2] += tg_[0] * c0_[0] + tg_[1] * c1_[0] + tg_[2] * c2_[0] + tg_[3] * c3_[0]; \
            v_[3] += tg_[0] * c0_[1] + tg_[1] * c1_[1] + tg_[2] * c2_[1] + tg_[3] * c3_[1]; \
            (R).z[j] = v_; } } while (0)
#define COMB_FINISH(R, m) do { float s_ = 0.f; _Pragma("unroll") for (int j = 0; j < 8; ++j) s_ += ((R).z[j][0] + (R).z[j][1]) + ((R).z[j][2] + (R).z[j][3]); \
        const float mean_ = wave_sum(s_) * (1.0f / DM); float s2_ = 0.f; \
        _Pragma("unroll") for (int j = 0; j < 8; ++j) { (R).z[j] = (R).z[j] - mean_; s2_ += ((R).z[j][0] * (R).z[j][0] + (R).z[j][1] * (R).z[j][1]) + ((R).z[j][2] * (R).z[j][2] + (R).z[j][3] * (R).z[j][3]); } \
        const float rstd_ = 1.0f / sqrtf(wave_sum(s2_) * (1.0f / DM) + LN_EPS); const int b_ = (m) / NTOK, t_ = (m) % NTOK; \
        _Pragma("unroll") for (int j = 0; j < 8; ++j) { const int c = 4 * lane + 256 * j; \
            const f32x4 o_ = (R).z[j] * rstd_ * *(const LAS f32x4*)(gl + c) + *(const LAS f32x4*)(gl + 2048 + c); \
            if (!last) { u32x2 w_; w_.x = cvtpk(o_[0], o_[1]); w_.y = cvtpk(o_[2], o_[3]); *(u32x2*)(HB + (size_t)(m) * DM + c) = w_; \
                *(unsigned*)(H8 + (size_t)(m) * DM + c) = cvt4_fp8(o_[0], o_[1], o_[2], o_[3]); } \
            else if (t_ >= NMETA && t_ < NMETA + SEQ) *(f32x4*)(outp + ((size_t)b_ * SEQ + (t_ - NMETA)) * DM + c) = o_; } } while (0)
    if (gw < MROWS) {
        i32x4 teA, tpA, teB, tpB; f32x4 tgA, tgB, tgC; u32x2 hwv[8]; unsigned wv[8][4]; CombRow r;
        IDX_LOAD(teA, tpA, tgA, gw);
        RAW_ISSUE(gw, teA, tpA); tgC = tgA;
        { const int m1 = (gw + NGW < MROWS) ? gw + NGW : gw; IDX_LOAD(teB, tpB, tgB, m1); }
        int m = gw;
#define COMB_STEP(teX, tpX, tgX, teY, tpY, tgY) do { const int m1 = (m + NGW < MROWS) ? m + NGW : m, m2 = (m + 2 * NGW < MROWS) ? m + 2 * NGW : m; \
            COMB_CONVERT(r, tgC);                              \
            RAW_ISSUE(m1, teX, tpX); tgC = tgX;                \
            IDX_LOAD(teY, tpY, tgY, m2);                       \
            asm volatile("" ::: "memory"); } while (0)
        COMB_STEP(teB, tpB, tgB, teA, tpA, tgA);
        for (;;) {
            COMB_FINISH(r, m);
            m += NGW; if (m >= MROWS) break;
            COMB_STEP(teA, tpA, tgA, teB, tpB, tgB);
            COMB_FINISH(r, m);
            m += NGW; if (m >= MROWS) break;
            COMB_STEP(teB, tpB, tgB, teA, tpA, tgA);
        }
#undef COMB_STEP
    }
#undef IDX_LOAD
#undef RAW_ISSUE
#undef COMB_CONVERT
#undef COMB_FINISH
}
namespace att {
constexpr int KVBLK = 64;
constexpr int BUF_BYTES = 40960, OFF_KN = 0, OFF_KR = 16384, OFF_V = 24576, OFF_WS = 2 * BUF_BYTES, OFF_FLAG = OFF_WS + 8 * 256;
#define KSWZ(row, colB) ((row) * 256 + ((colB) ^ (((row) & 7) << 4)))
#define KRSWZ(row, colB) ((row) * 128 + ((colB) ^ (((row) & 7) << 4)))
__device__ __forceinline__ int crow(int r, int hi) { return (r & 3) + 8 * (r >> 2) + 4 * hi; }
__device__ __forceinline__ int v_st(int k, int c) { const int kk = (k & ~0xC) | ((k & 4) << 1) | ((k & 8) >> 1); return ((kk >> 3) * 4 + (c >> 5)) * 512 + ((kk & 7) * 32 + (c & 31)) * 2; }
__device__ __forceinline__ int v_rd_base(int lane) { return ((lane & 3) << 3) | (((lane >> 2) & 3) << 6) | (((lane >> 4) & 1) << 5) | (((lane >> 5) & 1) << 8); }
constexpr int v_rd_off(int d0, int ks, int half) { return d0 * 512 + ks * 4096 + half * 2048; }
template <int OFF> __device__ __forceinline__ s16x4 tr_read(int vb) { s16x4 r; asm volatile("ds_read_b64_tr_b16 %0, %1 offset:%2" : "=&v"(r) : "v"(vb), "i"(OFF) : "memory"); return r; }
template <int D0> __device__ __forceinline__ void pv_one(f32x16& od, int vb, bf16x8 pa0, bf16x8 pa1, bf16x8 pa2, bf16x8 pa3) {
    const s16x4 l0 = tr_read<v_rd_off(D0, 0, 0)>(vb), h0 = tr_read<v_rd_off(D0, 0, 1)>(vb), l1 = tr_read<v_rd_off(D0, 1, 0)>(vb), h1 = tr_read<v_rd_off(D0, 1, 1)>(vb);
    const s16x4 l2 = tr_read<v_rd_off(D0, 2, 0)>(vb), h2 = tr_read<v_rd_off(D0, 2, 1)>(vb), l3 = tr_read<v_rd_off(D0, 3, 0)>(vb), h3 = tr_read<v_rd_off(D0, 3, 1)>(vb);
    asm volatile("s_waitcnt lgkmcnt(0)" ::: "memory"); SBAR();
#define PK(L, H) (bf16x8){L[0], L[1], L[2], L[3], H[0], H[1], H[2], H[3]}
    od = __builtin_amdgcn_mfma_f32_32x32x16_bf16(pa0, PK(l0, h0), od, 0, 0, 0);
    od = __builtin_amdgcn_mfma_f32_32x32x16_bf16(pa1, PK(l1, h1), od, 0, 0, 0);
    od = __builtin_amdgcn_mfma_f32_32x32x16_bf16(pa2, PK(l2, h2), od, 0, 0, 0);
    od = __builtin_amdgcn_mfma_f32_32x32x16_bf16(pa3, PK(l3, h3), od, 0, 0, 0);
#undef PK
}
__device__ __forceinline__ void pv_d0(f32x16* o, int vb, bf16x8 pa0, bf16x8 pa1, bf16x8 pa2, bf16x8 pa3) {
    pv_one<0>(o[0], vb, pa0, pa1, pa2, pa3); pv_one<1>(o[1], vb, pa0, pa1, pa2, pa3); pv_one<2>(o[2], vb, pa0, pa1, pa2, pa3); pv_one<3>(o[3], vb, pa0, pa1, pa2, pa3);
}
__device__ __forceinline__ void pack_p(const f32x16& p0, const f32x16& p1, bf16x8& pa0, bf16x8& pa1, bf16x8& pa2, bf16x8& pa3) {
#define PK4(P, BASE, OUT) do { unsigned a0 = cvtpk(P[BASE + 0], P[BASE + 1]), a1 = cvtpk(P[BASE + 2], P[BASE + 3]);   \
    unsigned b0 = cvtpk(P[BASE + 4], P[BASE + 5]), b1 = cvtpk(P[BASE + 6], P[BASE + 7]);                              \
    auto r0 = __builtin_amdgcn_permlane32_swap(a0, b0, false, false); auto r1 = __builtin_amdgcn_permlane32_swap(a1, b1, false, false); \
    u32x4 w = {r0[0], r1[0], r0[1], r1[1]}; OUT = __builtin_bit_cast(bf16x8, w); } while (0)
    PK4(p0, 0, pa0); PK4(p0, 8, pa1); PK4(p1, 0, pa2); PK4(p1, 8, pa3);
#undef PK4
}
__device__ __forceinline__ float xhalf_max(float v) { auto rr = __builtin_amdgcn_permlane32_swap(__float_as_uint(v), __float_as_uint(v), false, false); return fmaxf(__uint_as_float(rr[0]), __uint_as_float(rr[1])); }
__device__ __forceinline__ float xhalf_sum(float v) { auto rr = __builtin_amdgcn_permlane32_swap(__float_as_uint(v), __float_as_uint(v), false, false); return __uint_as_float(rr[0]) + __uint_as_float(rr[1]); }

template <bool MLA>
__device__ __forceinline__ void attn_unit(LAS unsigned char* lds, const bf16_t* __restrict__ Qp, int ldq, const bf16_t* __restrict__ Kn, int ldk, const bf16_t* __restrict__ Kr,
                                          const bf16_t* __restrict__ Vp, int ldv, unsigned char* __restrict__ Op, int ldo, int q0) {
    constexpr int NQ = MLA ? 12 : 8, NQR = 8;
    const int tid = opaque_tid(), wid = __builtin_amdgcn_readfirstlane(tid >> 6), lane = tid & 63, r32 = lane & 31, hi = lane >> 5;
    LAS float* wsl = (LAS float*)(lds + OFF_WS) + wid * 64; LAS float* li_l = wsl; LAS float* al_l = wsl + 32;
    volatile LAS unsigned* flags = (volatile LAS unsigned*)(lds + OFF_FLAG);
    const int t = q0 + wid * 32 + r32;
    const int tq = t < NTOK ? t : NTOK - 1;
    float m_reg = -1e30f, l_reg = 0.f, R = 0.f; f32x16 o[4];
#pragma unroll
    for (int d = 0; d < 4; ++d)
#pragma unroll
        for (int r = 0; r < 16; ++r) o[d][r] = 0.f;
    bf16x8 qr[NQR];
    const bf16_t* Qw = Qp + (size_t)tq * ldq + hi * 8;
#pragma unroll
    for (int d0 = 0; d0 < NQR; ++d0) qr[d0] = *(const bf16x8*)(Qw + d0 * 16);
    const int sr = tid >> 4, sc = (tid & 15) * 8, vst0 = v_st(sr, sc), vst1 = v_st(32 + sr, sc);
    const int krr = tid >> 3, krc = (tid & 7) * 8;
    const int vb0 = (int)(uintptr_t)(lds + OFF_V) + v_rd_base(lane);
    bf16x8 vs0, vs1, ks0, ks1, kr0;
    const unsigned offV0 = (unsigned)(sr * ldv + sc) * 2u, offV1 = (unsigned)((32 + sr) * ldv + sc) * 2u, offK0 = (unsigned)(sr * ldk + sc) * 2u, offK1 = (unsigned)((32 + sr) * ldk + sc) * 2u, offR = (unsigned)(krr * 64 + krc) * 2u;
#define SLOAD(k0) do { const char* vb_ = (const char*)(Vp + (size_t)(k0) * ldv); const char* kb_ = (const char*)(Kn + (size_t)(k0) * ldk); \
    vs0 = *(const bf16x8*)(vb_ + offV0); vs1 = *(const bf16x8*)(vb_ + offV1); ks0 = *(const bf16x8*)(kb_ + offK0); ks1 = *(const bf16x8*)(kb_ + offK1); \
    if (MLA) kr0 = *(const bf16x8*)((const char*)(Kr + (size_t)(k0) * 64) + offR); } while (0)
#define SWRITE(b) do { LAS unsigned char* bb = lds + (b) * BUF_BYTES; *(LAS bf16x8*)(bb + OFF_V + vst0) = vs0; *(LAS bf16x8*)(bb + OFF_V + vst1) = vs1; \
    *(LAS bf16x8*)(bb + OFF_KN + KSWZ(sr, sc * 2)) = ks0; *(LAS bf16x8*)(bb + OFF_KN + KSWZ(32 + sr, sc * 2)) = ks1; \
    if (MLA) *(LAS bf16x8*)(bb + OFF_KR + KRSWZ(krr, krc * 2)) = kr0; } while (0)
    int NT, jfirst, jstep;
    if (MLA) { const int emax = chunk_end(q0 + 255 < NTOK ? q0 + 255 : NTOK - 1); NT = (emax + 63) / 64; if (NT > NTOK / 64) NT = NTOK / 64; jfirst = 0; jstep = 1; }
    else { int jh = (q0 + 255) / 64; if (jh > NTOK / 64 - 1) jh = NTOK / 64 - 1; NT = jh + 1; jfirst = jh; jstep = -1; }
    const int emin = MLA ? chunk_end(q0) : 0;
    const int e_t = chunk_end(tq);
    constexpr float SC = MLA ? 0.072168783648703220f : 0.088388347648318440f;
    constexpr float C = SC * 1.4426950408889634f;
    SLOAD(jfirst * KVBLK); VM_WAIT(); SWRITE(0); LDS_WAIT(); __syncthreads();
    for (int it = 0; it < NT; ++it) {
        const int j = jfirst + it * jstep; const int cb = it & 1;
        const bool more = (it + 1 < NT);
        if (more) SLOAD((j + jstep) * KVBLK);
        SBAR();
        f32x16 p0, p1;
#pragma unroll
        for (int r = 0; r < 16; ++r) { p0[r] = 0.f; p1[r] = 0.f; }
        { const LAS unsigned char* Ks = lds + cb * BUF_BYTES + OFF_KN; const LAS unsigned char* Krs = lds + cb * BUF_BYTES + OFF_KR;
#pragma unroll
          for (int d0 = 0; d0 < NQ; ++d0) {
              bf16x8 b0, b1;
              if (d0 < 8) { const int cbb = (d0 * 16 + hi * 8) * 2; b0 = *(const LAS bf16x8*)(Ks + KSWZ(r32, cbb)); b1 = *(const LAS bf16x8*)(Ks + KSWZ(32 + r32, cbb)); }
              else { const int cbb = ((d0 - 8) * 16 + hi * 8) * 2; b0 = *(const LAS bf16x8*)(Krs + KRSWZ(r32, cbb)); b1 = *(const LAS bf16x8*)(Krs + KRSWZ(32 + r32, cbb)); }
              const bf16x8 qf = (d0 < NQR) ? qr[d0 < NQR ? d0 : 0] : *(const bf16x8*)(Qw + d0 * 16);
              p0 = __builtin_amdgcn_mfma_f32_32x32x16_bf16(b0, qf, p0, 0, 0, 0);
              p1 = __builtin_amdgcn_mfma_f32_32x32x16_bf16(b1, qf, p1, 0, 0, 0); } }
        const int kbase = j * KVBLK;
        if (MLA) {
            if (kbase + KVBLK > emin) {
#pragma unroll
                for (int r = 0; r < 16; ++r) { const int k0 = kbase + crow(r, hi); p0[r] = (k0 < e_t) ? p0[r] : -1e30f; p1[r] = (k0 + 32 < e_t) ? p1[r] : -1e30f; } }
            float pmax = p0[0];
#pragma unroll
            for (int r = 1; r < 16; ++r) pmax = fmaxf(pmax, p0[r]);
#pragma unroll
            for (int r = 0; r < 16; ++r) pmax = fmaxf(pmax, p1[r]);
            pmax = xhalf_max(pmax);
            const float mn = fmaxf(m_reg, pmax); const float alpha = __builtin_amdgcn_exp2f((m_reg - mn) * C); m_reg = mn;
            const float mnC = -mn * C; float ps = 0.f;
#pragma unroll
            for (int r = 0; r < 16; ++r) { p0[r] = __builtin_amdgcn_exp2f(fmaf(p0[r], C, mnC)); p1[r] = __builtin_amdgcn_exp2f(fmaf(p1[r], C, mnC)); ps += p0[r] + p1[r]; }
            ps = xhalf_sum(ps); l_reg = l_reg * alpha + ps;
            if (__any(alpha < 1.f)) { if (hi == 0) al_l[r32] = alpha; LDS_WAIT();
#pragma unroll
                for (int d = 0; d < 4; ++d)
#pragma unroll
                    for (int r = 0; r < 16; ++r) o[d][r] *= al_l[crow(r, hi)]; }
        } else {
#define SB_LK(zz, kk) (((kk) < t) ? -(fmaxf((zz), 0.f) + 0.6931471805599453f * __builtin_amdgcn_logf(1.0f + __builtin_amdgcn_exp2f(-fabsf(zz) * 1.4426950408889634f))) : 0.f)
#pragma unroll
            for (int r = 0; r < 16; ++r) { p0[r] *= SC; p1[r] *= SC; }
            float abv[2][4]; float run = 0.f;
#pragma unroll
            for (int tt = 1; tt >= 0; --tt)
#pragma unroll
                for (int c = 3; c >= 0; --c) {
                    float mine = 0.f;
#pragma unroll
                    for (int i = 0; i < 4; ++i) { const int r = 4 * c + i; const int kk = kbase + 32 * tt + crow(r, hi); mine += SB_LK(tt ? p1[r] : p0[r], kk); }
                    const float other = __shfl_xor(mine, 32);
                    const float g_hi1 = hi ? mine : other, g_hi0 = hi ? other : mine;
                    abv[tt][c] = hi ? run : run + g_hi1;
                    run += g_hi1 + g_hi0; }
#pragma unroll
            for (int tt = 0; tt < 2; ++tt)
#pragma unroll
                for (int c = 0; c < 4; ++c) {
                    float cum = R + abv[tt][c];
#pragma unroll
                    for (int i = 3; i >= 0; --i) { const int r = 4 * c + i; const int kk = kbase + 32 * tt + crow(r, hi);
                        const float z = tt ? p1[r] : p0[r]; cum += SB_LK(z, kk);
                        const float av = (kk < t) ? __builtin_amdgcn_exp2f((z + cum) * 1.4426950408889634f) : 0.f;
                        if (tt) p1[r] = av; else p0[r] = av; } }
#undef SB_LK
            R += run;
        }
        bf16x8 pa0, pa1, pa2, pa3; pack_p(p0, p1, pa0, pa1, pa2, pa3);
        SBAR();
        pv_d0(o, vb0 + cb * BUF_BYTES, pa0, pa1, pa2, pa3);
        if (!MLA) { const bool done = __all((R < -60.f) || (t >= NTOK)); if (lane == 0) flags[(it & 1) * 8 + wid] = done ? 1u : 0u; }
        if (more) { VM_WAIT(); SWRITE(cb ^ 1); }
        LDS_WAIT(); __syncthreads();
        if (!MLA) { unsigned alld = 1u;
#pragma unroll
            for (int w = 0; w < 8; ++w) alld &= flags[(it & 1) * 8 + w];
            if (alld) break; }
    }
    float rli[16];
    if (MLA) { if (hi == 0) li_l[r32] = l_reg; LDS_WAIT();
#pragma unroll
        for (int r = 0; r < 16; ++r) rli[r] = __builtin_amdgcn_rcpf(li_l[crow(r, hi)]); }
    else {
#pragma unroll
        for (int r = 0; r < 16; ++r) rli[r] = 1.f; }
#pragma unroll
    for (int r = 0; r < 16; ++r) { const int orow = q0 + wid * 32 + crow(r, hi);
        if (orow < NTOK) {
#pragma unroll
            for (int d0 = 0; d0 < 4; ++d0) Op[(size_t)orow * ldo + d0 * 32 + r32] = om_fp8(o[d0][r] * rli[r]); } }
    __syncthreads();
#undef SLOAD
#undef SWRITE
}
#undef KSWZ
#undef KRSWZ

__device__ __forceinline__ void phase_attention(const PArgs& a, LAS unsigned char* lds, int layer) {
    unsigned char* ws = a.ws;
    unsigned* qctr = (unsigned*)(ws + WS_CTL) + CW_Q + 64 * layer;
    const bf16_t* P = (const bf16_t*)(ws + WS_P); const bf16_t* QM = (const bf16_t*)(ws + WS_QM); const bf16_t* KN = (const bf16_t*)(ws + WS_KN);
    const bf16_t* KR = (const bf16_t*)(ws + WS_KR); const bf16_t* VM = (const bf16_t*)(ws + WS_VM); unsigned char* OM = ws + WS_OM;
    volatile LAS unsigned* slot = (volatile LAS unsigned*)(lds + OFF_FLAG + 128);
    constexpr int NQB = 33, NU = 16 * NQB;
    for (;;) {
        if (opaque_tid() == 0) slot[0] = __hip_atomic_fetch_add(qctr, 1u, __ATOMIC_RELAXED, __HIP_MEMORY_SCOPE_AGENT);
        LDS_WAIT(); __syncthreads();
        const unsigned u = slot[0];
        __syncthreads();
        if (u >= 2u * NU) break;
        if (u < (unsigned)NU) {
            const int qb = NQB - 1 - (int)(u / 16), bh = (int)(u % 16), b = bh >> 2, h = bh & 3; const size_t r0 = (size_t)b * NTOK;
            attn_unit<true>(lds, QM + r0 * 768 + h * 192, 768, KN + r0 * 512 + h * 128, 512, KR + r0 * 64, VM + r0 * 512 + h * 128, 512, OM + r0 * 1024 + h * 128, 1024, qb * 256);
        } else {
            const int v = (int)u - NU; const int qb = NQB - 1 - v / 16, bh = v % 16, b = bh >> 2, h = bh & 3; const size_t r0 = (size_t)b * NTOK;
            attn_unit<false>(lds, P + r0 * EVP + EC_SBQ + h * 128, EVP, P + r0 * EVP + EC_SBK + h * 128, EVP, nullptr, P + r0 * EVP + EC_SBV + h * 128, EVP, OM + r0 * 1024 + 512 + h * 128, 1024, qb * 256);
        }
    }
}
}
namespace idx {
__device__ __forceinline__ int crow(int r, int hi) { return (r & 3) + 8 * (r >> 2) + 4 * hi; }
constexpr int KCH = 256;
constexpr int NCH = (NTOK + KCH - 1) / KCH;
constexpr int NITEMS = 17680;
constexpr int NQG = MROWS / 32;

constexpr int SPITCH = 136;
__device__ __forceinline__ unsigned short score_key(float f) { unsigned h; asm volatile("v_cvt_f16_f32 %0, %1" : "=v"(h) : "v"(f)); const int m = ((int)(h << 16)) >> 31; return (unsigned short)(h ^ ((unsigned)m | 0x8000u)); }
__device__ __forceinline__ void phase_indexer(const PArgs& a, LAS unsigned char* lds, int vcu, int G) {
    const int tid = opaque_tid(), lane = tid & 63, wave = __builtin_amdgcn_readfirstlane(tid >> 6), r32 = lane & 31, hh = lane >> 5;
    const int gw = vcu * 8 + wave, NGW = G * 8;
    unsigned char* ws = a.ws;
    const bf16_t* P = (const bf16_t*)(ws + WS_P); unsigned short* SCO = (unsigned short*)(ws + WS_BIG);
    LAS float* wtab = (LAS float*)(lds + wave * 16384);
    LAS unsigned char* stg = lds + wave * 16384 + 1024;
    const int lo = (int)((long)gw * NITEMS / NGW), hi = (int)((long)(gw + 1) * NITEMS / NGW);
    int b = lo / 4420, g = 0, ck = lo % 4420;
#pragma unroll 1
    for (;;) { const int ng_ = (g + 2) / 8 + 1; if (ck < ng_) break; ck -= ng_; ++g; }
    for (int item = lo; item < hi; ) {
        const int nchunk = (g + 2) / 8 + 1; const int take = (hi - item < nchunk - ck) ? hi - item : nchunk - ck;
        const int t0 = g * 32;
        const int lmax = chunk_end(t0 + 31) < NTOK ? chunk_end(t0 + 31) : NTOK;
        const int k0 = ck * KCH;
        const int kend = (k0 + take * KCH < lmax) ? k0 + take * KCH : lmax; const int ntile = (kend - k0 + 31) / 32;
        item += take; ck += take;
        const int b_cur = b, g_done = (ck == nchunk);
        if (g_done) { ck = 0; ++g; if (g == NQG / BATCH) { g = 0; ++b; } }
        const size_t qrow = (size_t)b_cur * NTOK + t0 + r32;
        bf16x8 qa[8][4];
#pragma unroll
        for (int h = 0; h < 8; ++h)
#pragma unroll
            for (int s = 0; s < 4; ++s) qa[h][s] = *(const bf16x8*)(P + qrow * ODP + OC_IQ + h * 64 + s * 16 + hh * 8);
        if (hh == 0) { const u32x4 wv = *(const u32x4*)(P + qrow * ODP + OC_IW);
            const float w8[8] = {bflo(wv.x), bfhi(wv.x), bflo(wv.y), bfhi(wv.y), bflo(wv.z), bfhi(wv.z), bflo(wv.w), bfhi(wv.w)};
#pragma unroll
            for (int h = 0; h < 8; ++h) wtab[h * 32 + r32] = w8[h] * 0.044194173824159216f; }
        LDS_WAIT(); asm volatile("" ::: "memory");
        bf16x8 kb[4], kn[4];
        { const size_t krow = (size_t)b_cur * NTOK + k0 + r32;
#pragma unroll
          for (int s = 0; s < 4; ++s) kb[s] = *(const bf16x8*)(P + krow * ODP + OC_IK + s * 16 + hh * 8); }
        for (int tl = 0; tl < ntile; ++tl) {
            asm volatile("" ::: "memory");
            const int key0 = k0 + 32 * tl;
            { const int kx = (tl + 1 < ntile) ? key0 + 32 : key0; const size_t krow = (size_t)b_cur * NTOK + kx + r32;
#pragma unroll
              for (int s = 0; s < 4; ++s) kn[s] = *(const bf16x8*)(P + krow * ODP + OC_IK + s * 16 + hh * 8); }
            float sc[16];
#pragma unroll
            for (int r = 0; r < 16; ++r) sc[r] = 0.f;
#pragma unroll
            for (int h = 0; h < 8; h += 2) {
                f32x16 xa, xb;
#pragma unroll
                for (int r = 0; r < 16; ++r) { xa[r] = 0.f; xb[r] = 0.f; }
#pragma unroll
                for (int s = 0; s < 4; ++s) { xa = __builtin_amdgcn_mfma_f32_32x32x16_bf16(qa[h][s], kb[s], xa, 0, 0, 0);
                    xb = __builtin_amdgcn_mfma_f32_32x32x16_bf16(qa[h + 1][s], kb[s], xb, 0, 0, 0); SBAR(); }
#pragma unroll
                for (int c = 0; c < 4; ++c) { const f32x4 wa4 = *(const LAS f32x4*)(wtab + h * 32 + 8 * c + 4 * hh), wb4 = *(const LAS f32x4*)(wtab + (h + 1) * 32 + 8 * c + 4 * hh);
#pragma unroll
                    for (int i = 0; i < 4; i += 2) {
                        const int a0 = __float_as_int(xa[4 * c + i]), a1 = __float_as_int(xa[4 * c + i + 1]), b0 = __float_as_int(xb[4 * c + i]), b1 = __float_as_int(xb[4 * c + i + 1]);
                        const f32x2 ra = {__int_as_float(a0 > 0 ? a0 : 0), __int_as_float(a1 > 0 ? a1 : 0)}, rb = {__int_as_float(b0 > 0 ? b0 : 0), __int_as_float(b1 > 0 ? b1 : 0)};
                        const f32x2 wa = {wa4[i], wa4[i + 1]}, wb = {wb4[i], wb4[i + 1]}; f32x2 s2 = {sc[4 * c + i], sc[4 * c + i + 1]};
                        s2 = __builtin_elementwise_fma(wa, ra, s2); s2 = __builtin_elementwise_fma(wb, rb, s2); sc[4 * c + i] = s2[0]; sc[4 * c + i + 1] = s2[1]; } }
            }
            { int cb2 = ((tl & 3) * 32 + r32 + 4 * hh * SPITCH) * 2; asm volatile("" : "+v"(cb2));
#pragma unroll
              for (int r = 0; r < 16; ++r) *(LAS unsigned short*)(stg + cb2 + ((r & 3) + 8 * (r >> 2)) * SPITCH * 2) = score_key(sc[r]); }
            if ((tl & 3) == 3 || tl == ntile - 1) {
                const int ncol = 32 * ((tl & 3) + 1);
                char* gbase = (char*)(SCO + ((size_t)b_cur * NTOK + t0) * NTOK + k0 + 128 * (tl >> 2));
                LDS_WAIT(); asm volatile("" ::: "memory");
                int ln = lane; asm volatile("" : "+v"(ln));
                const int c8 = 8 * (ln & 15); const unsigned goff = (unsigned)((ln >> 4) * NTOK + c8) * 2u; const int soff = ((ln >> 4) * SPITCH + c8) * 2;
                if (c8 < ncol) {
#pragma unroll 1
                    for (int i = 0; i < 8; ++i) { const u32x4 pv = *(const LAS u32x4*)(stg + soff + i * 4 * SPITCH * 2); *(u32x4*)(gbase + goff + (size_t)i * 4 * NTOK * 2) = pv; }
                }
                asm volatile("" ::: "memory");
            }
#pragma unroll
            for (int s = 0; s < 4; ++s) kb[s] = kn[s];
        }
        LDS_WAIT(); asm volatile("" ::: "memory");
    }
}

__device__ __forceinline__ int t5_bucket(int rel) {
    const int base = rel > 0 ? 16 : 0; const int n = rel < 0 ? -rel : rel;
    if (n < 8) return base + n;
    int large = 8 + (31 - __builtin_clz((unsigned)(n * n))) - 6; large = large < 15 ? large : 15;
    return base + large;
}
__device__ __forceinline__ unsigned ord_key(float f) { const unsigned u = __float_as_uint(f); return (u & 0x80000000u) ? ~u : (u | 0x80000000u); }

constexpr int VPITCH = 272;
template <int OFF> __device__ __forceinline__ s16x4 tr_read_i(int vb) { s16x4 r; asm volatile("ds_read_b64_tr_b16 %0, %1 offset:%2" : "=&v"(r) : "v"(vb), "i"(OFF) : "memory"); return r; }
__device__ __forceinline__ void pv_chunk(f32x4 (&oc)[8], int vb, bf16x8 pa) {
    s16x4 lo[8], hi[8];
#define PV_RD(d) lo[d] = tr_read_i<(d) * 32>(vb); hi[d] = tr_read_i<(d) * 32 + 16 * VPITCH>(vb)
    PV_RD(0); PV_RD(1); PV_RD(2); PV_RD(3); PV_RD(4); PV_RD(5); PV_RD(6); PV_RD(7);
#undef PV_RD
    asm volatile("s_waitcnt lgkmcnt(0)" ::: "memory"); SBAR();
#pragma unroll
    for (int d = 0; d < 8; ++d) { const bf16x8 vf = {lo[d][0], lo[d][1], lo[d][2], lo[d][3], hi[d][0], hi[d][1], hi[d][2], hi[d][3]};
        oc[d] = __builtin_amdgcn_mfma_f32_16x16x32_bf16(pa, vf, oc[d], 0, 0, 0); }
}
__device__ __forceinline__ void phase_select_attend(const PArgs& a, LAS unsigned char* lds, int vcu, int G) {
    const int tid = opaque_tid(), lane = tid & 63, wave = __builtin_amdgcn_readfirstlane(tid >> 6);
    const int gw = vcu * 8 + wave, NGW = G * 8;
    unsigned char* ws = a.ws;
    const bf16_t* P = (const bf16_t*)(ws + WS_P); const unsigned short* SCO = (const unsigned short*)(ws + WS_BIG); unsigned char* OM = ws + WS_OM;
    LAS unsigned char* wl = lds + wave * 16384;
    LAS unsigned* hist = (LAS unsigned*)wl;
    LAS unsigned long long* cand = (LAS unsigned long long*)wl;
    LAS unsigned* hist2 = (LAS unsigned*)(wl + 8704);
    LAS unsigned long long* cand2 = (LAS unsigned long long*)(wl + 9728);
    LAS int* bkt = (LAS int*)(wl + 13312);
    LAS float* btab = (LAS float*)(wl + 14336);
    LAS int* sel = (LAS int*)(wl + 15360);
    constexpr int CAP = 1024, CAP2 = 448;
    const unsigned long long lt_mask = (1ull << lane) - 1ull;
    const int hn = lane & 15, g4 = lane >> 4;
    const int vwr = (int)(uintptr_t)wl + (g4 * VPITCH + hn * 16);
    const int vrd = (int)(uintptr_t)wl + ((4 * g4 + (hn >> 2)) * VPITCH + (hn & 3) * 8);
    { const f32x4 tv = *(const f32x4*)(a.in(I_REL) + 4 * lane); *(LAS f32x4*)(btab + 4 * lane) = tv; }
    LDS_WAIT(); asm volatile("" ::: "memory");
#define APPEND(flag, list, count, value) do { const unsigned long long b_ = __ballot(flag); if (flag) (list)[(count) + (int)__builtin_popcountll(b_ & lt_mask)] = (value); (count) += (int)__builtin_popcountll(b_); } while (0)
#define RANK_TAKE(lst, n, nd) do { _Pragma("unroll 1") for (int j0_ = 0; j0_ < (n); j0_ += 64) { const int j_ = j0_ + lane; const bool act_ = j_ < (n); \
        const unsigned long long kj_ = act_ ? (lst)[j_] : 0ull; int rank_ = 0; \
        _Pragma("unroll 4") for (int k_ = 0; k_ < (n); ++k_) rank_ += ((lst)[k_] > kj_) ? 1 : 0; \
        const bool take_ = act_ && rank_ < (nd); APPEND(take_, sel, base, (int)(0xFFFFFFFFu - (unsigned)kj_)); } } while (0)
    const bool paired = (G % 8 == 0); const int cpx = paired ? G / 8 : 1;
    const int nwl = paired ? 16 * cpx : NGW; const int wl0 = paired ? ((vcu / cpx) & 1) * 8 * cpx + (vcu % cpx) * 8 + wave : gw;
    const int qend = paired ? NTOK : MROWS;
    for (int qq = wl0; qq < qend; qq += nwl) {
        const int qi = paired ? (vcu / (2 * cpx)) * NTOK + qq : qq;
        const int b = qi / NTOK, t = qi % NTOK; const size_t row = (size_t)b * NTOK + t;
        const int L = chunk_end(t) < NTOK ? chunk_end(t) : NTOK;
        const bf16_t* Pb = P + (size_t)b * NTOK * ODP;
        int nsel;
        if (L <= 256) {
            nsel = L;
#pragma unroll
            for (int i = 0; i < 4; ++i) sel[64 * i + lane] = 64 * i + lane;
        } else {
            nsel = 256;
            const unsigned short* srow = SCO + row * NTOK;
            unsigned zz = 0u; asm volatile("" : "+v"(zz));
            int sh = 16; unsigned pfx = 0u; int need = 256; unsigned cbin = 0u;
#define CHUNK_LOAD(dst, c0_) do { int l8_ = 8 * lane; asm volatile("" : "+v"(l8_)); _Pragma("unroll") for (int k = 0; k < 8; ++k) { const int idx_ = (c0_) + 512 * k + l8_; dst[k] = __builtin_nontemporal_load((const u32x4*)(srow + (idx_ < L ? idx_ : 0))); } } while (0)
#define KEY16(w, c) (((c) & 1) ? ((w)[(c) >> 1] >> 16) : ((w)[(c) >> 1] & 0xffffu))
#pragma unroll 1
            for (;;) {
                const int nb = sh >= 11 ? 11 : sh; const int nsh = sh - nb; const unsigned dmask = (1u << nb) - 1u; const bool first = (sh == 16); const unsigned pv0 = first ? 0u : (pfx >> sh);
#pragma unroll 1
                for (int i = 0; i < 8; ++i) *(LAS u32x4*)(wl + i * 1024 + lane * 16) = (u32x4){zz, zz, zz, zz};
                u32x4 v[8];
                LDS_WAIT(); asm volatile("" ::: "memory");
#pragma unroll 1
                for (int c0 = 0; c0 < L; c0 += 4096) {
                    CHUNK_LOAD(v, c0);
                    int l8 = 8 * lane; asm volatile("" : "+v"(l8));
#pragma unroll
                    for (int k = 0; k < 8; ++k) { const bool ok = (c0 + 512 * k + l8) < L;
#pragma unroll
                        for (int c = 0; c < 8; ++c) { const unsigned u = KEY16(v[k], c); const bool match = ok && (first || ((u >> sh) == pv0));
                            if (match) __hip_atomic_fetch_add(hist + ((u >> nsh) & dmask), 1u, __ATOMIC_RELAXED, __HIP_MEMORY_SCOPE_WORKGROUP); } }
                }
                LDS_WAIT(); asm volatile("" ::: "memory");
                unsigned loc = 0u;
#pragma unroll
                for (int i = 0; i < 8; ++i) { const u32x4 h4 = *(const LAS u32x4*)(hist + 32 * lane + 4 * i); loc += (h4.x + h4.y) + (h4.z + h4.w); }
                unsigned above = loc;
#pragma unroll
                for (int o = 1; o < 64; o <<= 1) { const unsigned vv = __shfl_down(above, o); if (lane + o < 64) above += vv; }
                const unsigned excl = above - loc;
                const bool mine = (excl < (unsigned)need) && ((unsigned)need <= above);
                const unsigned long long bal = __ballot(mine);
                const int owner = (int)__builtin_ctzll(bal ? bal : 1ull);
                unsigned run = excl; int bsel = 0; unsigned abv = excl, cb = 0u; bool found = false;
#pragma unroll 1
                for (int i = 7; i >= 0; --i) { const u32x4 h4 = *(const LAS u32x4*)(hist + 32 * lane + 4 * i); const unsigned hv[4] = {h4.x, h4.y, h4.z, h4.w};
#pragma unroll
                    for (int k = 3; k >= 0; --k) { const unsigned nr = run + hv[k]; const bool hit = !found && (nr >= (unsigned)need); bsel = hit ? 4 * i + k : bsel; abv = hit ? run : abv; cb = hit ? hv[k] : cb; found = found || hit; run = nr; } }
                const unsigned bin = (unsigned)__shfl(32 * lane + bsel, owner); const unsigned abv_b = (unsigned)__shfl((int)abv, owner); cbin = (unsigned)__shfl((int)cb, owner);
                pfx |= bin << nsh; need -= (int)abv_b; sh = nsh;
                if (cbin <= (unsigned)CAP || sh == 0) break;
            }
            const bool alleq = (sh == 0) && (cbin > (unsigned)CAP);
            const unsigned pv = pfx >> sh;
            int base = 0, ccount = 0;
            if (!alleq) {
                { u32x4 v[8];
#pragma unroll 1
                for (int c0 = 0; c0 < L; c0 += 4096) {
                    CHUNK_LOAD(v, c0);
                    int l8 = 8 * lane; asm volatile("" : "+v"(l8));
#pragma unroll
                    for (int k = 0; k < 8; ++k) { const int idx = c0 + 512 * k + l8; const bool ok = idx < L;
#pragma unroll
                        for (int c = 0; c < 8; ++c) { const unsigned u = KEY16(v[k], c); const unsigned hi = u >> sh;
                            const bool sure = ok && hi > pv, isc = ok && hi == pv;
                            const unsigned long long bt = __ballot(sure), bc = __ballot(isc);
                            if (bt | bc) {
                                if (sure) sel[base + (int)__builtin_popcountll(bt & lt_mask)] = idx + c;
                                if (isc) cand[ccount + (int)__builtin_popcountll(bc & lt_mask)] = ((unsigned long long)u << 32) | (unsigned long long)(0xFFFFFFFFu - (unsigned)(idx + c));
                                base += (int)__builtin_popcountll(bt); ccount += (int)__builtin_popcountll(bc); } } }
                } }
                LDS_WAIT(); asm volatile("" ::: "memory");
                bool done = false;
                if (sh >= 8 && ccount > 64) {
                    *(LAS u32x4*)(hist2 + 4 * lane) = (u32x4){zz, zz, zz, zz};
                    LDS_WAIT(); asm volatile("" ::: "memory");
                    const int s2 = 32 + sh - 8;
#pragma unroll 1
                    for (int j0 = 0; j0 < ccount; j0 += 64) { const int j = j0 + lane; if (j < ccount) __hip_atomic_fetch_add(hist2 + (unsigned)((cand[j] >> s2) & 255ull), 1u, __ATOMIC_RELAXED, __HIP_MEMORY_SCOPE_WORKGROUP); }
                    LDS_WAIT(); asm volatile("" ::: "memory");
                    const u32x4 h4 = *(const LAS u32x4*)(hist2 + 4 * lane); const unsigned loc2 = (h4.x + h4.y) + (h4.z + h4.w);
                    unsigned ab2 = loc2;
#pragma unroll
                    for (int o = 1; o < 64; o <<= 1) { const unsigned vv = __shfl_down(ab2, o); if (lane + o < 64) ab2 += vv; }
                    const unsigned ex2 = ab2 - loc2; const bool mine2 = (ex2 < (unsigned)need) && ((unsigned)need <= ab2);
                    const unsigned long long bal2 = __ballot(mine2); const int own2 = (int)__builtin_ctzll(bal2 ? bal2 : 1ull);
                    unsigned run2 = ex2; int bs2 = 0; unsigned av2 = ex2, cb2 = 0u; bool f2 = false; const unsigned hv2[4] = {h4.x, h4.y, h4.z, h4.w};
#pragma unroll
                    for (int k = 3; k >= 0; --k) { const unsigned nr = run2 + hv2[k]; const bool hit = !f2 && (nr >= (unsigned)need); bs2 = hit ? k : bs2; av2 = hit ? run2 : av2; cb2 = hit ? hv2[k] : cb2; f2 = f2 || hit; run2 = nr; }
                    const unsigned bin2 = (unsigned)__shfl(4 * lane + bs2, own2); const unsigned abv2 = (unsigned)__shfl((int)av2, own2); const unsigned cnt2 = (unsigned)__shfl((int)cb2, own2);
                    if (cnt2 <= (unsigned)CAP2) {
                        int c2 = 0;
#pragma unroll 1
                        for (int j0 = 0; j0 < ccount; j0 += 64) { const int j = j0 + lane; const bool act = j < ccount; const unsigned long long kj = act ? cand[j] : 0ull;
                            const unsigned sub = (unsigned)((kj >> s2) & 255ull); const bool sure2 = act && sub > bin2, isc2 = act && sub == bin2;
                            APPEND(sure2, sel, base, (int)(0xFFFFFFFFu - (unsigned)kj));
                            APPEND(isc2, cand2, c2, kj); }
                        LDS_WAIT(); asm volatile("" ::: "memory");
                        const int need2 = need - (int)abv2;
                        RANK_TAKE(cand2, c2, need2);
                        done = true;
                    }
                }
                if (!done) RANK_TAKE(cand, ccount, need);
            } else {
#pragma unroll 2
                for (int i0 = 0; i0 < L; i0 += 64) { const int s = i0 + lane; const bool valid = s < L;
                    const unsigned u = valid ? (unsigned)srow[s < L ? s : L - 1] : 0u;
                    const bool sure = valid && u > pv, isc = valid && u == pv;
                    const unsigned long long bc = __ballot(isc); const int crank = ccount + (int)__builtin_popcountll(bc & lt_mask);
                    const bool take = sure || (isc && crank < need);
                    ccount += (int)__builtin_popcountll(bc);
                    APPEND(take, sel, base, s); }
            }
#undef CHUNK_LOAD
#undef KEY16
        }
        LDS_WAIT(); asm volatile("" ::: "memory");
#pragma unroll
        for (int i = 0; i < 4; ++i) { const int jj = 64 * i + lane; bkt[jj] = t5_bucket(((jj < nsel) ? sel[jj] : t) - t) * 8; }
        bf16x8 qb[4];
#pragma unroll
        for (int kk = 0; kk < 4; ++kk) { bf16x8 z = {0, 0, 0, 0, 0, 0, 0, 0}; qb[kk] = (hn < 8) ? *(const bf16x8*)(P + row * ODP + OC_Q + hn * 128 + kk * 32 + g4 * 8) : z; }
        f32x4 sa[16];
#pragma unroll
        for (int tb = 0; tb < 4; ++tb) {
            bf16x8 ka[4][4]; int hno = hn; asm volatile("" : "+v"(hno));
#pragma unroll
            for (int u = 0; u < 4; ++u) { const int jj = 16 * (4 * tb + u) + hno; const int key = (jj < nsel) ? sel[jj] : 0; const unsigned koff = (unsigned)(key * ODP + OC_K + g4 * 8) * 2u;
#pragma unroll
                for (int kk = 0; kk < 4; ++kk) ka[u][kk] = *(const bf16x8*)((const char*)Pb + koff + kk * 64); }
#pragma unroll
            for (int u = 0; u < 4; ++u) { f32x4 acc = {0.f, 0.f, 0.f, 0.f};
#pragma unroll
                for (int kk = 0; kk < 4; ++kk) acc = __builtin_amdgcn_mfma_f32_16x16x32_bf16(ka[u][kk], qb[kk], acc, 0, 0, 0);
                sa[4 * tb + u] = acc; }
            asm volatile("" ::: "memory");
        }
        bf16x8 vr0[8], vr1[8];
#define V_LOAD(dst, c) do { int g4o_ = g4; asm volatile("" : "+v"(g4o_)); _Pragma("unroll") for (int i_ = 0; i_ < 8; ++i_) { const int jj_ = 32 * (c) + g4o_ + 4 * i_; const int key_ = (jj_ < nsel) ? sel[jj_] : 0; \
            dst[i_] = *(const bf16x8*)((const char*)Pb + (unsigned)(key_ * ODP + OC_V + hn * 8) * 2u); } } while (0)
#define V_WRITE(src) do { _Pragma("unroll") for (int i_ = 0; i_ < 8; ++i_) *(LAS bf16x8*)(uintptr_t)(vwr + 4 * i_ * VPITCH) = src[i_]; } while (0)
        V_LOAD(vr0, 0); V_LOAD(vr1, 1);
        float mx = -1e30f; int g4b = 4 * g4; asm volatile("" : "+v"(g4b));
#pragma unroll
        for (int tl = 0; tl < 16; ++tl) { const i32x4 b4 = *(const LAS i32x4*)(bkt + 16 * tl + 4 * g4); const int bb[4] = {b4.x, b4.y, b4.z, b4.w};
#pragma unroll
            for (int i = 0; i < 4; ++i) { const int jj = 16 * tl + g4b + i; const bool ok = jj < nsel;
                const float bias = btab[bb[i] + (hn & 7)];
                const float s = ok ? sa[tl][i] * 0.088388347648318440f + bias : -1e30f; sa[tl][i] = s; mx = fmaxf(mx, s); } }
        mx = fmaxf(mx, __shfl_xor(mx, 16)); mx = fmaxf(mx, __shfl_xor(mx, 32));
        float sum = 0.f;
#pragma unroll
        for (int tl = 0; tl < 16; ++tl)
#pragma unroll
            for (int i = 0; i < 4; ++i) { const float p = __builtin_amdgcn_exp2f((sa[tl][i] - mx) * 1.4426950408889634f); sa[tl][i] = p; sum += p; }
        sum += __shfl_xor(sum, 16); sum += __shfl_xor(sum, 32);
        const float rs = 1.0f / sum;
        f32x4 oc[8];
#pragma unroll
        for (int d = 0; d < 8; ++d) oc[d] = (f32x4){0.f, 0.f, 0.f, 0.f};
#define PV_CHUNK(c, cur) do { \
            if ((c) + 1 < 8) asm volatile("s_waitcnt vmcnt(8)" ::: "memory"); else asm volatile("s_waitcnt vmcnt(0)" ::: "memory"); \
            V_WRITE(cur); if ((c) + 2 < 8) V_LOAD(cur, (c) + 2); \
            const f32x4 pa_ = sa[2 * (c)] * rs, pb_ = sa[2 * (c) + 1] * rs; \
            u32x4 pw; pw.x = cvtpk(pa_[0], pa_[1]); pw.y = cvtpk(pa_[2], pa_[3]); pw.z = cvtpk(pb_[0], pb_[1]); pw.w = cvtpk(pb_[2], pb_[3]); \
            const bf16x8 pf = __builtin_bit_cast(bf16x8, pw); \
            LDS_WAIT(); asm volatile("" ::: "memory"); \
            pv_chunk(oc, vrd, pf); } while (0)
        PV_CHUNK(0, vr0); PV_CHUNK(1, vr1); PV_CHUNK(2, vr0); PV_CHUNK(3, vr1); PV_CHUNK(4, vr0); PV_CHUNK(5, vr1); PV_CHUNK(6, vr0); PV_CHUNK(7, vr1);
#undef PV_CHUNK
#undef V_LOAD
#undef V_WRITE
        if (g4 < 2) {
#pragma unroll
            for (int dt = 0; dt < 8; ++dt)
#pragma unroll
                for (int i = 0; i < 4; ++i) OM[row * 1024 + (4 * g4 + i) * 128 + 16 * dt + hn] = om_fp8(oc[dt][i]);
        }
        LDS_WAIT(); asm volatile("" ::: "memory");
    }
#undef APPEND
#undef RANK_TAKE
}
}
typedef __attribute__((address_space(1))) unsigned char gu8_t;
#define PH_ARGS const KArgs& ka, unsigned lds_off
#define PH_SETUP PArgs a{ka, opaque_ws(ka.ws)}; LAS unsigned char* lds = (LAS unsigned char*)(uintptr_t)lds_off; unsigned char* ws = a.ws; (void)ws; (void)lds; \
    int G_ = gridDim.x, bx_ = blockIdx.x; asm volatile("" : "+s"(G_), "+s"(bx_)); const int G = G_, bx = bx_; const int vcu = (G % 8 == 0) ? (bx % 8) * (G / 8) + bx / 8 : bx; (void)vcu

__device__ __forceinline__ void ph_prologue(PH_ARGS) { PH_SETUP; phase_prologue(a, lds, vcu, G); }
__device__ __forceinline__ void ph_inproj(PH_ARGS, int layer) { PH_SETUP;
    const int jl = layer >> 1; const bool even = (layer & 1) == 0; const int N = even ? EVP : ODP;
    const bf16_t* Bt = even ? (const bf16_t*)(ws + WS_WINE + jl * SZ_WINE) : (const bf16_t*)(ws + WS_WINO + jl * SZ_WINO);
    pg8::DenseOrder S; S.init(MROWS, N, G, bx);
    pg8::EpiBf16 E{(bf16_t*)(ws + WS_P), N, 1.0f / FP8_WSCALE};
    pg8::gemm_phase<pg8::EpiBf16, pg8::DenseOrder, true>(lds, (const bf16_t*)(ws + WS_HB8), DM / 2, Bt, DM / 2, S, E);
}
__device__ __forceinline__ void ph_latent(PH_ARGS, int jl) { PH_SETUP; phase_latent_norm(a, jl, vcu, G); }
__device__ __forceinline__ void ph_upq(PH_ARGS, int jl) { PH_SETUP;
    pg8::DenseOrder S; S.init(MROWS, 768, G, bx);
    pg8::EpiQ E{(bf16_t*)(ws + WS_QM), (const float*)(ws + WS_ROPE)};
    pg8::gemm_phase<pg8::EpiQ, pg8::DenseOrder>(lds, (const bf16_t*)(ws + WS_QN), 512, (const bf16_t*)(ws + WS_WUQ + jl * SZ_WUQ), 512, S, E);
}
__device__ __forceinline__ void ph_upkv(PH_ARGS, int jl) { PH_SETUP;
    pg8::DenseOrder S; S.init(MROWS, 1024, G, bx);
    pg8::EpiKV E{(bf16_t*)(ws + WS_KN), (bf16_t*)(ws + WS_VM)};
    pg8::gemm_phase<pg8::EpiKV, pg8::DenseOrder>(lds, (const bf16_t*)(ws + WS_KVN), 256, (const bf16_t*)(ws + WS_WUKV + jl * SZ_WUKV), 256, S, E);
}
__device__ __forceinline__ void ph_attn(PH_ARGS, int layer) { PH_SETUP; att::phase_attention(a, lds, layer); }
__device__ __forceinline__ void ph_indexer(PH_ARGS) { PH_SETUP; idx::phase_indexer(a, lds, vcu, G); }
__device__ __forceinline__ void ph_select(PH_ARGS) { PH_SETUP; idx::phase_select_attend(a, lds, vcu, G); }
__device__ __forceinline__ void ph_outproj(PH_ARGS, int layer) { PH_SETUP;
    const int jl = layer >> 1; const bool even = (layer & 1) == 0;
    const bf16_t* Bt = even ? (const bf16_t*)(ws + WS_WOUTE + jl * SZ_WOUT) : (const bf16_t*)(ws + WS_WOUTO + jl * SZ_WOUT);
    pg8::DenseOrder S; S.init(MROWS, DM, G, bx);
    pg8::EpiOut E{(const bf16_t*)(ws + WS_HB), (bf16_t*)(ws + WS_Y), (float*)(ws + WS_STAT)};
    pg8::gemm_phase<pg8::EpiOut, pg8::DenseOrder, true>(lds, (const bf16_t*)(ws + WS_OM), 1024 / 2, Bt, 1024 / 2, S, E);
}
__device__ __forceinline__ void ph_lnroute(PH_ARGS, int layer, int cslot) { PH_SETUP; phase_ln_route(a, layer, cslot, lds, vcu, G); }
__device__ __forceinline__ void ph_expert_up(PH_ARGS, int layer) { PH_SETUP;
    const unsigned* cnt = (const unsigned*)(ws + WS_CTL) + CW_CNT + 2048 * layer; LAS int* tstart = (LAS int*)(lds + TBL_OFF);
    build_tile_table(cnt, tstart);
    pg8::MoeOrder S{tstart, cnt, (const int*)(ws + WS_ROWTOK), 4, G, vcu, true, false};
    pg8::EpiSwiglu E{(bf16_t*)(ws + WS_ACT), a.in(I_EBIN) + (size_t)layer * NEXP * 1024};
    pg8::gemm_phase<pg8::EpiSwiglu, pg8::MoeOrder, true>(lds, (const bf16_t*)(ws + WS_HB8), DM / 2, (const bf16_t*)(ws + WS_WEI + (size_t)layer * NEXP * SZ_WEI), DM / 2, S, E);
}
__device__ __forceinline__ void ph_expert_down(PH_ARGS, int layer) { PH_SETUP;
    const unsigned* cnt = (const unsigned*)(ws + WS_CTL) + CW_CNT + 2048 * layer; LAS int* tstart = (LAS int*)(lds + TBL_OFF);
    pg8::MoeOrder S{tstart, cnt, (const int*)(ws + WS_ROWTOK), 8, G, vcu, false, false};
    pg8::EpiDown E{(unsigned char*)(ws + WS_YEXP), a.in(I_EBOUT) + (size_t)layer * NEXP * DM};
    pg8::gemm_phase<pg8::EpiDown, pg8::MoeOrder, true>(lds, (const bf16_t*)(ws + WS_ACT), DFF / 2, (const bf16_t*)(ws + WS_WEO + (size_t)layer * NEXP * SZ_WEO), DFF / 2, S, E);
}
__device__ __forceinline__ void ph_combine(PH_ARGS, int layer, bool dummy) { PH_SETUP;
    if (layer == DEPTH - 1) phase_combine_ln<true>(a, layer, (const LAS int*)(lds + TBL_OFF), vcu, G, dummy); else phase_combine_ln<false>(a, layer, (const LAS int*)(lds + TBL_OFF), vcu, G, dummy); }

__global__ void __launch_bounds__(512, 2) mk_fwd(KArgs a) {
    extern __shared__ __attribute__((aligned(16))) unsigned char lds_raw[];
    LAS unsigned char* lds = (LAS unsigned char*)lds_raw;
    const int tid = threadIdx.x;
    for (int u = tid; u < (LDS_BYTES - LDS_CTL) / 4; u += 512) ((LAS unsigned*)(lds + LDS_CTL))[u] = 0u;
    __syncthreads();
    const unsigned lo = (unsigned)(uintptr_t)lds;
    gu32_t* barw = (gu32_t*)(a.ws + WS_CTL) + CW_BAR; const unsigned st_off = lo + MISC_OFF + 32;
    const unsigned xcc = xcd_barrier_post((unsigned*)barw, (volatile LAS unsigned*)(uintptr_t)st_off).x;
#define GRID_BAR() xcd_barrier(barw, xcc, st_off)

    ph_prologue(a, lo);
    GRID_BAR();
#pragma unroll 1
    for (int layer = 0; layer < DEPTH; ++layer) {
        const int jl = layer >> 1; const bool even = (layer & 1) == 0;
        ph_inproj(a, lo, layer);
        GRID_BAR();
        if (even) {
            ph_latent(a, lo, jl);
            GRID_BAR();
            ph_upq(a, lo, jl);
            ph_upkv(a, lo, jl);
            GRID_BAR();
            ph_attn(a, lo, layer);
            GRID_BAR();
        } else {
            ph_indexer(a, lo);
            GRID_BAR();
            ph_select(a, lo);
            GRID_BAR();
        }
        ph_outproj(a, lo, layer);
        GRID_BAR();
        ph_lnroute(a, lo, layer, layer);
        GRID_BAR();
        ph_expert_up(a, lo, layer);
        GRID_BAR();
        ph_expert_down(a, lo, layer);
        GRID_BAR();
        ph_combine(a, lo, layer, false);
        if (layer + 1 < DEPTH) GRID_BAR();
    }
}

extern "C" void kernel_launch(void* const* d_in, const int* in_sizes, int n_in, void* d_out, int out_size, void* d_ws, size_t ws_size, hipStream_t stream) {
    static int grid = 0;
    if (grid == 0) {
        if (n_in != 19 || ws_size < WS_END) { fprintf(stderr, "kernel_launch: n_in %d (want 19), ws %zu (need %zu)\n", n_in, ws_size, (size_t)WS_END); grid = -1; return; }
        int dev = 0, cus = 0, per_cu = 0;
        if (hipGetDevice(&dev) != hipSuccess || hipDeviceGetAttribute(&cus, hipDeviceAttributeMultiprocessorCount, dev) != hipSuccess) { grid = -1; return; }
        if (hipFuncSetAttribute((const void*)mk_fwd, hipFuncAttributeMaxDynamicSharedMemorySize, LDS_BYTES) != hipSuccess) { fprintf(stderr, "kernel_launch: hipFuncSetAttribute failed\n"); grid = -1; return; }
        if (hipOccupancyMaxActiveBlocksPerMultiprocessor(&per_cu, (const void*)mk_fwd, 512, LDS_BYTES) != hipSuccess || per_cu < 1)
            fprintf(stderr, "kernel_launch: occupancy query reports %d workgroups per CU\n", per_cu);
        (void)hipGetLastError();
        grid = cus > 0 ? cus : 256;
    }
    if (grid < 0) return;
    if (hipMemsetAsync((char*)d_ws + WS_CTL, 0, CTL_BYTES, stream) != hipSuccess) return;
    KArgs a{};
    for (int i = 0; i < 19; ++i) a.in[i] = (const float*)d_in[i];
    a.out = (float*)d_out; a.ws = (unsigned char*)d_ws;
    hipLaunchKernelGGL(mk_fwd, dim3(grid), dim3(512), LDS_BYTES, stream, a);
    (void)hipPeekAtLastError();
}
```

```cpp
#include <hip/hip_runtime.h>
#include <cstdio>
#include <cstdint>

#define LAS __attribute__((address_space(3)))
typedef unsigned short bf16_t;
typedef short bf16x8 __attribute__((ext_vector_type(8)));
typedef short s16x4 __attribute__((ext_vector_type(4)));
typedef float f32x2 __attribute__((ext_vector_type(2)));
typedef float f32x4 __attribute__((ext_vector_type(4)));
typedef float f32x16 __attribute__((ext_vector_type(16)));
typedef unsigned u32x2 __attribute__((ext_vector_type(2)));
typedef unsigned u32x4 __attribute__((ext_vector_type(4)));
typedef int i32x4 __attribute__((ext_vector_type(4)));

constexpr int BATCH = 4, NTOK = 8320, MROWS = BATCH * NTOK, DM = 2048, SEQ = 8192, NMETA = 16, DEPTH = 4;
constexpr int NEXP = 32, DFF = 512;
constexpr float DN_ALPHA = 1.6817928305074290f;
constexpr float LN_EPS = 1e-5f, RMS_EPS = 1e-6f;
constexpr int EVP = 2560;
constexpr int ODP = 2048;
constexpr int MAXSLOT = MROWS * 4 + NEXP * 256;
constexpr int EC_QLAT = 0, EC_KVLAT = 512, EC_SBQ = 768, EC_SBK = 1280, EC_SBV = 1792, EC_KROPE = 2304;
constexpr int OC_Q = 0, OC_K = 1024, OC_V = 1152, OC_IQ = 1280, OC_IK = 1792, OC_IW = 1856;

constexpr size_t MiB = 1u << 20;
constexpr size_t alignup(size_t x) { return (x + 4095) & ~(size_t)4095; }
constexpr size_t WS_CTL = 0, CTL_BYTES = 1 * MiB;
constexpr size_t SZ_WINE = (size_t)EVP * DM * 2, SZ_WUQ = 768 * 512 * 2, SZ_WUKV = 1024 * 256 * 2, SZ_WOUT = (size_t)DM * 1024 * 2, SZ_WINO = (size_t)ODP * DM * 2;
constexpr size_t SZ_WEI = (size_t)1024 * DM, SZ_WEO = (size_t)DM * DFF  , SZ_WR = (size_t)32 * DM * 2;
constexpr size_t WS_WINE = WS_CTL + CTL_BYTES;
constexpr size_t WS_WUQ = WS_WINE + 2 * SZ_WINE;
constexpr size_t WS_WUKV = WS_WUQ + 2 * SZ_WUQ;
constexpr size_t WS_WOUTE = WS_WUKV + 2 * SZ_WUKV;
constexpr size_t WS_WINO = WS_WOUTE + 2 * SZ_WOUT;
constexpr size_t WS_WOUTO = WS_WINO + 2 * SZ_WINO;
constexpr size_t WS_WEI = WS_WOUTO + 2 * SZ_WOUT;
constexpr size_t WS_WEO = WS_WEI + (size_t)DEPTH * NEXP * SZ_WEI;
constexpr size_t WS_WRH = WS_WEO + (size_t)DEPTH * NEXP * SZ_WEO;
constexpr size_t WS_WRL = WS_WRH + DEPTH * SZ_WR;
constexpr size_t WS_ROPE = WS_WRL + DEPTH * SZ_WR;
constexpr size_t WS_H = alignup(WS_ROPE + (size_t)NTOK * 64 * 4);
constexpr size_t WS_HB8 = WS_H;
constexpr size_t WS_HB = WS_H + (size_t)MROWS * DM * 4;
constexpr size_t WS_Y = WS_HB + (size_t)MROWS * DM * 2;
constexpr size_t WS_STAT = WS_Y + (size_t)MROWS * DM * 4;
constexpr size_t WS_P = WS_STAT + (size_t)MROWS * 64 * 4;
constexpr size_t WS_QN = WS_P + (size_t)MROWS * EVP * 2;
constexpr size_t WS_KVN = WS_QN + (size_t)MROWS * 512 * 2;
constexpr size_t WS_QM = WS_KVN + (size_t)MROWS * 256 * 2;
constexpr size_t WS_KN = WS_QM + (size_t)MROWS * 768 * 2;
constexpr size_t WS_VM = WS_KN + (size_t)MROWS * 512 * 2;
constexpr size_t WS_KR = WS_VM + (size_t)MROWS * 512 * 2;
constexpr size_t WS_OM = WS_KR + (size_t)MROWS * 64 * 2;
constexpr size_t WS_TOPE = WS_OM + (size_t)MROWS * 1024 * 2;
constexpr size_t WS_TOPP = WS_TOPE + (size_t)MROWS * 16;
constexpr size_t WS_TOPG = WS_TOPP + (size_t)MROWS * 16;
constexpr size_t WS_ROWTOK = WS_TOPG + (size_t)MROWS * 16;
constexpr size_t WS_BIG = alignup(WS_ROWTOK + (size_t)NEXP * MROWS * 4);
constexpr size_t SZ_SCORES = (size_t)BATCH * NTOK * NTOK * 4;
constexpr size_t WS_ACT = WS_BIG, WS_YEXP = WS_BIG + alignup((size_t)MAXSLOT * DFF * 2);
constexpr size_t WS_END = WS_BIG + SZ_SCORES;
static_assert(WS_YEXP + (size_t)MAXSLOT * DM * 2 <= WS_END, "alias region");
constexpr size_t WS_ARGTAB = 512 * 1024;
constexpr int CW_BAR = 4096, CW_CNT = 16384  , CW_Q = 32768  , CW_ERR = 65536;

constexpr int LDS_BYTES = 147456, LDS_CTL = 131072, MISC_OFF = LDS_CTL + 320, TBL_OFF = LDS_CTL + 1024;

#define LDS_WAIT() asm volatile("s_waitcnt lgkmcnt(0)" ::: "memory")
#define VM_WAIT() asm volatile("s_waitcnt vmcnt(0)" ::: "memory")
#define SBAR() __builtin_amdgcn_sched_barrier(0)

__device__ __forceinline__ unsigned cvtpk(float lo, float hi) { unsigned r; asm volatile("v_cvt_pk_bf16_f32 %0, %1, %2" : "=v"(r) : "v"(lo), "v"(hi)); return r; }
typedef int i32x8 __attribute__((ext_vector_type(8)));
__device__ __forceinline__ unsigned cvt4_fp8(float a, float b, float c, float d) { int w = __builtin_amdgcn_cvt_pk_fp8_f32(a, b, 0, false); w = __builtin_amdgcn_cvt_pk_fp8_f32(c, d, w, true); return (unsigned)w; }
constexpr float OM_SCALE = 64.0f;
__device__ __forceinline__ unsigned char om_fp8(float v) { v = fminf(fmaxf(v * OM_SCALE, -448.0f), 448.0f); return (unsigned char)(__builtin_amdgcn_cvt_pk_fp8_f32(v, v, 0, false) & 0xff); }
constexpr float FP8_WSCALE = 32.0f;
__device__ __forceinline__ float bf2f(unsigned short b) { return __uint_as_float(((unsigned)b) << 16); }
__device__ __forceinline__ float bflo(unsigned w) { return __uint_as_float(w << 16); }
__device__ __forceinline__ float bfhi(unsigned w) { return __uint_as_float(w & 0xffff0000u); }
__device__ __forceinline__ float wave_sum(float v) {
#pragma unroll
    for (int o = 1; o < 64; o <<= 1) v += __shfl_xor(v, o);
    return v;
}
typedef __attribute__((address_space(1))) unsigned char gu8_t;
__device__ __forceinline__ int opaque_tid() { int t = (int)threadIdx.x; asm volatile("" : "+v"(t)); return t; }
__device__ __forceinline__ unsigned char* opaque_ws(unsigned char* p) { size_t z = 0; asm volatile("" : "+s"(z)); return p + z; }
__device__ __forceinline__ int chunk_end(int t) { return t < NMETA ? NMETA : NMETA + 64 * ((t - NMETA) / 64 + 1); }

#define XB_TMO      128
#define XB_XCNT(j)  (256  + 64 * (j))
#define XB_XSUB(j)  (1280 + 64 * (j))
#define XB_XGEN(j)  (2304 + 64 * (j))
#define XB_TOP      3328
#define XB_TOPGEN   3392
#define XCD_BAR_WORDS 3456
#define XB_SPIN_CAP (1u << 18)
__device__ __forceinline__ unsigned xb_ld(unsigned* p)              { return __hip_atomic_load(p, __ATOMIC_RELAXED, __HIP_MEMORY_SCOPE_AGENT); }
__device__ __forceinline__ unsigned xb_add(unsigned* p, unsigned v) { return __hip_atomic_fetch_add(p, v, __ATOMIC_RELAXED, __HIP_MEMORY_SCOPE_AGENT); }
__device__ __forceinline__ unsigned xb_xcc_id() { return (unsigned)__builtin_amdgcn_s_getreg((3 << 11) | 20) & 0xFu; }
#define XB_SPIN(cond, bar) do { unsigned _sp = 0; while (cond) { __builtin_amdgcn_s_sleep(1); \
    if ((++_sp & 255u) == 0u) { if (xb_ld(&(bar)[XB_TMO])) break; if (_sp > XB_SPIN_CAP) { atomicAdd(&(bar)[XB_TMO], 1u); break; } } } } while (0)
struct XcdBarrier { unsigned* bar; unsigned x; volatile LAS unsigned* st; };
__device__ __forceinline__ XcdBarrier xcd_barrier_post(unsigned* bar, volatile LAS unsigned* st) {
    XcdBarrier b; b.bar = bar; b.x = xb_xcc_id(); b.st = st;
    if (threadIdx.x == 0) (void)xb_add(&bar[XB_XCNT(b.x)], 1u);
    return b;
}
__device__ __forceinline__ void xcd_barrier_complete(unsigned* bar, unsigned x, unsigned& nloc, unsigned& nx) {
    const unsigned G = gridDim.x * gridDim.y * gridDim.z;
    unsigned sum, cnt, mine, sp = 0u;
    for (;;) {
        sum = 0u; cnt = 0u; mine = 0u;
#pragma unroll
        for (unsigned j = 0; j < 16; ++j) { const unsigned c = xb_ld(&bar[XB_XCNT(j)]); sum += c; cnt += (c > 0u) ? 1u : 0u; mine = (j == x) ? c : mine; }
        if (sum == G) break;
        __builtin_amdgcn_s_sleep(1);
        if ((++sp & 255u) == 0u) { if (xb_ld(&bar[XB_TMO])) break; if (sp > XB_SPIN_CAP) { atomicAdd(&bar[XB_TMO], 1u); break; } }
    }
    nloc = mine > 0u ? mine : 1u; nx = cnt > 0u ? cnt : 1u;
}
typedef __attribute__((address_space(1))) unsigned gu32_t;
__device__ __forceinline__ void xcd_barrier_body(const XcdBarrier& b) {
    asm volatile("s_waitcnt vmcnt(0)" ::: "memory");
    __syncthreads();
    if (opaque_tid() == 0) {
        size_t z_ = 0; asm volatile("" : "+s"(z_));
        unsigned* bar = b.bar + z_; unsigned bxx = b.x; asm volatile("" : "+s"(bxx));
        __builtin_amdgcn_s_waitcnt(0);
        unsigned nloc = b.st[0], nx = b.st[1];
        if (nloc == 0u) { xcd_barrier_complete(bar, bxx, nloc, nx); b.st[0] = nloc; b.st[1] = nx; }
        const unsigned old = xb_add(&bar[XB_XSUB(bxx)], 1u);
        const unsigned gen = old / nloc;
        if (old + 1u == (gen + 1u) * nloc) {
            __builtin_amdgcn_fence(__ATOMIC_RELEASE, "agent");
            asm volatile("s_waitcnt vmcnt(0)" ::: "memory");
            const unsigned og = xb_add(&bar[XB_TOP], 1u);
            const unsigned tg = og / nx;
            if (og + 1u == (tg + 1u) * nx) xb_add(&bar[XB_TOPGEN], 1u);
            else XB_SPIN(xb_ld(&bar[XB_TOPGEN]) == tg, bar);
            __builtin_amdgcn_fence(__ATOMIC_ACQUIRE, "agent");
            xb_add(&bar[XB_XGEN(bxx)], 1u);
            asm volatile("s_waitcnt vmcnt(0)" ::: "memory");
        } else {
            XB_SPIN(xb_ld(&bar[XB_XGEN(bxx)]) == gen, bar);
            __builtin_amdgcn_fence(__ATOMIC_ACQUIRE, "agent");
            asm volatile("s_waitcnt vmcnt(0)" ::: "memory");
        }
    }
    __syncthreads();
}

__device__ __forceinline__ void xcd_barrier(gu32_t* barg, unsigned x, unsigned st_off) {
    XcdBarrier b; b.bar = (unsigned*)barg; b.x = x; b.st = (volatile LAS unsigned*)(uintptr_t)st_off;
    xcd_barrier_body(b);
}

namespace pg8 {
constexpr int BM = 256, BK = 64, HALF = 128, HTB = HALF * BK * 2, STAGE_BYTES = 8 * HTB, NXCD = 8, WGM = 8;
__device__ __forceinline__ int lds_byte(int r, int c) { const int st = (r >> 4) * 2 + (c >> 5), rr = r & 15, cc = c & 31, ob = rr * 64 + cc * 2; return st * 1024 + (ob ^ (((ob >> 9) & 1) << 5)); }
__device__ __forceinline__ void stage_rc(int b, int& R, int& C) { const int st = b / 1024, sb = b % 1024, swz = sb ^ (((sb >> 9) & 1) << 5); R = (st >> 1) * 16 + swz / 64; C = (st & 1) * 32 + (swz % 64) / 2; }
__device__ __forceinline__ int perm16(int R) { return (R >> 5) * 64 + ((R >> 2) & 3) * 16 + ((R >> 4) & 1) * 4 + (R & 3); }
__device__ __forceinline__ int perm32(int rho) { const int n = rho >> 4, i = rho & 15; return 8 * (i >> 2) + 4 * n + (i & 3); }
struct Unit { int pm, pn, pb, e, j, half; };

struct DenseOrder {
    int nM, nN, nwg, G, c;
    __device__ __forceinline__ void init(int M, int N, int G_, int c_) { nM = M / BM; nN = N / BM; nwg = nM * nN; G = G_; c = c_; }
    __device__ __forceinline__ bool next(int i, Unit& u) const {
        const long L = (long)i * G + c; if (L >= nwg) return false;
        int wgid = (int)L; { const int q = nwg / NXCD, r = nwg % NXCD, xcd = wgid % NXCD, off = wgid / NXCD; wgid = (xcd < r ? xcd * (q + 1) : r * (q + 1) + (xcd - r) * q) + off; }
        const int nig = WGM * nN, gid = wgid / nig, fm = gid * WGM, gsz = (nM - fm) < WGM ? (nM - fm) : WGM;
        u.pm = fm + ((wgid % nig) % gsz); u.pn = (wgid % nig) / gsz; u.pb = u.pn; u.e = 0; u.j = 0; u.half = 0; return true;
    }
    __device__ __forceinline__ int arow(const Unit& u, int r) const { return u.pm * BM + r; }
    __device__ __forceinline__ void arow4(const Unit& u, const int (&r)[4], int (&o)[4]) const { for (int q = 0; q < 4; ++q) o[q] = u.pm * BM + r[q]; }
    __device__ __forceinline__ void arow4_issue(const Unit&, const int (&)[4], int (&)[4]) const {}
    __device__ __forceinline__ int arow4_fin(const Unit& u, int r, int) const { return u.pm * BM + r; }
};

template <class Epi, class Sched, bool FP8 = false>
__device__ __forceinline__ void gemm_phase(LAS unsigned char* lds, const bf16_t* Ag, int lda, const bf16_t* Btg, int K, const Sched& S, const Epi& E) {
    const int tid = opaque_tid(), wid = __builtin_amdgcn_readfirstlane(tid >> 6), lane = tid & 63, wr = wid >> 2, wc = wid & 3, fr = lane & 15, fq = lane >> 4;
    const int nt = K / BK;
    unsigned voffB[2];
#pragma unroll
    for (int i = 0; i < 2; ++i) { int R, C; stage_rc(tid * 16 + i * 8192, R, C); const int Rb = (int)Epi::PERM == 2 ? perm16(R) : Epi::PERM ? ((R & ~31) + perm32(R & 31)) : R; voffB[i] = (unsigned)(Rb * K + C) * 2u; }
    const size_t kstep = (size_t)(BK * 2);
    const size_t tstep = (size_t)2 * HALF * K * 2;
    const size_t hstep = (size_t)((int)Epi::PERM == 2 ? 8 : HALF) * K * 2;
    const unsigned ldsw = (unsigned)wid * 1024u;
    const int aoff = lds_byte(wr * 64 + fr, fq * 8), boff = lds_byte(wc * 32 + fr, fq * 8);
#define PG8_SA(b, h) (((b) * 2 + (h)) * HTB)
#define PG8_SB(b, h) ((4 + (b) * 2 + (h)) * HTB)
#define PG8_STAGE(bufoff, gbase, voff) do { _Pragma("unroll") for (int _i = 0; _i < 2; ++_i) \
        __builtin_amdgcn_global_load_lds((const unsigned*)((const char*)(gbase) + (voff)[_i]), (LAS unsigned*)(lds + (bufoff) + ldsw + _i * 8192), 16, 0, 0); } while (0)
#define PG8_LDA(dst, b, h) do { _Pragma("unroll") for (int m = 0; m < 4; ++m) _Pragma("unroll") for (int k = 0; k < 2; ++k) dst[m][k] = *(const LAS bf16x8*)(lds + PG8_SA(b, h) + aoff + m * 2048 + k * 1024); } while (0)
#define PG8_LDB(dst, b, h) do { _Pragma("unroll") for (int n = 0; n < 2; ++n) _Pragma("unroll") for (int k = 0; k < 2; ++k) dst[n][k] = *(const LAS bf16x8*)(lds + PG8_SB(b, h) + boff + n * 2048 + k * 1024); } while (0)
#define PG8_MMA(ai, bj, At, Bt) do { __builtin_amdgcn_s_setprio(1); _Pragma("unroll") for (int m = 0; m < 4; ++m) _Pragma("unroll") for (int n = 0; n < 2; ++n) { \
        if constexpr (FP8) { const i32x4 a0_ = __builtin_bit_cast(i32x4, At[m][0]), a1_ = __builtin_bit_cast(i32x4, At[m][1]), b0_ = __builtin_bit_cast(i32x4, Bt[n][0]), b1_ = __builtin_bit_cast(i32x4, Bt[n][1]); \
            const i32x8 a8_ = __builtin_shufflevector(a0_, a1_, 0, 1, 2, 3, 4, 5, 6, 7), b8_ = __builtin_shufflevector(b0_, b1_, 0, 1, 2, 3, 4, 5, 6, 7); \
            acc[ai][bj][m][n] = __builtin_amdgcn_mfma_scale_f32_16x16x128_f8f6f4(b8_, a8_, acc[ai][bj][m][n], 0, 0, 0, sc1_, 0, sc1_); } \
        else { _Pragma("unroll") for (int k = 0; k < 2; ++k) acc[ai][bj][m][n] = __builtin_amdgcn_mfma_f32_16x16x32_bf16(Bt[n][k], At[m][k], acc[ai][bj][m][n], 0, 0, 0); } } \
        __builtin_amdgcn_s_setprio(0); } while (0)
#define PG8_WAIT_V(n) asm volatile("s_waitcnt vmcnt(" #n ")" ::: "memory")
#define PG8_WAIT_L(n) asm volatile("s_waitcnt lgkmcnt(" #n ")" ::: "memory")
#define PG8_BAR __builtin_amdgcn_s_barrier()
#define PG8_SCHED __builtin_amdgcn_sched_barrier(0)
#define PG8_AOFF(dst, u) do { int _t = tid; asm volatile("" : "+v"(_t)); int _rw[4], _cc[4]; _Pragma("unroll") for (int _h = 0; _h < 2; ++_h) _Pragma("unroll") for (int _i = 0; _i < 2; ++_i) { int _R, _C; stage_rc(_t * 16 + _i * 8192, _R, _C); \
        _rw[_h * 2 + _i] = _h * HALF + _R; _cc[_h * 2 + _i] = _C; } \
        int _ar[4]; S.arow4(u, _rw, _ar);                                        \
        _Pragma("unroll") for (int _q = 0; _q < 4; ++_q) dst[_q >> 1][_q & 1] = (unsigned)(_ar[_q] * lda + _cc[_q]) * 2u; } while (0)
#define PG8_AOFF_ISSUE(raw, u) do { int _t = tid; asm volatile("" : "+v"(_t)); int _rw[4]; _Pragma("unroll") for (int _h = 0; _h < 2; ++_h) _Pragma("unroll") for (int _i = 0; _i < 2; ++_i) { int _R, _C; stage_rc(_t * 16 + _i * 8192, _R, _C); _rw[_h * 2 + _i] = _h * HALF + _R; } \
        S.arow4_issue(u, _rw, raw); } while (0)
#define PG8_AOFF_FIN(dst, raw, u) do { int _t = tid; asm volatile("" : "+v"(_t)); _Pragma("unroll") for (int _h = 0; _h < 2; ++_h) _Pragma("unroll") for (int _i = 0; _i < 2; ++_i) { int _R, _C; stage_rc(_t * 16 + _i * 8192, _R, _C); \
        dst[_h][_i] = (unsigned)(S.arow4_fin(u, _h * HALF + _R, raw[_h * 2 + _i]) * lda + _C) * 2u; } } while (0)
    Unit cur, nxt; int ui = 0; cur.e = 0;
    if (!S.next(0, cur)) return;
    f32x4 acc[2][2][4][2];
    int sc1_ = 0x7f7f7f7f; float z0_ = 0.f; asm volatile("" : "+v"(sc1_), "+v"(z0_));
    (void)sc1_;
#pragma unroll
    for (int a = 0; a < 2; ++a)
#pragma unroll
        for (int b = 0; b < 2; ++b)
#pragma unroll
            for (int m = 0; m < 4; ++m)
#pragma unroll
                for (int n = 0; n < 2; ++n) acc[a][b][m][n] = (f32x4){z0_, z0_, z0_, z0_};
    bf16x8 At[4][2], B0[2][2], B1[2][2];
    unsigned vA[2][2];
    PG8_AOFF(vA, cur);
    const char* cA = (const char*)Ag;
    const char* cB = (const char*)Btg + (size_t)cur.pb * tstep;
    PG8_STAGE(PG8_SB(0, 0), cB, voffB); PG8_STAGE(PG8_SB(0, 1), cB + hstep, voffB); PG8_STAGE(PG8_SA(0, 0), cA, vA[0]); PG8_STAGE(PG8_SA(0, 1), cA, vA[1]);
    if (wr == 1) PG8_BAR;
    PG8_WAIT_V(2); PG8_BAR;
    PG8_STAGE(PG8_SB(1, 0), cB + kstep, voffB); PG8_STAGE(PG8_SA(1, 0), cA + kstep, vA[0]); PG8_STAGE(PG8_SB(1, 1), cB + hstep + kstep, voffB);
    PG8_WAIT_V(6); PG8_BAR;
    for (;;) {
        nxt.e = cur.e;
        const bool has_next = S.next(ui + 1, nxt);
        const char* nB = has_next ? (const char*)Btg + (size_t)nxt.pb * tstep : cB;
        int rawn[4] = {0, 0, 0, 0}; if (has_next) PG8_AOFF_ISSUE(rawn, nxt);
#pragma unroll 1
        for (int t = 0; t < nt; t += 2) {
            const bool last = (t == nt - 2);
            const char* a1 = cA + (size_t)(t + 1) * kstep;
            const char* a2 = last ? cA : cA + (size_t)(t + 2) * kstep; const char* b2 = last ? nB : cB + (size_t)(t + 2) * kstep;
            const char* a3 = a2 + kstep; const char* b3 = b2 + kstep;
            PG8_LDB(B0, 0, 0); PG8_LDB(B1, 0, 1); PG8_SCHED; PG8_LDA(At, 0, 0); PG8_STAGE(PG8_SA(1, 1), a1, vA[1]);
            if (last && has_next) { PG8_AOFF_FIN(vA, rawn, nxt); }
            PG8_WAIT_V(8); PG8_WAIT_L(0); PG8_BAR; PG8_MMA(0, 0, At, B0); PG8_MMA(0, 1, At, B1); PG8_BAR; PG8_SCHED;
            PG8_LDA(At, 0, 1); PG8_STAGE(PG8_SB(0, 0), b2, voffB); PG8_STAGE(PG8_SB(0, 1), b2 + hstep, voffB); PG8_STAGE(PG8_SA(0, 0), a2, vA[0]);
            PG8_WAIT_V(8); PG8_WAIT_L(0); PG8_BAR; PG8_MMA(1, 0, At, B0); PG8_MMA(1, 1, At, B1); PG8_BAR; PG8_SCHED;
            PG8_LDB(B0, 1, 0); PG8_LDB(B1, 1, 1); PG8_SCHED; PG8_LDA(At, 1, 0); PG8_STAGE(PG8_SA(0, 1), a2, vA[1]);
            PG8_WAIT_V(8); PG8_WAIT_L(0); PG8_BAR; PG8_MMA(0, 0, At, B0); PG8_MMA(0, 1, At, B1); PG8_BAR; PG8_SCHED;
            PG8_LDA(At, 1, 1); PG8_STAGE(PG8_SB(1, 0), b3, voffB); PG8_STAGE(PG8_SB(1, 1), b3 + hstep, voffB); PG8_STAGE(PG8_SA(1, 0), a3, vA[0]);
            PG8_WAIT_V(8); PG8_WAIT_L(0); PG8_BAR; PG8_MMA(1, 0, At, B0); PG8_MMA(1, 1, At, B1); PG8_BAR; PG8_SCHED;
        }
        if (wr == 0) PG8_BAR;
        { const int l_ = opaque_tid() & 63; E(acc, cur, wr, wc, l_ & 15, l_ >> 4); }
        if (!has_next) break;
#pragma unroll
        for (int a = 0; a < 2; ++a)
#pragma unroll
            for (int b = 0; b < 2; ++b)
#pragma unroll
                for (int m = 0; m < 4; ++m)
#pragma unroll
                    for (int n = 0; n < 2; ++n) acc[a][b][m][n] = (f32x4){z0_, z0_, z0_, z0_};
        cur = nxt; cB = nB; ++ui;
        if (wr == 1) PG8_BAR;
    }
    PG8_WAIT_V(0);
    PG8_BAR;
#undef PG8_SA
#undef PG8_SB
#undef PG8_STAGE
#undef PG8_LDA
#undef PG8_LDB
#undef PG8_MMA
#undef PG8_WAIT_V
#undef PG8_WAIT_L
#undef PG8_BAR
#undef PG8_SCHED
#undef PG8_AOFF
#undef PG8_AOFF_ISSUE
#undef PG8_AOFF_FIN
}
}
namespace pg8 {
#define ST16(base, boff, v) (*(u32x4*)((char*)(base) + (boff)) = (v))
#define PACK8(v0, v1) ({ u32x4 w_; w_.x = cvtpk((v0)[0], (v0)[1]); w_.y = cvtpk((v0)[2], (v0)[3]); w_.z = cvtpk((v1)[0], (v1)[1]); w_.w = cvtpk((v1)[2], (v1)[3]); w_; })
struct EpiBf16 {
    static constexpr bool PERM = true;
    bf16_t* O; int ldc; float sc;
    __device__ __forceinline__ void operator()(const f32x4 (&acc)[2][2][4][2], const Unit& u, int wr, int wc, int fr, int fq) const {
        const unsigned o0 = (unsigned)((u.pm * BM + wr * 64 + fr) * ldc + u.pn * BM + wc * 32 + 8 * fq) * 2u;
#pragma unroll
        for (int ai = 0; ai < 2; ++ai)
#pragma unroll
            for (int m = 0; m < 4; ++m) { const unsigned ro = o0 + (unsigned)((ai * HALF + m * 16) * ldc) * 2u;
#pragma unroll
                for (int bj = 0; bj < 2; ++bj) ST16(O, ro + bj * HALF * 2, PACK8(acc[ai][bj][m][0] * sc, acc[ai][bj][m][1] * sc)); }
    }
};
struct EpiQ {
    static constexpr bool PERM = true;
    bf16_t* QM; const float* rope;
    __device__ __forceinline__ void operator()(const f32x4 (&acc)[2][2][4][2], const Unit& u, int wr, int wc, int fr, int fq) const {
        const int row0 = u.pm * BM + wr * 64 + fr;
        if (u.pn < 2) {
            const unsigned o0 = (unsigned)(row0 * 768 + 2 * u.pn * 192 + wc * 32 + 8 * fq) * 2u;
#pragma unroll
            for (int ai = 0; ai < 2; ++ai)
#pragma unroll
                for (int m = 0; m < 4; ++m) { const unsigned ro = o0 + (unsigned)((ai * HALF + m * 16) * 768) * 2u;
#pragma unroll
                    for (int bj = 0; bj < 2; ++bj) ST16(QM, ro + bj * 192 * 2, PACK8(acc[ai][bj][m][0], acc[ai][bj][m][1])); }
        } else {
            const int g8 = 4 * (wc & 1) + fq;
            const unsigned o0 = (unsigned)(row0 * 768 + (wc >> 1) * 192 + 128 + 4 * g8) * 2u;
#pragma unroll
            for (int ai = 0; ai < 2; ++ai) {
                f32x4 csa[4], csb[4];
#pragma unroll
                for (int m = 0; m < 4; ++m) { const int t_ = (row0 + ai * HALF + m * 16) % NTOK; const unsigned co_ = (unsigned)(t_ * 32 + 4 * g8) * 8u;
                    csa[m] = *(const f32x4*)((const char*)rope + co_); csb[m] = *(const f32x4*)((const char*)rope + co_ + 16); }
                asm volatile("" ::: "memory");
#pragma unroll
                for (int m = 0; m < 4; ++m) {
                    const f32x4 cs0 = csa[m], cs1 = csb[m];
                    const float c[4] = {cs0[0], cs0[2], cs1[0], cs1[2]}, s[4] = {cs0[1], cs0[3], cs1[1], cs1[3]};
                    const unsigned ro = o0 + (unsigned)((ai * HALF + m * 16) * 768) * 2u;
#pragma unroll
                    for (int bj = 0; bj < 2; ++bj) { const f32x4 x1 = acc[ai][bj][m][0], x2 = acc[ai][bj][m][1];
                        float o1[4], o2[4];
#pragma unroll
                        for (int i = 0; i < 4; ++i) { o1[i] = x1[i] * c[i] - x2[i] * s[i]; o2[i] = x1[i] * s[i] + x2[i] * c[i]; }
                        u32x2 w1, w2; w1.x = cvtpk(o1[0], o1[1]); w1.y = cvtpk(o1[2], o1[3]); w2.x = cvtpk(o2[0], o2[1]); w2.y = cvtpk(o2[2], o2[3]);
                        *(u32x2*)((char*)QM + ro + bj * 2 * 192 * 2) = w1; *(u32x2*)((char*)QM + ro + bj * 2 * 192 * 2 + 64) = w2; }
                    asm volatile("" ::: "memory"); }
            }
        }
    }
};
struct EpiKV {
    static constexpr bool PERM = true;
    bf16_t* KN; bf16_t* VM;
    __device__ __forceinline__ void operator()(const f32x4 (&acc)[2][2][4][2], const Unit& u, int wr, int wc, int fr, int fq) const {
        const unsigned o0 = (unsigned)((u.pm * BM + wr * 64 + fr) * 512 + u.pn * 128 + wc * 32 + 8 * fq) * 2u;
#pragma unroll
        for (int ai = 0; ai < 2; ++ai)
#pragma unroll
            for (int m = 0; m < 4; ++m) { const unsigned ro = o0 + (unsigned)((ai * HALF + m * 16) * 512) * 2u;
                ST16(KN, ro, PACK8(acc[ai][0][m][0], acc[ai][0][m][1])); ST16(VM, ro, PACK8(acc[ai][1][m][0], acc[ai][1][m][1])); }
    }
};
struct EpiOut {
    static constexpr bool PERM = false;
    const bf16_t* HB; bf16_t* Y; float* STAT;
    __device__ __forceinline__ void operator()(const f32x4 (&acc)[2][2][4][2], const Unit& u, int wr, int wc, int fr, int fq) const {
        const int row0 = u.pm * BM + wr * 64 + fr, col0 = u.pn * BM + wc * 32 + 4 * fq;
#pragma unroll
        for (int ai = 0; ai < 2; ++ai) {
            u32x2 hres[4][2][2];
#pragma unroll
            for (int m = 0; m < 4; ++m) { const unsigned off = (unsigned)((row0 + ai * HALF + m * 16) * DM + col0) * 4u;
#pragma unroll
                for (int bj = 0; bj < 2; ++bj)
#pragma unroll
                    for (int n = 0; n < 2; ++n) hres[m][bj][n] = *(const u32x2*)((const char*)HB + ((off + (bj * HALF + n * 16) * 4) >> 1)); }
            asm volatile("" ::: "memory");
#pragma unroll
            for (int m = 0; m < 4; ++m) { const int row = row0 + ai * HALF + m * 16; float s = 0.f, q = 0.f;
                const unsigned yb = (unsigned)((((row >> 5) * 128 + (col0 >> 4)) * 32 + (row & 31)) * 16 + (col0 & 15)) * 2u;
#pragma unroll
                for (int bj = 0; bj < 2; ++bj)
#pragma unroll
                    for (int n = 0; n < 2; ++n) { const u32x2 hw = hres[m][bj][n]; const f32x4 hv = {bflo(hw.x), bfhi(hw.x), bflo(hw.y), bfhi(hw.y)}; const f32x4 y = acc[ai][bj][m][n] * (1.0f / (FP8_WSCALE * OM_SCALE)) + hv * DN_ALPHA;
                        { u32x2 yw; yw.x = cvtpk(y[0], y[1]); yw.y = cvtpk(y[2], y[3]); *(u32x2*)((char*)Y + yb + (unsigned)(((bj * HALF + n * 16) >> 4) * 32 * 16) * 2u) = yw; } s += (y[0] + y[1]) + (y[2] + y[3]); q += (y[0] * y[0] + y[1] * y[1]) + (y[2] * y[2] + y[3] * y[3]); }
                s += __shfl_xor(s, 16); s += __shfl_xor(s, 32); q += __shfl_xor(q, 16); q += __shfl_xor(q, 32);
                if (fq == 0) *(f32x2*)((char*)STAT + (unsigned)(row * 32 + u.pn * 4 + wc) * 8u) = (f32x2){s, q}; }
        }
    }
};
struct EpiSwiglu {
    static constexpr bool PERM = true;
    bf16_t* ACT; const float* b_in;
    __device__ __forceinline__ void operator()(const f32x4 (&acc)[2][2][4][2], const Unit& u, int wr, int wc, int fr, int fq) const {
        const int col = u.pn * 128 + wc * 32 + 8 * fq;
        const unsigned o0 = (unsigned)((u.pm * BM + wr * 64 + fr) * DFF + col);
        const float* bg = b_in + (size_t)u.e * 1024 + col; const float* bu = bg + 512;
        const f32x4 bg0 = *(const f32x4*)bg, bg1 = *(const f32x4*)(bg + 4), bu0 = *(const f32x4*)bu, bu1 = *(const f32x4*)(bu + 4);
#pragma unroll
        for (int ai = 0; ai < 2; ++ai)
#pragma unroll
            for (int m = 0; m < 4; ++m) { float a[8];
#pragma unroll
                for (int n = 0; n < 2; ++n) { const f32x4 g4 = acc[ai][0][m][n] * (1.0f / FP8_WSCALE) + (n ? bg1 : bg0), u4 = acc[ai][1][m][n] * (1.0f / FP8_WSCALE) + (n ? bu1 : bu0);
#pragma unroll
                    for (int i = 0; i < 4; ++i) { const float g = fminf(g4[i], 7.0f), up = fminf(fmaxf(u4[i], -7.0f), 7.0f);
                        const float sg = __builtin_amdgcn_rcpf(1.0f + __builtin_amdgcn_exp2f(-1.702f * 1.4426950408889634f * g));
                        a[4 * n + i] = g * sg * (up + 1.0f); } }
                u32x2 w; w.x = cvt4_fp8(a[0], a[1], a[2], a[3]); w.y = cvt4_fp8(a[4], a[5], a[6], a[7]);
                *(u32x2*)((char*)ACT + o0 + (unsigned)((ai * HALF + m * 16) * DFF)) = w;
                asm volatile("" ::: "memory"); }
    }
};
struct EpiDown {
    static constexpr int PERM = 2;
    unsigned char* YE; const float* b_out;
    __device__ __forceinline__ void operator()(const f32x4 (&acc)[2][2][4][2], const Unit& u, int wr, int wc, int fr, int fq) const {
        const int col0 = u.pn * BM + wc * 64 + 16 * fq;
        const unsigned o0 = (unsigned)((u.pm * BM + wr * 64 + fr) * DM + col0);
        const unsigned bo = (unsigned)(u.e * DM + col0) * 4u;
        f32x4 bb[2][2];
#pragma unroll
        for (int bj = 0; bj < 2; ++bj)
#pragma unroll
            for (int n = 0; n < 2; ++n) bb[bj][n] = *(const f32x4*)((const char*)b_out + bo + (bj * 8 + n * 4) * 4);
#pragma unroll
        for (int ai = 0; ai < 2; ++ai)
#pragma unroll
            for (int m = 0; m < 4; ++m) { u32x4 w;
                { const f32x4 v = acc[ai][0][m][0] * (1.0f / FP8_WSCALE) + bb[0][0]; w.x = cvt4_fp8(v[0], v[1], v[2], v[3]); }
                { const f32x4 v = acc[ai][0][m][1] * (1.0f / FP8_WSCALE) + bb[0][1]; w.y = cvt4_fp8(v[0], v[1], v[2], v[3]); }
                { const f32x4 v = acc[ai][1][m][0] * (1.0f / FP8_WSCALE) + bb[1][0]; w.z = cvt4_fp8(v[0], v[1], v[2], v[3]); }
                { const f32x4 v = acc[ai][1][m][1] * (1.0f / FP8_WSCALE) + bb[1][1]; w.w = cvt4_fp8(v[0], v[1], v[2], v[3]); }
                *(u32x4*)(YE + o0 + (unsigned)((ai * HALF + m * 16) * DM)) = w; }
    }
};
struct MoeOrder {
    const LAS int* tstart; const unsigned* cnt; const int* rowtok; int nN, G, c; bool gather; bool runs;
    __device__ __forceinline__ bool next(int i, Unit& u) const {
        const int total = tstart[NEXP];
        const int per = (total * nN + G - 1) / G;
        const long L = runs ? (long)c * per + i : (long)i * G + c; if (L >= (long)total * nN || (runs && i >= per)) return false;
        const int mt = (int)(L / nN), pn = (int)(L % nN);
        int e = (u.e > 0 && u.e < NEXP && tstart[u.e] <= mt) ? u.e : 0;
#pragma unroll 1
        while (e + 1 < NEXP && tstart[e + 1] <= mt) ++e;
        u.pm = mt; u.pn = pn; u.e = e; u.j = mt - tstart[e]; u.pb = e * nN + pn; u.half = 0; return true;
    }
    __device__ __forceinline__ int arow(const Unit& u, int r) const {
        if (!gather) return u.pm * BM + r;
        const int p = u.j * BM + r; const int n = tstart[64 + u.e];
        const int v = rowtok[(size_t)u.e * MROWS + (p < n ? p : 0)];
        return (p < n) ? v : 0;
    }
    __device__ __forceinline__ void arow4_issue(const Unit& u, const int (&r)[4], int (&raw)[4]) const {
        if (!gather) return;
        const int n = tstart[64 + u.e];
#pragma unroll
        for (int q = 0; q < 4; ++q) { const int p = u.j * BM + r[q]; raw[q] = rowtok[(size_t)u.e * MROWS + (p < n ? p : 0)]; }
    }
    __device__ __forceinline__ int arow4_fin(const Unit& u, int r, int raw) const {
        if (!gather) return u.pm * BM + r;
        const int p = u.j * BM + r; const int n = tstart[64 + u.e]; return (p < n) ? raw : 0;
    }
    __device__ __forceinline__ void arow4(const Unit& u, const int (&r)[4], int (&o)[4]) const {
        if (!gather) { for (int q = 0; q < 4; ++q) o[q] = u.pm * BM + r[q]; return; }
        const int n = tstart[64 + u.e]; int v[4];
#pragma unroll
        for (int q = 0; q < 4; ++q) { const int p = u.j * BM + r[q]; v[q] = rowtok[(size_t)u.e * MROWS + (p < n ? p : 0)]; }
        asm volatile("" ::: "memory");
#pragma unroll
        for (int q = 0; q < 4; ++q) { const int p = u.j * BM + r[q]; o[q] = (p < n) ? v[q] : 0; }
    }
};
}
struct KArgs { const float* in[19]; float* out; unsigned char* ws; };
struct PArgs { const KArgs& k; unsigned char* ws;
    __device__ __forceinline__ const float* in(int i) const { return k.in[i]; }
    __device__ __forceinline__ float* out() const { return k.out; } };
enum { I_X = 0, I_META, I_REL, I_EVWIN, I_QNORM, I_KVNORM, I_WUQ, I_WUKV, I_EVWOUT, I_ODWIN, I_ODWOUT, I_LNG, I_LNB, I_RW, I_RB, I_EWIN, I_EBIN, I_EWOUT, I_EBOUT };

__device__ __forceinline__ int rowmap(int kind, int n) {
    switch (kind) {
    case 0: {
        if (n < 768) return n; if (n < 832) return EC_KROPE + (n - 768); if (n < 2368) return n - 64; return n; }
    case 1: {
        const int head = n / 192, d = n % 192; if (d < 128) return head * 128 + d;
        const int i = d - 128; if (i < 32) return 512 + head * 64 + 8 * (i >> 2) + (i & 3); const int i2 = i - 32; return 512 + head * 64 + 8 * (i2 >> 2) + 4 + (i2 & 3); }
    case 2: {
        if (n < 512) return 256 * (n >> 7) + (n & 127); const int j = n - 512; return 256 * (j >> 7) + 128 + (j & 127); }
    default: return n;
    }
}
__device__ __forceinline__ void ti_load(f32x4 (&v)[8], const float* W, int Nsrc, int nblk, int item, int lane) {
    const int kb = item / nblk, nb = item % nblk, k0 = 64 * kb, n0 = 32 * nb; const int nq = n0 + 4 * (lane & 7);
#pragma unroll
    for (int i = 0; i < 8; ++i) { const int kk = 8 * i + (lane >> 3); v[i] = (nq < Nsrc) ? *(const f32x4*)(W + (size_t)(k0 + kk) * Nsrc + nq) : (f32x4){0.f, 0.f, 0.f, 0.f}; }
}
__device__ __forceinline__ void ti_finish(const f32x4 (&v)[8], int K, int nblk, bf16_t* WT, int kind, LAS float* scr, int item, int lane) {
    const int kb = item / nblk, nb = item % nblk, k0 = 64 * kb, n0 = 32 * nb;
#pragma unroll
    for (int i = 0; i < 8; ++i) { const int kk = 8 * i + (lane >> 3); LAS float* d = scr + kk * 33 + 4 * (lane & 7); d[0] = v[i][0]; d[1] = v[i][1]; d[2] = v[i][2]; d[3] = v[i][3]; }
    LDS_WAIT(); asm volatile("" ::: "memory");
    const int c = lane & 7;
#pragma unroll
    for (int j = 0; j < 4; ++j) { const int n = (lane >> 3) + 8 * j; const LAS float* s = scr + (8 * c) * 33 + n;
        u32x4 o; o.x = cvtpk(s[0 * 33], s[1 * 33]); o.y = cvtpk(s[2 * 33], s[3 * 33]); o.z = cvtpk(s[4 * 33], s[5 * 33]); o.w = cvtpk(s[6 * 33], s[7 * 33]);
        *(u32x4*)(WT + (size_t)rowmap(kind, n0 + n) * K + k0 + 8 * c) = o; }
    LDS_WAIT(); asm volatile("" ::: "memory");
}
__device__ __forceinline__ void ti_finish8(const f32x4 (&v)[8], int K, int nblk, unsigned char* WT8, int kind, LAS float* scr, int item, int lane) {
    const int kb = item / nblk, nb = item % nblk, k0 = 64 * kb, n0 = 32 * nb;
#pragma unroll
    for (int i = 0; i < 8; ++i) { const int kk = 8 * i + (lane >> 3); LAS float* d = scr + kk * 33 + 4 * (lane & 7); d[0] = v[i][0]; d[1] = v[i][1]; d[2] = v[i][2]; d[3] = v[i][3]; }
    LDS_WAIT(); asm volatile("" ::: "memory");
    const int c = lane & 7;
#pragma unroll
    for (int j = 0; j < 4; ++j) { const int n = (lane >> 3) + 8 * j; const LAS float* s = scr + (8 * c) * 33 + n;
        u32x2 o; o.x = cvt4_fp8(s[0 * 33] * FP8_WSCALE, s[1 * 33] * FP8_WSCALE, s[2 * 33] * FP8_WSCALE, s[3 * 33] * FP8_WSCALE);
        o.y = cvt4_fp8(s[4 * 33] * FP8_WSCALE, s[5 * 33] * FP8_WSCALE, s[6 * 33] * FP8_WSCALE, s[7 * 33] * FP8_WSCALE);
        *(u32x2*)(WT8 + (size_t)rowmap(kind, n0 + n) * K + k0 + 8 * c) = o; }
    LDS_WAIT(); asm volatile("" ::: "memory");
}
__device__ __forceinline__ void transpose_item8(const float* W, int K, int Nsrc, int nblk, unsigned char* WT8, int kind, LAS float* scr, int item, int lane) {
    f32x4 v[8]; ti_load(v, W, Nsrc, nblk, item, lane); ti_finish8(v, K, nblk, WT8, kind, scr, item, lane);
}
__device__ __forceinline__ void transpose_item(const float* W, int K, int Nsrc, int nblk, bf16_t* WT, int kind, LAS float* scr, int item, int lane) {
    f32x4 v[8]; ti_load(v, W, Nsrc, nblk, item, lane); ti_finish(v, K, nblk, WT, kind, scr, item, lane);
}
__device__ __forceinline__ void phase_prologue(const PArgs& a, LAS unsigned char* lds, int vcu, int G) {
    const int tid = opaque_tid(), lane = tid & 63, wave = __builtin_amdgcn_readfirstlane(tid >> 6);
    LAS float* scr = (LAS float*)(lds + wave * 16384);
    const int gw = vcu * 8 + wave, NGW = G * 8;
    unsigned char* ws = a.ws;
    constexpr int I_EVIN = (DM / 64) * (EVP / 32), I_UQ = (512 / 64) * (768 / 32), I_UKV = (256 / 64) * (1024 / 32), I_OUT = (1024 / 64) * (DM / 32), I_ODIN = (DM / 64) * (ODP / 32);
    constexpr int I_EI = (DM / 64) * (1024 / 32), I_EO = (DFF / 64) * (DM / 32);
    constexpr int N_SMALL = 2 * (I_EVIN + I_UQ + I_UKV + I_OUT + I_ODIN + I_OUT);
    constexpr long N_ALL = (long)N_SMALL;
    for (long it = gw; it < N_ALL; it += NGW) {
        long r = it;
        if (r < N_SMALL) {
            const int j = (int)(r & 1); r >>= 1;
            if (r < I_EVIN) { transpose_item8(a.in(I_EVWIN) + (size_t)j * DM * 2368, DM, 2368, EVP / 32, ws + WS_WINE + j * SZ_WINE, 0, scr, (int)r, lane); continue; } r -= I_EVIN;
            if (r < I_UQ) { transpose_item(a.in(I_WUQ) + (size_t)j * 512 * 768, 512, 768, 768 / 32, (bf16_t*)(ws + WS_WUQ + j * SZ_WUQ), 1, scr, (int)r, lane); continue; } r -= I_UQ;
            if (r < I_UKV) { transpose_item(a.in(I_WUKV) + (size_t)j * 256 * 1024, 256, 1024, 1024 / 32, (bf16_t*)(ws + WS_WUKV + j * SZ_WUKV), 3, scr, (int)r, lane); continue; } r -= I_UKV;
            if (r < I_OUT) { transpose_item8(a.in(I_EVWOUT) + (size_t)j * 1024 * DM, 1024, DM, DM / 32, ws + WS_WOUTE + j * SZ_WOUT, 3, scr, (int)r, lane); continue; } r -= I_OUT;
            if (r < I_ODIN) { transpose_item8(a.in(I_ODWIN) + (size_t)j * DM * 1864, DM, 1864, ODP / 32, ws + WS_WINO + j * SZ_WINO, 3, scr, (int)r, lane); continue; } r -= I_ODIN;
            transpose_item8(a.in(I_ODWOUT) + (size_t)j * 1024 * DM, 1024, DM, DM / 32, ws + WS_WOUTO + j * SZ_WOUT, 3, scr, (int)r, lane); continue;
        }
    }
    {   constexpr int PER = I_EI + I_EO; constexpr long NEXI = (long)DEPTH * NEXP * PER;
#define EXP_DESC(idx, Wp, Kd, Ns, nb, Tp, kd, qi) const int le_ = (int)((idx) / PER), q_ = (int)((idx) % PER); const bool ei_ = q_ < I_EI; \
        const float* Wp = ei_ ? a.in(I_EWIN) + (size_t)le_ * DM * 1024 : a.in(I_EWOUT) + (size_t)le_ * DFF * DM; const int Kd = ei_ ? DM : DFF, Ns = ei_ ? 1024 : DM, nb = ei_ ? 1024 / 32 : DM / 32; \
        unsigned char* Tp = ei_ ? (ws + WS_WEI + (size_t)le_ * SZ_WEI) : (ws + WS_WEO + (size_t)le_ * SZ_WEO); const int kd = ei_ ? 2 : 3, qi = ei_ ? q_ : q_ - I_EI
        f32x4 va[8], vb[8];
        long it = gw;
        if (it < NEXI) { EXP_DESC(it, W0, K0, N0, B0, T0, D0, Q0); (void)K0; (void)T0; (void)D0; ti_load(va, W0, N0, B0, Q0, lane); }
        for (; it < NEXI; it += 2 * NGW) {
            const long i1 = it + NGW, i2 = it + 2 * NGW;
            if (i1 < NEXI) { EXP_DESC(i1, W1, K1, N1, B1, T1, D1, Q1); (void)K1; (void)T1; (void)D1; ti_load(vb, W1, N1, B1, Q1, lane); }
            { EXP_DESC(it, W0, K0, N0, B0, T0, D0, Q0); (void)W0; (void)N0; ti_finish8(va, K0, B0, T0, D0, scr, Q0, lane); }
            if (i2 < NEXI) { EXP_DESC(i2, W2, K2, N2, B2, T2, D2, Q2); (void)K2; (void)T2; (void)D2; ti_load(va, W2, N2, B2, Q2, lane); }
            if (i1 < NEXI) { EXP_DESC(i1, W1, K1, N1, B1, T1, D1, Q1); (void)W1; (void)N1; ti_finish8(vb, K1, B1, T1, D1, scr, Q1, lane); }
        }
#undef EXP_DESC
    }
    for (int i = gw * 64 + lane; i < DEPTH * 32 * DM; i += NGW * 64) {
        const int l = i / (32 * DM), e = (i / DM) % 32, k = i % DM;
        const float w = a.in(I_RW)[((size_t)l * DM + k) * 32 + e];
        const unsigned hi = cvtpk(w, 0.f) & 0xffffu; const float lo = w - bflo(hi);
        ((bf16_t*)(ws + WS_WRH))[i] = (bf16_t)hi; ((bf16_t*)(ws + WS_WRL))[i] = (bf16_t)(cvtpk(lo, 0.f) & 0xffffu);
    }
    for (int i = gw * 64 + lane; i < NTOK * 32; i += NGW * 64) {
        const int t = i >> 5, k = i & 31;
        const float inv = powf(10000.0f, -(float)k / 32.0f); const float ang = (float)t * inv;
        float sn, cs; sincosf(ang, &sn, &cs);
        *(f32x2*)((float*)(ws + WS_ROPE) + (size_t)i * 2) = (f32x2){cs, sn};
    }
    bf16_t* HB = (bf16_t*)(ws + WS_HB);
    for (int m = gw; m < MROWS; m += NGW) {
        const int b = m / NTOK, t = m % NTOK;
        const float* src = (t < NMETA) ? a.in(I_META) + (size_t)t * DM : a.in(I_X) + ((size_t)b * SEQ + (t - NMETA)) * DM;
        const bool zero = t >= NMETA + SEQ;
        f32x4 v8[8];
#pragma unroll
        for (int j = 0; j < 8; ++j) v8[j] = zero ? (f32x4){0.f, 0.f, 0.f, 0.f} : *(const f32x4*)(src + 4 * lane + 256 * j);
        asm volatile("" ::: "memory");
#pragma unroll
        for (int j = 0; j < 8; ++j) { const int c = 4 * lane + 256 * j; const f32x4 v = v8[j];
            u32x2 w; w.x = cvtpk(v[0], v[1]); w.y = cvtpk(v[2], v[3]); *(u32x2*)(HB + (size_t)m * DM + c) = w;
            *(unsigned*)(ws + WS_HB8 + (size_t)m * DM + c) = cvt4_fp8(v[0], v[1], v[2], v[3]); }
    }
}

__device__ __forceinline__ void phase_latent_norm(const PArgs& a, int jl, int vcu, int G) {
    const int tid = opaque_tid(), lane = tid & 63, wave = __builtin_amdgcn_readfirstlane(tid >> 6);
    const int gw = vcu * 8 + wave, NGW = G * 8;
    unsigned char* ws = a.ws;
    const bf16_t* P = (const bf16_t*)(ws + WS_P); bf16_t* QN = (bf16_t*)(ws + WS_QN); bf16_t* KVN = (bf16_t*)(ws + WS_KVN); bf16_t* KR = (bf16_t*)(ws + WS_KR);
    const float* rope = (const float*)(ws + WS_ROPE);
    const float* gq = a.in(I_QNORM) + jl * 512; const float* gkv = a.in(I_KVNORM) + jl * 256;
    f32x4 g0 = *(const f32x4*)(gq + 8 * lane), g1 = *(const f32x4*)(gq + 8 * lane + 4), gk = *(const f32x4*)(gkv + 4 * lane);
    const int lr = lane & 31;
#define LAT_LOAD(m_, qv_, kv_, x1_, x2_, cs_) do { const bf16_t* pr_ = P + (size_t)(m_) * EVP; qv_ = *(const u32x4*)(pr_ + EC_QLAT + 8 * lane); kv_ = *(const u32x2*)(pr_ + EC_KVLAT + 4 * lane); \
        x1_ = pr_[EC_KROPE + lr]; x2_ = pr_[EC_KROPE + 32 + lr]; cs_ = *(const f32x2*)(rope + ((size_t)((m_) % NTOK) * 32 + lr) * 2); } while (0)
    u32x4 qv = {0u, 0u, 0u, 0u}, qvn = qv; u32x2 kv = {0u, 0u}, kvn = kv; bf16_t x1b = 0, x2b = 0, x1n = 0, x2n = 0; f32x2 cs = {0.f, 0.f}, csn = cs;
    if (gw < MROWS) LAT_LOAD(gw, qv, kv, x1b, x2b, cs);
    for (int m = gw; m < MROWS; m += NGW) {
        const int mn = (m + NGW < MROWS) ? m + NGW : m;
        LAT_LOAD(mn, qvn, kvn, x1n, x2n, csn);
        asm volatile("" ::: "memory");
        float q[8] = {bflo(qv.x), bfhi(qv.x), bflo(qv.y), bfhi(qv.y), bflo(qv.z), bfhi(qv.z), bflo(qv.w), bfhi(qv.w)};
        float k[4] = {bflo(kv.x), bfhi(kv.x), bflo(kv.y), bfhi(kv.y)};
        float sq = 0.f, sk = 0.f;
#pragma unroll
        for (int i = 0; i < 8; ++i) sq += q[i] * q[i];
#pragma unroll
        for (int i = 0; i < 4; ++i) sk += k[i] * k[i];
        sq = wave_sum(sq); sk = wave_sum(sk);
        const float rq = 1.0f / sqrtf(sq * (1.0f / 512.0f) + RMS_EPS), rk = 1.0f / sqrtf(sk * (1.0f / 256.0f) + RMS_EPS);
        u32x4 wq; wq.x = cvtpk(q[0] * rq * g0[0], q[1] * rq * g0[1]); wq.y = cvtpk(q[2] * rq * g0[2], q[3] * rq * g0[3]);
        wq.z = cvtpk(q[4] * rq * g1[0], q[5] * rq * g1[1]); wq.w = cvtpk(q[6] * rq * g1[2], q[7] * rq * g1[3]);
        *(u32x4*)(QN + (size_t)m * 512 + 8 * lane) = wq;
        u32x2 wk; wk.x = cvtpk(k[0] * rk * gk[0], k[1] * rk * gk[1]); wk.y = cvtpk(k[2] * rk * gk[2], k[3] * rk * gk[3]);
        *(u32x2*)(KVN + (size_t)m * 256 + 4 * lane) = wk;
        if (lane < 32) {
            const float x1 = bf2f(x1b), x2 = bf2f(x2b);
            KR[(size_t)m * 64 + lane] = (bf16_t)(cvtpk(x1 * cs[0] - x2 * cs[1], 0.f) & 0xffffu);
            KR[(size_t)m * 64 + 32 + lane] = (bf16_t)(cvtpk(x1 * cs[1] + x2 * cs[0], 0.f) & 0xffffu);
        }
        qv = qvn; kv = kvn; x1b = x1n; x2b = x2n; cs = csn;
    }
#undef LAT_LOAD
}

__device__ __forceinline__ void phase_ln_route(const PArgs& a, int layer, int cslot, LAS unsigned char* lds, int vcu, int G) {
    const int tid = opaque_tid(), lane = tid & 63, wave = __builtin_amdgcn_readfirstlane(tid >> 6);
    const int r32 = lane & 31, hh = lane >> 5;
    unsigned char* ws = a.ws;
    const bf16_t* Y = (const bf16_t*)(ws + WS_Y); const float* STAT = (const float*)(ws + WS_STAT);
    bf16_t* HB = (bf16_t*)(ws + WS_HB);
    const bf16_t* WRH = (const bf16_t*)(ws + WS_WRH) + (size_t)layer * 32 * DM; const bf16_t* WRL = (const bf16_t*)(ws + WS_WRL) + (size_t)layer * 32 * DM;
    const float* g = a.in(I_LNG) + (size_t)(layer * 2 + 0) * DM; const float* bta = a.in(I_LNB) + (size_t)(layer * 2 + 0) * DM;
    const float* rb = a.in(I_RB) + layer * 32;
    unsigned* cnt = (unsigned*)(ws + WS_CTL) + CW_CNT + 2048 * cslot;
    int* TOPE = (int*)(ws + WS_TOPE); int* TOPP = (int*)(ws + WS_TOPP); float* TOPG = (float*)(ws + WS_TOPG); int* ROWTOK = (int*)(ws + WS_ROWTOK);
    LAS float* part = (LAS float*)lds;
    LAS float* tot = part + 8 * 16 * 64;
    LAS float* gbl = tot + 16 * 64 + wave * 512;
    LAS unsigned* lcnt = (LAS unsigned*)(tot + 16 * 64 + 8 * 512);
    LAS unsigned char* stg = lds + 57344 + wave * 7168;
    const int cbase = 256 * wave, lcol = 16 * hh;
    bf16x8 whf[16], wlf[16];
#pragma unroll
    for (int s = 0; s < 16; ++s) { const int col = cbase + 32 * (s >> 1) + lcol + 8 * (s & 1);
        whf[s] = *(const bf16x8*)(WRH + (size_t)r32 * DM + col); wlf[s] = *(const bf16x8*)(WRL + (size_t)r32 * DM + col); }
    { const f32x4 gv = *(const f32x4*)(g + cbase + 4 * lane), bv = *(const f32x4*)(bta + cbase + 4 * lane);
      *(LAS f32x4*)(gbl + 4 * lane) = gv; *(LAS f32x4*)(gbl + 256 + 4 * lane) = bv; }
    LDS_WAIT(); asm volatile("" ::: "memory");
    int prow = -1; unsigned pbs = 0u;
    LAS int* pend = (LAS int*)(lcnt + 64);
    for (int grp = vcu; grp < MROWS / 32; grp += G) {
        const int row = grp * 32 + r32;
        float s = 0.f, q = 0.f;
        { const f32x4* st = (const f32x4*)(STAT + (size_t)row * 64);
#pragma unroll
          for (int i = 0; i < 16; ++i) { const f32x4 v = st[i]; s += v[0] + v[2]; q += v[1] + v[3]; } }
        const float mean = s * (1.0f / DM); const float var = fmaxf(q * (1.0f / DM) - mean * mean, 0.f); const float rstd = 1.0f / sqrtf(var + LN_EPS);
        f32x16 acc;
#pragma unroll
        for (int i = 0; i < 16; ++i) acc[i] = 0.f;
        const size_t ro = (size_t)row * DM + cbase + lcol;
        u32x4 yAv[4], yBv[4];
#pragma unroll
        for (int p = 0; p < 8; ++p) {
            if ((p & 3) == 0) {
#pragma unroll
                for (int pp = 0; pp < 4; ++pp) { const bf16_t* yp = Y + ((size_t)(grp * 128 + 16 * wave + 2 * (p + pp) + hh) * 32 + r32) * 16;
                    yAv[pp] = *(const u32x4*)(yp); yBv[pp] = *(const u32x4*)(yp + 8); }
                asm volatile("" ::: "memory"); }
            const u32x4 yA = yAv[p & 3], yB = yBv[p & 3];
            const f32x4 y0 = {bflo(yA.x), bfhi(yA.x), bflo(yA.y), bfhi(yA.y)}, y1 = {bflo(yA.z), bfhi(yA.z), bflo(yA.w), bfhi(yA.w)}, y2 = {bflo(yB.x), bfhi(yB.x), bflo(yB.y), bfhi(yB.y)}, y3 = {bflo(yB.z), bfhi(yB.z), bflo(yB.w), bfhi(yB.w)};
            const LAS float* gp = gbl + 32 * p + lcol;
            const f32x4 g0 = *(const LAS f32x4*)(gp), g1 = *(const LAS f32x4*)(gp + 4), g2 = *(const LAS f32x4*)(gp + 8), g3 = *(const LAS f32x4*)(gp + 12);
            const f32x4 b0 = *(const LAS f32x4*)(gp + 256), b1 = *(const LAS f32x4*)(gp + 260), b2 = *(const LAS f32x4*)(gp + 264), b3 = *(const LAS f32x4*)(gp + 268);
            const f32x4 h0 = (y0 - mean) * rstd * g0 + b0, h1 = (y1 - mean) * rstd * g1 + b1, h2 = (y2 - mean) * rstd * g2 + b2, h3 = (y3 - mean) * rstd * g3 + b3;
            u32x4 hiA, hiB; hiA.x = cvtpk(h0[0], h0[1]); hiA.y = cvtpk(h0[2], h0[3]); hiA.z = cvtpk(h1[0], h1[1]); hiA.w = cvtpk(h1[2], h1[3]);
            hiB.x = cvtpk(h2[0], h2[1]); hiB.y = cvtpk(h2[2], h2[3]); hiB.z = cvtpk(h3[0], h3[1]); hiB.w = cvtpk(h3[2], h3[3]);
            { LAS unsigned char* sH = stg + r32 * 144 + (p & 1) * 64 + hh * 32; *(LAS u32x4*)(sH) = hiA; *(LAS u32x4*)(sH + 16) = hiB;
              u32x4 q8; q8.x = cvt4_fp8(h0[0], h0[1], h0[2], h0[3]); q8.y = cvt4_fp8(h1[0], h1[1], h1[2], h1[3]); q8.z = cvt4_fp8(h2[0], h2[1], h2[2], h2[3]); q8.w = cvt4_fp8(h3[0], h3[1], h3[2], h3[3]);
              *(LAS u32x4*)(stg + 4608 + r32 * 80 + (p & 1) * 32 + hh * 16) = q8; }
            if (p & 1) {
                LDS_WAIT(); asm volatile("" ::: "memory");
                int ln_ = lane; asm volatile("" : "+v"(ln_));
                const size_t cq = (size_t)cbase + 64 * (p >> 1);
#pragma unroll
                for (int i = 0; i < 4; ++i) { const int id = i * 64 + ln_, rw = id >> 3, c = id & 7; const u32x4 w = *(const LAS u32x4*)(stg + rw * 144 + c * 16);
                    *(u32x4*)((unsigned char*)HB + ((size_t)(grp * 32 + rw) * DM + cq) * 2 + c * 16) = w; }
#pragma unroll
                for (int i = 0; i < 2; ++i) { const int id = i * 64 + ln_, rw = id >> 2, c = id & 3; const u32x4 w = *(const LAS u32x4*)(stg + 4608 + rw * 80 + c * 16);
                    *(u32x4*)((unsigned char*)(ws + WS_HB8) + (size_t)(grp * 32 + rw) * DM + cq + c * 16) = w; }
                asm volatile("" ::: "memory");
            }
            u32x4 loA, loB; loA.x = cvtpk(h0[0] - bflo(hiA.x), h0[1] - bfhi(hiA.x)); loA.y = cvtpk(h0[2] - bflo(hiA.y), h0[3] - bfhi(hiA.y));
            loA.z = cvtpk(h1[0] - bflo(hiA.z), h1[1] - bfhi(hiA.z)); loA.w = cvtpk(h1[2] - bflo(hiA.w), h1[3] - bfhi(hiA.w));
            loB.x = cvtpk(h2[0] - bflo(hiB.x), h2[1] - bfhi(hiB.x)); loB.y = cvtpk(h2[2] - bflo(hiB.y), h2[3] - bfhi(hiB.y));
            loB.z = cvtpk(h3[0] - bflo(hiB.z), h3[1] - bfhi(hiB.z)); loB.w = cvtpk(h3[2] - bflo(hiB.w), h3[3] - bfhi(hiB.w));
            const bf16x8 hiAf = __builtin_bit_cast(bf16x8, hiA), hiBf = __builtin_bit_cast(bf16x8, hiB), loAf = __builtin_bit_cast(bf16x8, loA), loBf = __builtin_bit_cast(bf16x8, loB);
            acc = __builtin_amdgcn_mfma_f32_32x32x16_bf16(whf[2 * p], hiAf, acc, 0, 0, 0);
            acc = __builtin_amdgcn_mfma_f32_32x32x16_bf16(whf[2 * p], loAf, acc, 0, 0, 0);
            acc = __builtin_amdgcn_mfma_f32_32x32x16_bf16(wlf[2 * p], hiAf, acc, 0, 0, 0);
            acc = __builtin_amdgcn_mfma_f32_32x32x16_bf16(whf[2 * p + 1], hiBf, acc, 0, 0, 0);
            acc = __builtin_amdgcn_mfma_f32_32x32x16_bf16(whf[2 * p + 1], loBf, acc, 0, 0, 0);
            acc = __builtin_amdgcn_mfma_f32_32x32x16_bf16(wlf[2 * p + 1], hiBf, acc, 0, 0, 0);
        }
#pragma unroll
        for (int r = 0; r < 16; ++r) part[(wave * 16 + r) * 64 + lane] = acc[r];
        LDS_WAIT(); __syncthreads();
#pragma unroll
        for (int rr = 0; rr < 2; ++rr) { const int r = 2 * wave + rr; float t = 0.f;
#pragma unroll
            for (int w = 0; w < 8; ++w) t += part[(w * 16 + r) * 64 + lane];
            tot[r * 64 + lane] = t; }
        LDS_WAIT(); __syncthreads();
        if (wave == 0) {
            float v[16];
#pragma unroll
            for (int r = 0; r < 16; ++r) v[r] = tot[r * 64 + lane] + rb[(r & 3) + 8 * (r >> 2) + 4 * hh];
            float bv[4]; int bi[4];
#pragma unroll
            for (int k = 0; k < 4; ++k) { float best = -3.0e38f; int br = 0;
#pragma unroll
                for (int r = 0; r < 16; ++r) { const bool gt = v[r] > best; best = gt ? v[r] : best; br = gt ? r : br; }
#pragma unroll
                for (int r = 0; r < 16; ++r) v[r] = (r == br) ? -3.0e38f : v[r];
                bv[k] = best; bi[k] = (br & 3) + 8 * (br >> 2) + 4 * hh; }
            float ov[4]; int oi[4];
#pragma unroll
            for (int k = 0; k < 4; ++k) { ov[k] = __shfl_xor(bv[k], 32); oi[k] = __shfl_xor(bi[k], 32); }
            float tv[4]; int ti[4]; int pa = 0, pb = 0;
#pragma unroll
            for (int k = 0; k < 4; ++k) {
                float av = bv[0], ovv = ov[0]; int ai = bi[0], oii = oi[0];
#pragma unroll
                for (int z = 1; z < 4; ++z) { av = (pa == z) ? bv[z] : av; ai = (pa == z) ? bi[z] : ai; ovv = (pb == z) ? ov[z] : ovv; oii = (pb == z) ? oi[z] : oii; }
                const bool takeA = (av > ovv) || (av == ovv && ai < oii);
                tv[k] = takeA ? av : ovv; ti[k] = takeA ? ai : oii; pa += takeA ? 1 : 0; pb += takeA ? 0 : 1; }
            if (hh == 0) {
                const float e1 = __expf(tv[1] - tv[0]), e2 = __expf(tv[2] - tv[0]), e3 = __expf(tv[3] - tv[0]); const float inv = 1.0f / (1.0f + e1 + e2 + e3);
                const float gt[4] = {inv, e1 * inv, e2 * inv, e3 * inv};
                if (prow >= 0) { lcnt[32 + lane] = pbs; LDS_WAIT(); asm volatile("" ::: "memory");
                    int ps[4];
#pragma unroll
                    for (int k = 0; k < 4; ++k) { const int pe = pend[k * 32 + lane]; ps[k] = (int)lcnt[32 + pe] + pend[(4 + k) * 32 + lane]; ROWTOK[(size_t)pe * MROWS + ps[k]] = prow; }
                    *(i32x4*)(TOPP + (size_t)prow * 4) = (i32x4){ps[0], ps[1], ps[2], ps[3]}; }
                lcnt[lane] = 0u; LDS_WAIT(); asm volatile("" ::: "memory");
#pragma unroll
                for (int k = 0; k < 4; ++k) { const unsigned lr_ = __hip_atomic_fetch_add(lcnt + ti[k], 1u, __ATOMIC_RELAXED, __HIP_MEMORY_SCOPE_WORKGROUP); pend[k * 32 + lane] = ti[k]; pend[(4 + k) * 32 + lane] = (int)lr_; }
                LDS_WAIT(); asm volatile("" ::: "memory");
                { const unsigned n = lcnt[lane]; pbs = 0u; if (n) pbs = __hip_atomic_fetch_add(cnt + 64 * lane, n, __ATOMIC_RELAXED, __HIP_MEMORY_SCOPE_AGENT); }
                prow = row;
                *(i32x4*)(TOPE + (size_t)row * 4) = (i32x4){ti[0], ti[1], ti[2], ti[3]};
                *(f32x4*)(TOPG + (size_t)row * 4) = (f32x4){gt[0], gt[1], gt[2], gt[3]};
            }
        }
    }
    if (wave == 0 && hh == 0 && prow >= 0) {
        lcnt[32 + lane] = pbs; LDS_WAIT(); asm volatile("" ::: "memory");
        int ps[4];
#pragma unroll
        for (int k = 0; k < 4; ++k) { const int pe = pend[k * 32 + lane]; ps[k] = (int)lcnt[32 + pe] + pend[(4 + k) * 32 + lane]; ROWTOK[(size_t)pe * MROWS + ps[k]] = prow; }
        *(i32x4*)(TOPP + (size_t)prow * 4) = (i32x4){ps[0], ps[1], ps[2], ps[3]};
    }
    __syncthreads();
}

__device__ __forceinline__ void build_tile_table(const unsigned* cnt, LAS int* tstart) {
    const int tid_ = opaque_tid();
    if (tid_ < 64) {
        const int lane = tid_; const int n = (lane < NEXP) ? (int)__hip_atomic_load(cnt + 64 * lane, __ATOMIC_RELAXED, __HIP_MEMORY_SCOPE_AGENT) : 0;
        const int tiles = (n + 255) >> 8; int incl = tiles;
#pragma unroll
        for (int o = 1; o < 64; o <<= 1) { const int v = __shfl_up(incl, o); if (lane >= o) incl += v; }
        if (lane <= NEXP) tstart[lane] = incl - tiles;
        if (lane < NEXP) tstart[64 + lane] = n;
    }
    LDS_WAIT(); __syncthreads();
}

struct CombRow { f32x4 z[8]; };
template <bool last>
__device__ __forceinline__ void phase_combine_ln(const PArgs& a, int layer, const LAS int* tstart, int vcu, int G, bool dummy) {
    const int tid = opaque_tid(), lane = tid & 63, wave = __builtin_amdgcn_readfirstlane(tid >> 6);
    LAS unsigned char* lds_b = (LAS unsigned char*)tstart - TBL_OFF;
    const int gw = vcu * 8 + wave, NGW = G * 8;
    unsigned char* ws = a.ws;
    const bf16_t* HBin = (const bf16_t*)(ws + WS_HB); const unsigned char* YE = (const unsigned char*)(ws + WS_YEXP);
    bf16_t* HB = dummy ? (bf16_t*)(ws + WS_P) : (bf16_t*)(ws + WS_HB);
    unsigned char* H8 = ws + WS_HB8;
    const int* TOPE = (const int*)(ws + WS_TOPE); const int* TOPP = (const int*)(ws + WS_TOPP); const float* TOPG = (const float*)(ws + WS_TOPG);
    const float* g = a.in(I_LNG) + (size_t)(layer * 2 + 1) * DM; const float* bta = a.in(I_LNB) + (size_t)(layer * 2 + 1) * DM;
    float* outp = dummy ? (float*)(ws + WS_Y) : a.out();
    LAS float* gl = (LAS float*)(lds_b);
    { const int tid_ = tid; *(LAS f32x4*)(gl + 4 * tid_) = *(const f32x4*)(g + 4 * tid_); *(LAS f32x4*)(gl + 2048 + 4 * tid_) = *(const f32x4*)(bta + 4 * tid_); }
    LDS_WAIT(); __syncthreads();
#define IDX_LOAD(te_, tp_, tg_, m) do { te_ = *(const i32x4*)(TOPE + (size_t)(m) * 4); tp_ = *(const i32x4*)(TOPP + (size_t)(m) * 4); tg_ = *(const f32x4*)(TOPG + (size_t)(m) * 4); } while (0)
#define RAW_ISSUE(m, te_, tp_) do { \
        const unsigned o0_ = (unsigned)((tstart[te_[0]] * 256 + tp_[0])) , o1_ = (unsigned)((tstart[te_[1]] * 256 + tp_[1])), o2_ = (unsigned)((tstart[te_[2]] * 256 + tp_[2])), o3_ = (unsigned)((tstart[te_[3]] * 256 + tp_[3])); \
        _Pragma("unroll") for (int j = 0; j < 8; ++j) { const int c = 4 * lane + 256 * j; hwv[j] = *(const u32x2*)(HBin + (size_t)(m) * DM + c); \
            wv[j][0] = *(const unsigned*)(YE + (size_t)o0_ * DM + c); wv[j][1] = *(const unsigned*)(YE + (size_t)o1_ * DM + c); wv[j][2] = *(const unsigned*)(YE + (size_t)o2_ * DM + c); wv[j][3] = *(const unsigned*)(YE + (size_t)o3_ * DM + c); } } while (0)
#define COMB_CONVERT(R, tg_) do { _Pragma("unroll") for (int j = 0; j < 8; ++j) { const u32x2 hw_ = hwv[j]; f32x4 v_ = (f32x4){bflo(hw_.x), bfhi(hw_.x), bflo(hw_.y), bfhi(hw_.y)} * DN_ALPHA; \
            const unsigned w0_ = wv[j][0], w1_ = wv[j][1], w2_ = wv[j][2], w3_ = wv[j][3]; \
            const f32x2 a0_ = __builtin_amdgcn_cvt_pk_f32_fp8((int)w0_, false), c0_ = __builtin_amdgcn_cvt_pk_f32_fp8((int)w0_, true), a1_ = __builtin_amdgcn_cvt_pk_f32_fp8((int)w1_, false), c1_ = __builtin_amdgcn_cvt_pk_f32_fp8((int)w1_, true); \
            const f32x2 a2_ = __builtin_amdgcn_cvt_pk_f32_fp8((int)w2_, false), c2_ = __builtin_amdgcn_cvt_pk_f32_fp8((int)w2_, true), a3_ = __builtin_amdgcn_cvt_pk_f32_fp8((int)w3_, false), c3_ = __builtin_amdgcn_cvt_pk_f32_fp8((int)w3_, true); \
            v_[0] += tg_[0] * a0_[0] + tg_[1] * a1_[0] + tg_[2] * a2_[0] + tg_[3] * a3_[0]; \
            v_[1] += tg_[0] * a0_[1] + tg_[1] * a1_[1] + tg_[2] * a2_[1] + tg_[3] * a3_[1]; \
            v_[2] += tg_[0] * c0_[0] + tg_[1] * c1_[0] + tg_[2] * c2_[0] + tg_[3] * c3_[0]; \
            v_[3] += tg_[0] * c0_[1] + tg_[1] * c1_[1] + tg_[2] * c2_[1] + tg_[3] * c3_[1]; \
            (R).z[j] = v_; } } while (0)
#define COMB_FINISH(R, m) do { float s_ = 0.f; _Pragma("unroll") for (int j = 0; j < 8; ++j) s_ += ((R).z[j][0] + (R).z[j][1]) + ((R).z[j][2] + (R).z[j][3]); \
        const float mean_ = wave_sum(s_) * (1.0f / DM); float s2_ = 0.f; \
        _Pragma("unroll") for (int j = 0; j < 8; ++j) { (R).z[j] = (R).z[j] - mean_; s2_ += ((R).z[j][0] * (R).z[j][0] + (R).z[j][1] * (R).z[j][1]) + ((R).z[j][2] * (R).z[j][2] + (R).z[j][3] * (R).z[j][3]); } \
        const float rstd_ = 1.0f / sqrtf(wave_sum(s2_) * (1.0f / DM) + LN_EPS); const int b_ = (m) / NTOK, t_ = (m) % NTOK; \
        _Pragma("unroll") for (int j = 0; j < 8; ++j) { const int c = 4 * lane + 256 * j; \
            const f32x4 o_ = (R).z[j] * rstd_ * *(const LAS f32x4*)(gl + c) + *(const LAS f32x4*)(gl + 2048 + c); \
            if (!last) { u32x2 w_; w_.x = cvtpk(o_[0], o_[1]); w_.y = cvtpk(o_[2], o_[3]); *(u32x2*)(HB + (size_t)(m) * DM + c) = w_; \
                *(unsigned*)(H8 + (size_t)(m) * DM + c) = cvt4_fp8(o_[0], o_[1], o_[2], o_[3]); } \
            else if (t_ >= NMETA && t_ < NMETA + SEQ) *(f32x4*)(outp + ((size_t)b_ * SEQ + (t_ - NMETA)) * DM + c) = o_; } } while (0)
    if (gw < MROWS) {
        i32x4 teA, tpA, teB, tpB; f32x4 tgA, tgB, tgC; u32x2 hwv[8]; unsigned wv[8][4]; CombRow r;
        IDX_LOAD(teA, tpA, tgA, gw);
        RAW_ISSUE(gw, teA, tpA); tgC = tgA;
        { const int m1 = (gw + NGW < MROWS) ? gw + NGW : gw; IDX_LOAD(teB, tpB, tgB, m1); }
        int m = gw;
#define COMB_STEP(teX, tpX, tgX, teY, tpY, tgY) do { const int m1 = (m + NGW < MROWS) ? m + NGW : m, m2 = (m + 2 * NGW < MROWS) ? m + 2 * NGW : m; \
            COMB_CONVERT(r, tgC);                              \
            RAW_ISSUE(m1, teX, tpX); tgC = tgX;                \
            IDX_LOAD(teY, tpY, tgY, m2);                       \
            asm volatile("" ::: "memory"); } while (0)
        COMB_STEP(teB, tpB, tgB, teA, tpA, tgA);
        for (;;) {
            COMB_FINISH(r, m);
            m += NGW; if (m >= MROWS) break;
            COMB_STEP(teA, tpA, tgA, teB, tpB, tgB);
            COMB_FINISH(r, m);
            m += NGW; if (m >= MROWS) break;
            COMB_STEP(teB, tpB, tgB, teA, tpA, tgA);
        }
#undef COMB_STEP
    }
#undef IDX_LOAD
#undef RAW_ISSUE
#undef COMB_CONVERT
#undef COMB_FINISH
}
namespace att {
constexpr int KVBLK = 64;
constexpr int BUF_BYTES = 40960, OFF_KN = 0, OFF_KR = 16384, OFF_V = 24576, OFF_WS = 2 * BUF_BYTES, OFF_FLAG = OFF_WS + 8 * 256;
#define KSWZ(row, colB) ((row) * 256 + ((colB) ^ (((row) & 7) << 4)))
#define KRSWZ(row, colB) ((row) * 128 + ((colB) ^ (((row) & 7) << 4)))
__device__ __forceinline__ int crow(int r, int hi) { return (r & 3) + 8 * (r >> 2) + 4 * hi; }
__device__ __forceinline__ int v_st(int k, int c) { const int kk = (k & ~0xC) | ((k & 4) << 1) | ((k & 8) >> 1); return ((kk >> 3) * 4 + (c >> 5)) * 512 + ((kk & 7) * 32 + (c & 31)) * 2; }
__device__ __forceinline__ int v_rd_base(int lane) { return ((lane & 3) << 3) | (((lane >> 2) & 3) << 6) | (((lane >> 4) & 1) << 5) | (((lane >> 5) & 1) << 8); }
constexpr int v_rd_off(int d0, int ks, int half) { return d0 * 512 + ks * 4096 + half * 2048; }
template <int OFF> __device__ __forceinline__ s16x4 tr_read(int vb) { s16x4 r; asm volatile("ds_read_b64_tr_b16 %0, %1 offset:%2" : "=&v"(r) : "v"(vb), "i"(OFF) : "memory"); return r; }
template <int D0> __device__ __forceinline__ void pv_one(f32x16& od, int vb, bf16x8 pa0, bf16x8 pa1, bf16x8 pa2, bf16x8 pa3) {
    const s16x4 l0 = tr_read<v_rd_off(D0, 0, 0)>(vb), h0 = tr_read<v_rd_off(D0, 0, 1)>(vb), l1 = tr_read<v_rd_off(D0, 1, 0)>(vb), h1 = tr_read<v_rd_off(D0, 1, 1)>(vb);
    const s16x4 l2 = tr_read<v_rd_off(D0, 2, 0)>(vb), h2 = tr_read<v_rd_off(D0, 2, 1)>(vb), l3 = tr_read<v_rd_off(D0, 3, 0)>(vb), h3 = tr_read<v_rd_off(D0, 3, 1)>(vb);
    asm volatile("s_waitcnt lgkmcnt(0)" ::: "memory"); SBAR();
#define PK(L, H) (bf16x8){L[0], L[1], L[2], L[3], H[0], H[1], H[2], H[3]}
    od = __builtin_amdgcn_mfma_f32_32x32x16_bf16(pa0, PK(l0, h0), od, 0, 0, 0);
    od = __builtin_amdgcn_mfma_f32_32x32x16_bf16(pa1, PK(l1, h1), od, 0, 0, 0);
    od = __builtin_amdgcn_mfma_f32_32x32x16_bf16(pa2, PK(l2, h2), od, 0, 0, 0);
    od = __builtin_amdgcn_mfma_f32_32x32x16_bf16(pa3, PK(l3, h3), od, 0, 0, 0);
#undef PK
}
__device__ __forceinline__ void pv_d0(f32x16* o, int vb, bf16x8 pa0, bf16x8 pa1, bf16x8 pa2, bf16x8 pa3) {
    pv_one<0>(o[0], vb, pa0, pa1, pa2, pa3); pv_one<1>(o[1], vb, pa0, pa1, pa2, pa3); pv_one<2>(o[2], vb, pa0, pa1, pa2, pa3); pv_one<3>(o[3], vb, pa0, pa1, pa2, pa3);
}
__device__ __forceinline__ void pack_p(const f32x16& p0, const f32x16& p1, bf16x8& pa0, bf16x8& pa1, bf16x8& pa2, bf16x8& pa3) {
#define PK4(P, BASE, OUT) do { unsigned a0 = cvtpk(P[BASE + 0], P[BASE + 1]), a1 = cvtpk(P[BASE + 2], P[BASE + 3]);   \
    unsigned b0 = cvtpk(P[BASE + 4], P[BASE + 5]), b1 = cvtpk(P[BASE + 6], P[BASE + 7]);                              \
    auto r0 = __builtin_amdgcn_permlane32_swap(a0, b0, false, false); auto r1 = __builtin_amdgcn_permlane32_swap(a1, b1, false, false); \
    u32x4 w = {r0[0], r1[0], r0[1], r1[1]}; OUT = __builtin_bit_cast(bf16x8, w); } while (0)
    PK4(p0, 0, pa0); PK4(p0, 8, pa1); PK4(p1, 0, pa2); PK4(p1, 8, pa3);
#undef PK4
}
__device__ __forceinline__ float xhalf_max(float v) { auto rr = __builtin_amdgcn_permlane32_swap(__float_as_uint(v), __float_as_uint(v), false, false); return fmaxf(__uint_as_float(rr[0]), __uint_as_float(rr[1])); }
__device__ __forceinline__ float xhalf_sum(float v) { auto rr = __builtin_amdgcn_permlane32_swap(__float_as_uint(v), __float_as_uint(v), false, false); return __uint_as_float(rr[0]) + __uint_as_float(rr[1]); }

template <bool MLA>
__device__ __forceinline__ void attn_unit(LAS unsigned char* lds, const bf16_t* __restrict__ Qp, int ldq, const bf16_t* __restrict__ Kn, int ldk, const bf16_t* __restrict__ Kr,
                                          const bf16_t* __restrict__ Vp, int ldv, unsigned char* __restrict__ Op, int ldo, int q0) {
    constexpr int NQ = MLA ? 12 : 8, NQR = 8;
    const int tid = opaque_tid(), wid = __builtin_amdgcn_readfirstlane(tid >> 6), lane = tid & 63, r32 = lane & 31, hi = lane >> 5;
    LAS float* wsl = (LAS float*)(lds + OFF_WS) + wid * 64; LAS float* li_l = wsl; LAS float* al_l = wsl + 32;
    volatile LAS unsigned* flags = (volatile LAS unsigned*)(lds + OFF_FLAG);
    const int t = q0 + wid * 32 + r32;
    const int tq = t < NTOK ? t : NTOK - 1;
    float m_reg = -1e30f, l_reg = 0.f, R = 0.f; f32x16 o[4];
#pragma unroll
    for (int d = 0; d < 4; ++d)
#pragma unroll
        for (int r = 0; r < 16; ++r) o[d][r] = 0.f;
    bf16x8 qr[NQR];
    const bf16_t* Qw = Qp + (size_t)tq * ldq + hi * 8;
#pragma unroll
    for (int d0 = 0; d0 < NQR; ++d0) qr[d0] = *(const bf16x8*)(Qw + d0 * 16);
    const int sr = tid >> 4, sc = (tid & 15) * 8, vst0 = v_st(sr, sc), vst1 = v_st(32 + sr, sc);
    const int krr = tid >> 3, krc = (tid & 7) * 8;
    const int vb0 = (int)(uintptr_t)(lds + OFF_V) + v_rd_base(lane);
    bf16x8 vs0, vs1, ks0, ks1, kr0;
    const unsigned offV0 = (unsigned)(sr * ldv + sc) * 2u, offV1 = (unsigned)((32 + sr) * ldv + sc) * 2u, offK0 = (unsigned)(sr * ldk + sc) * 2u, offK1 = (unsigned)((32 + sr) * ldk + sc) * 2u, offR = (unsigned)(krr * 64 + krc) * 2u;
#define SLOAD(k0) do { const char* vb_ = (const char*)(Vp + (size_t)(k0) * ldv); const char* kb_ = (const char*)(Kn + (size_t)(k0) * ldk); \
    vs0 = *(const bf16x8*)(vb_ + offV0); vs1 = *(const bf16x8*)(vb_ + offV1); ks0 = *(const bf16x8*)(kb_ + offK0); ks1 = *(const bf16x8*)(kb_ + offK1); \
    if (MLA) kr0 = *(const bf16x8*)((const char*)(Kr + (size_t)(k0) * 64) + offR); } while (0)
#define SWRITE(b) do { LAS unsigned char* bb = lds + (b) * BUF_BYTES; *(LAS bf16x8*)(bb + OFF_V + vst0) = vs0; *(LAS bf16x8*)(bb + OFF_V + vst1) = vs1; \
    *(LAS bf16x8*)(bb + OFF_KN + KSWZ(sr, sc * 2)) = ks0; *(LAS bf16x8*)(bb + OFF_KN + KSWZ(32 + sr, sc * 2)) = ks1; \
    if (MLA) *(LAS bf16x8*)(bb + OFF_KR + KRSWZ(krr, krc * 2)) = kr0; } while (0)
    int NT, jfirst, jstep;
    if (MLA) { const int emax = chunk_end(q0 + 255 < NTOK ? q0 + 255 : NTOK - 1); NT = (emax + 63) / 64; if (NT > NTOK / 64) NT = NTOK / 64; jfirst = 0; jstep = 1; }
    else { int jh = (q0 + 255) / 64; if (jh > NTOK / 64 - 1) jh = NTOK / 64 - 1; NT = jh + 1; jfirst = jh; jstep = -1; }
    const int emin = MLA ? chunk_end(q0) : 0;
    const int e_t = chunk_end(tq);
    constexpr float SC = MLA ? 0.072168783648703220f : 0.088388347648318440f;
    constexpr float C = SC * 1.4426950408889634f;
    SLOAD(jfirst * KVBLK); VM_WAIT(); SWRITE(0); LDS_WAIT(); __syncthreads();
    for (int it = 0; it < NT; ++it) {
        const int j = jfirst + it * jstep; const int cb = it & 1;
        const bool more = (it + 1 < NT);
        if (more) SLOAD((j + jstep) * KVBLK);
        SBAR();
        f32x16 p0, p1;
#pragma unroll
        for (int r = 0; r < 16; ++r) { p0[r] = 0.f; p1[r] = 0.f; }
        { const LAS unsigned char* Ks = lds + cb * BUF_BYTES + OFF_KN; const LAS unsigned char* Krs = lds + cb * BUF_BYTES + OFF_KR;
#pragma unroll
          for (int d0 = 0; d0 < NQ; ++d0) {
              bf16x8 b0, b1;
              if (d0 < 8) { const int cbb = (d0 * 16 + hi * 8) * 2; b0 = *(const LAS bf16x8*)(Ks + KSWZ(r32, cbb)); b1 = *(const LAS bf16x8*)(Ks + KSWZ(32 + r32, cbb)); }
              else { const int cbb = ((d0 - 8) * 16 + hi * 8) * 2; b0 = *(const LAS bf16x8*)(Krs + KRSWZ(r32, cbb)); b1 = *(const LAS bf16x8*)(Krs + KRSWZ(32 + r32, cbb)); }
              const bf16x8 qf = (d0 < NQR) ? qr[d0 < NQR ? d0 : 0] : *(const bf16x8*)(Qw + d0 * 16);
              p0 = __builtin_amdgcn_mfma_f32_32x32x16_bf16(b0, qf, p0, 0, 0, 0);
              p1 = __builtin_amdgcn_mfma_f32_32x32x16_bf16(b1, qf, p1, 0, 0, 0); } }
        const int kbase = j * KVBLK;
        if (MLA) {
            if (kbase + KVBLK > emin) {
#pragma unroll
                for (int r = 0; r < 16; ++r) { const int k0 = kbase + crow(r, hi); p0[r] = (k0 < e_t) ? p0[r] : -1e30f; p1[r] = (k0 + 32 < e_t) ? p1[r] : -1e30f; } }
            float pmax = p0[0];
#pragma unroll
            for (int r = 1; r < 16; ++r) pmax = fmaxf(pmax, p0[r]);
#pragma unroll
            for (int r = 0; r < 16; ++r) pmax = fmaxf(pmax, p1[r]);
            pmax = xhalf_max(pmax);
            const float mn = fmaxf(m_reg, pmax); const float alpha = __builtin_amdgcn_exp2f((m_reg - mn) * C); m_reg = mn;
            const float mnC = -mn * C; float ps = 0.f;
#pragma unroll
            for (int r = 0; r < 16; ++r) { p0[r] = __builtin_amdgcn_exp2f(fmaf(p0[r], C, mnC)); p1[r] = __builtin_amdgcn_exp2f(fmaf(p1[r], C, mnC)); ps += p0[r] + p1[r]; }
            ps = xhalf_sum(ps); l_reg = l_reg * alpha + ps;
            if (__any(alpha < 1.f)) { if (hi == 0) al_l[r32] = alpha; LDS_WAIT();
#pragma unroll
                for (int d = 0; d < 4; ++d)
#pragma unroll
                    for (int r = 0; r < 16; ++r) o[d][r] *= al_l[crow(r, hi)]; }
        } else {
#define SB_LK(zz, kk) (((kk) < t) ? -(fmaxf((zz), 0.f) + 0.6931471805599453f * __builtin_amdgcn_logf(1.0f + __builtin_amdgcn_exp2f(-fabsf(zz) * 1.4426950408889634f))) : 0.f)
#pragma unroll
            for (int r = 0; r < 16; ++r) { p0[r] *= SC; p1[r] *= SC; }
            float abv[2][4]; float run = 0.f;
#pragma unroll
            for (int tt = 1; tt >= 0; --tt)
#pragma unroll
                for (int c = 3; c >= 0; --c) {
                    float mine = 0.f;
#pragma unroll
                    for (int i = 0; i < 4; ++i) { const int r = 4 * c + i; const int kk = kbase + 32 * tt + crow(r, hi); mine += SB_LK(tt ? p1[r] : p0[r], kk); }
                    const float other = __shfl_xor(mine, 32);
                    const float g_hi1 = hi ? mine : other, g_hi0 = hi ? other : mine;
                    abv[tt][c] = hi ? run : run + g_hi1;
                    run += g_hi1 + g_hi0; }
#pragma unroll
            for (int tt = 0; tt < 2; ++tt)
#pragma unroll
                for (int c = 0; c < 4; ++c) {
                    float cum = R + abv[tt][c];
#pragma unroll
                    for (int i = 3; i >= 0; --i) { const int r = 4 * c + i; const int kk = kbase + 32 * tt + crow(r, hi);
                        const float z = tt ? p1[r] : p0[r]; cum += SB_LK(z, kk);
                        const float av = (kk < t) ? __builtin_amdgcn_exp2f((z + cum) * 1.4426950408889634f) : 0.f;
                        if (tt) p1[r] = av; else p0[r] = av; } }
#undef SB_LK
            R += run;
        }
        bf16x8 pa0, pa1, pa2, pa3; pack_p(p0, p1, pa0, pa1, pa2, pa3);
        SBAR();
        pv_d0(o, vb0 + cb * BUF_BYTES, pa0, pa1, pa2, pa3);
        if (!MLA) { const bool done = __all((R < -60.f) || (t >= NTOK)); if (lane == 0) flags[(it & 1) * 8 + wid] = done ? 1u : 0u; }
        if (more) { VM_WAIT(); SWRITE(cb ^ 1); }
        LDS_WAIT(); __syncthreads();
        if (!MLA) { unsigned alld = 1u;
#pragma unroll
            for (int w = 0; w < 8; ++w) alld &= flags[(it & 1) * 8 + w];
            if (alld) break; }
    }
    float rli[16];
    if (MLA) { if (hi == 0) li_l[r32] = l_reg; LDS_WAIT();
#pragma unroll
        for (int r = 0; r < 16; ++r) rli[r] = __builtin_amdgcn_rcpf(li_l[crow(r, hi)]); }
    else {
#pragma unroll
        for (int r = 0; r < 16; ++r) rli[r] = 1.f; }
#pragma unroll
    for (int r = 0; r < 16; ++r) { const int orow = q0 + wid * 32 + crow(r, hi);
        if (orow < NTOK) {
#pragma unroll
            for (int d0 = 0; d0 < 4; ++d0) Op[(size_t)orow * ldo + d0 * 32 + r32] = om_fp8(o[d0][r] * rli[r]); } }
    __syncthreads();
#undef SLOAD
#undef SWRITE
}
#undef KSWZ
#undef KRSWZ

__device__ __forceinline__ void phase_attention(const PArgs& a, LAS unsigned char* lds, int layer) {
    unsigned char* ws = a.ws;
    unsigned* qctr = (unsigned*)(ws + WS_CTL) + CW_Q + 64 * layer;
    const bf16_t* P = (const bf16_t*)(ws + WS_P); const bf16_t* QM = (const bf16_t*)(ws + WS_QM); const bf16_t* KN = (const bf16_t*)(ws + WS_KN);
    const bf16_t* KR = (const bf16_t*)(ws + WS_KR); const bf16_t* VM = (const bf16_t*)(ws + WS_VM); unsigned char* OM = ws + WS_OM;
    volatile LAS unsigned* slot = (volatile LAS unsigned*)(lds + OFF_FLAG + 128);
    constexpr int NQB = 33, NU = 16 * NQB;
    for (;;) {
        if (opaque_tid() == 0) slot[0] = __hip_atomic_fetch_add(qctr, 1u, __ATOMIC_RELAXED, __HIP_MEMORY_SCOPE_AGENT);
        LDS_WAIT(); __syncthreads();
        const unsigned u = slot[0];
        __syncthreads();
        if (u >= 2u * NU) break;
        if (u < (unsigned)NU) {
            const int qb = NQB - 1 - (int)(u / 16), bh = (int)(u % 16), b = bh >> 2, h = bh & 3; const size_t r0 = (size_t)b * NTOK;
            attn_unit<true>(lds, QM + r0 * 768 + h * 192, 768, KN + r0 * 512 + h * 128, 512, KR + r0 * 64, VM + r0 * 512 + h * 128, 512, OM + r0 * 1024 + h * 128, 1024, qb * 256);
        } else {
            const int v = (int)u - NU; const int qb = NQB - 1 - v / 16, bh = v % 16, b = bh >> 2, h = bh & 3; const size_t r0 = (size_t)b * NTOK;
            attn_unit<false>(lds, P + r0 * EVP + EC_SBQ + h * 128, EVP, P + r0 * EVP + EC_SBK + h * 128, EVP, nullptr, P + r0 * EVP + EC_SBV + h * 128, EVP, OM + r0 * 1024 + 512 + h * 128, 1024, qb * 256);
        }
    }
}
}
namespace idx {
__device__ __forceinline__ int crow(int r, int hi) { return (r & 3) + 8 * (r >> 2) + 4 * hi; }
constexpr int KCH = 256;
constexpr int NCH = (NTOK + KCH - 1) / KCH;
constexpr int NITEMS = 17680;
constexpr int NQG = MROWS / 32;

constexpr int SPITCH = 136;
__device__ __forceinline__ unsigned short score_key(float f) { unsigned h; asm volatile("v_cvt_f16_f32 %0, %1" : "=v"(h) : "v"(f)); const int m = ((int)(h << 16)) >> 31; return (unsigned short)(h ^ ((unsigned)m | 0x8000u)); }
__device__ __forceinline__ void phase_indexer(const PArgs& a, LAS unsigned char* lds, int vcu, int G) {
    const int tid = opaque_tid(), lane = tid & 63, wave = __builtin_amdgcn_readfirstlane(tid >> 6), r32 = lane & 31, hh = lane >> 5;
    const int gw = vcu * 8 + wave, NGW = G * 8;
    unsigned char* ws = a.ws;
    const bf16_t* P = (const bf16_t*)(ws + WS_P); unsigned short* SCO = (unsigned short*)(ws + WS_BIG);
    LAS float* wtab = (LAS float*)(lds + wave * 16384);
    LAS unsigned char* stg = lds + wave * 16384 + 1024;
    const int lo = (int)((long)gw * NITEMS / NGW), hi = (int)((long)(gw + 1) * NITEMS / NGW);
    int b = lo / 4420, g = 0, ck = lo % 4420;
#pragma unroll 1
    for (;;) { const int ng_ = (g + 2) / 8 + 1; if (ck < ng_) break; ck -= ng_; ++g; }
    for (int item = lo; item < hi; ) {
        const int nchunk = (g + 2) / 8 + 1; const int take = (hi - item < nchunk - ck) ? hi - item : nchunk - ck;
        const int t0 = g * 32;
        const int lmax = chunk_end(t0 + 31) < NTOK ? chunk_end(t0 + 31) : NTOK;
        const int k0 = ck * KCH;
        const int kend = (k0 + take * KCH < lmax) ? k0 + take * KCH : lmax; const int ntile = (kend - k0 + 31) / 32;
        item += take; ck += take;
        const int b_cur = b, g_done = (ck == nchunk);
        if (g_done) { ck = 0; ++g; if (g == NQG / BATCH) { g = 0; ++b; } }
        const size_t qrow = (size_t)b_cur * NTOK + t0 + r32;
        bf16x8 qa[8][4];
#pragma unroll
        for (int h = 0; h < 8; ++h)
#pragma unroll
            for (int s = 0; s < 4; ++s) qa[h][s] = *(const bf16x8*)(P + qrow * ODP + OC_IQ + h * 64 + s * 16 + hh * 8);
        if (hh == 0) { const u32x4 wv = *(const u32x4*)(P + qrow * ODP + OC_IW);
            const float w8[8] = {bflo(wv.x), bfhi(wv.x), bflo(wv.y), bfhi(wv.y), bflo(wv.z), bfhi(wv.z), bflo(wv.w), bfhi(wv.w)};
#pragma unroll
            for (int h = 0; h < 8; ++h) wtab[h * 32 + r32] = w8[h] * 0.044194173824159216f; }
        LDS_WAIT(); asm volatile("" ::: "memory");
        bf16x8 kb[4], kn[4];
        { const size_t krow = (size_t)b_cur * NTOK + k0 + r32;
#pragma unroll
          for (int s = 0; s < 4; ++s) kb[s] = *(const bf16x8*)(P + krow * ODP + OC_IK + s * 16 + hh * 8); }
        for (int tl = 0; tl < ntile; ++tl) {
            asm volatile("" ::: "memory");
            const int key0 = k0 + 32 * tl;
            { const int kx = (tl + 1 < ntile) ? key0 + 32 : key0; const size_t krow = (size_t)b_cur * NTOK + kx + r32;
#pragma unroll
              for (int s = 0; s < 4; ++s) kn[s] = *(const bf16x8*)(P + krow * ODP + OC_IK + s * 16 + hh * 8); }
            float sc[16];
#pragma unroll
            for (int r = 0; r < 16; ++r) sc[r] = 0.f;
#pragma unroll
            for (int h = 0; h < 8; h += 2) {
                f32x16 xa, xb;
#pragma unroll
                for (int r = 0; r < 16; ++r) { xa[r] = 0.f; xb[r] = 0.f; }
#pragma unroll
                for (int s = 0; s < 4; ++s) { xa = __builtin_amdgcn_mfma_f32_32x32x16_bf16(qa[h][s], kb[s], xa, 0, 0, 0);
                    xb = __builtin_amdgcn_mfma_f32_32x32x16_bf16(qa[h + 1][s], kb[s], xb, 0, 0, 0); SBAR(); }
#pragma unroll
                for (int c = 0; c < 4; ++c) { const f32x4 wa4 = *(const LAS f32x4*)(wtab + h * 32 + 8 * c + 4 * hh), wb4 = *(const LAS f32x4*)(wtab + (h + 1) * 32 + 8 * c + 4 * hh);
#pragma unroll
                    for (int i = 0; i < 4; i += 2) {
                        const int a0 = __float_as_int(xa[4 * c + i]), a1 = __float_as_int(xa[4 * c + i + 1]), b0 = __float_as_int(xb[4 * c + i]), b1 = __float_as_int(xb[4 * c + i + 1]);
                        const f32x2 ra = {__int_as_float(a0 > 0 ? a0 : 0), __int_as_float(a1 > 0 ? a1 : 0)}, rb = {__int_as_float(b0 > 0 ? b0 : 0), __int_as_float(b1 > 0 ? b1 : 0)};
                        const f32x2 wa = {wa4[i], wa4[i + 1]}, wb = {wb4[i], wb4[i + 1]}; f32x2 s2 = {sc[4 * c + i], sc[4 * c + i + 1]};
                        s2 = __builtin_elementwise_fma(wa, ra, s2); s2 = __builtin_elementwise_fma(wb, rb, s2); sc[4 * c + i] = s2[0]; sc[4 * c + i + 1] = s2[1]; } }
            }
            { int cb2 = ((tl & 3) * 32 + r32 + 4 * hh * SPITCH) * 2; asm volatile("" : "+v"(cb2));
#pragma unroll
              for (int r = 0; r < 16; ++r) *(LAS unsigned short*)(stg + cb2 + ((r & 3) + 8 * (r >> 2)) * SPITCH * 2) = score_key(sc[r]); }
            if ((tl & 3) == 3 || tl == ntile - 1) {
                const int ncol = 32 * ((tl & 3) + 1);
                char* gbase = (char*)(SCO + ((size_t)b_cur * NTOK + t0) * NTOK + k0 + 128 * (tl >> 2));
                LDS_WAIT(); asm volatile("" ::: "memory");
                int ln = lane; asm volatile("" : "+v"(ln));
                const int c8 = 8 * (ln & 15); const unsigned goff = (unsigned)((ln >> 4) * NTOK + c8) * 2u; const int soff = ((ln >> 4) * SPITCH + c8) * 2;
                if (c8 < ncol) {
#pragma unroll 1
                    for (int i = 0; i < 8; ++i) { const u32x4 pv = *(const LAS u32x4*)(stg + soff + i * 4 * SPITCH * 2); *(u32x4*)(gbase + goff + (size_t)i * 4 * NTOK * 2) = pv; }
                }
                asm volatile("" ::: "memory");
            }
#pragma unroll
            for (int s = 0; s < 4; ++s) kb[s] = kn[s];
        }
        LDS_WAIT(); asm volatile("" ::: "memory");
    }
}

__device__ __forceinline__ int t5_bucket(int rel) {
    const int base = rel > 0 ? 16 : 0; const int n = rel < 0 ? -rel : rel;
    if (n < 8) return base + n;
    int large = 8 + (31 - __builtin_clz((unsigned)(n * n))) - 6; large = large < 15 ? large : 15;
    return base + large;
}
__device__ __forceinline__ unsigned ord_key(float f) { const unsigned u = __float_as_uint(f); return (u & 0x80000000u) ? ~u : (u | 0x80000000u); }

constexpr int VPITCH = 272;
template <int OFF> __device__ __forceinline__ s16x4 tr_read_i(int vb) { s16x4 r; asm volatile("ds_read_b64_tr_b16 %0, %1 offset:%2" : "=&v"(r) : "v"(vb), "i"(OFF) : "memory"); return r; }
__device__ __forceinline__ void pv_chunk(f32x4 (&oc)[8], int vb, bf16x8 pa) {
    s16x4 lo[8], hi[8];
#define PV_RD(d) lo[d] = tr_read_i<(d) * 32>(vb); hi[d] = tr_read_i<(d) * 32 + 16 * VPITCH>(vb)
    PV_RD(0); PV_RD(1); PV_RD(2); PV_RD(3); PV_RD(4); PV_RD(5); PV_RD(6); PV_RD(7);
#undef PV_RD
    asm volatile("s_waitcnt lgkmcnt(0)" ::: "memory"); SBAR();
#pragma unroll
    for (int d = 0; d < 8; ++d) { const bf16x8 vf = {lo[d][0], lo[d][1], lo[d][2], lo[d][3], hi[d][0], hi[d][1], hi[d][2], hi[d][3]};
        oc[d] = __builtin_amdgcn_mfma_f32_16x16x32_bf16(pa, vf, oc[d], 0, 0, 0); }
}
__device__ __forceinline__ void phase_select_attend(const PArgs& a, LAS unsigned char* lds, int vcu, int G) {
    const int tid = opaque_tid(), lane = tid & 63, wave = __builtin_amdgcn_readfirstlane(tid >> 6);
    const int gw = vcu * 8 + wave, NGW = G * 8;
    unsigned char* ws = a.ws;
    const bf16_t* P = (const bf16_t*)(ws + WS_P); const unsigned short* SCO = (const unsigned short*)(ws + WS_BIG); unsigned char* OM = ws + WS_OM;
    LAS unsigned char* wl = lds + wave * 16384;
    LAS unsigned* hist = (LAS unsigned*)wl;
    LAS unsigned long long* cand = (LAS unsigned long long*)wl;
    LAS unsigned* hist2 = (LAS unsigned*)(wl + 8704);
    LAS unsigned long long* cand2 = (LAS unsigned long long*)(wl + 9728);
    LAS int* bkt = (LAS int*)(wl + 13312);
    LAS float* btab = (LAS float*)(wl + 14336);
    LAS int* sel = (LAS int*)(wl + 15360);
    constexpr int CAP = 1024, CAP2 = 448;
    const unsigned long long lt_mask = (1ull << lane) - 1ull;
    const int hn = lane & 15, g4 = lane >> 4;
    const int vwr = (int)(uintptr_t)wl + (g4 * VPITCH + hn * 16);
    const int vrd = (int)(uintptr_t)wl + ((4 * g4 + (hn >> 2)) * VPITCH + (hn & 3) * 8);
    { const f32x4 tv = *(const f32x4*)(a.in(I_REL) + 4 * lane); *(LAS f32x4*)(btab + 4 * lane) = tv; }
    LDS_WAIT(); asm volatile("" ::: "memory");
#define APPEND(flag, list, count, value) do { const unsigned long long b_ = __ballot(flag); if (flag) (list)[(count) + (int)__builtin_popcountll(b_ & lt_mask)] = (value); (count) += (int)__builtin_popcountll(b_); } while (0)
#define RANK_TAKE(lst, n, nd) do { _Pragma("unroll 1") for (int j0_ = 0; j0_ < (n); j0_ += 64) { const int j_ = j0_ + lane; const bool act_ = j_ < (n); \
        const unsigned long long kj_ = act_ ? (lst)[j_] : 0ull; int rank_ = 0; \
        _Pragma("unroll 4") for (int k_ = 0; k_ < (n); ++k_) rank_ += ((lst)[k_] > kj_) ? 1 : 0; \
        const bool take_ = act_ && rank_ < (nd); APPEND(take_, sel, base, (int)(0xFFFFFFFFu - (unsigned)kj_)); } } while (0)
    const bool paired = (G % 8 == 0); const int cpx = paired ? G / 8 : 1;
    const int nwl = paired ? 16 * cpx : NGW; const int wl0 = paired ? ((vcu / cpx) & 1) * 8 * cpx + (vcu % cpx) * 8 + wave : gw;
    const int qend = paired ? NTOK : MROWS;
    for (int qq = wl0; qq < qend; qq += nwl) {
        const int qi = paired ? (vcu / (2 * cpx)) * NTOK + qq : qq;
        const int b = qi / NTOK, t = qi % NTOK; const size_t row = (size_t)b * NTOK + t;
        const int L = chunk_end(t) < NTOK ? chunk_end(t) : NTOK;
        const bf16_t* Pb = P + (size_t)b * NTOK * ODP;
        int nsel;
        if (L <= 256) {
            nsel = L;
#pragma unroll
            for (int i = 0; i < 4; ++i) sel[64 * i + lane] = 64 * i + lane;
        } else {
            nsel = 256;
            const unsigned short* srow = SCO + row * NTOK;
            unsigned zz = 0u; asm volatile("" : "+v"(zz));
            int sh = 16; unsigned pfx = 0u; int need = 256; unsigned cbin = 0u;
#define CHUNK_LOAD(dst, c0_) do { int l8_ = 8 * lane; asm volatile("" : "+v"(l8_)); _Pragma("unroll") for (int k = 0; k < 8; ++k) { const int idx_ = (c0_) + 512 * k + l8_; dst[k] = __builtin_nontemporal_load((const u32x4*)(srow + (idx_ < L ? idx_ : 0))); } } while (0)
#define KEY16(w, c) (((c) & 1) ? ((w)[(c) >> 1] >> 16) : ((w)[(c) >> 1] & 0xffffu))
#pragma unroll 1
            for (;;) {
                const int nb = sh >= 11 ? 11 : sh; const int nsh = sh - nb; const unsigned dmask = (1u << nb) - 1u; const bool first = (sh == 16); const unsigned pv0 = first ? 0u : (pfx >> sh);
#pragma unroll 1
                for (int i = 0; i < 8; ++i) *(LAS u32x4*)(wl + i * 1024 + lane * 16) = (u32x4){zz, zz, zz, zz};
                u32x4 v[8];
                LDS_WAIT(); asm volatile("" ::: "memory");
#pragma unroll 1
                for (int c0 = 0; c0 < L; c0 += 4096) {
                    CHUNK_LOAD(v, c0);
                    int l8 = 8 * lane; asm volatile("" : "+v"(l8));
#pragma unroll
                    for (int k = 0; k < 8; ++k) { const bool ok = (c0 + 512 * k + l8) < L;
#pragma unroll
                        for (int c = 0; c < 8; ++c) { const unsigned u = KEY16(v[k], c); const bool match = ok && (first || ((u >> sh) == pv0));
                            if (match) __hip_atomic_fetch_add(hist + ((u >> nsh) & dmask), 1u, __ATOMIC_RELAXED, __HIP_MEMORY_SCOPE_WORKGROUP); } }
                }
                LDS_WAIT(); asm volatile("" ::: "memory");
                unsigned loc = 0u;
#pragma unroll
                for (int i = 0; i < 8; ++i) { const u32x4 h4 = *(const LAS u32x4*)(hist + 32 * lane + 4 * i); loc += (h4.x + h4.y) + (h4.z + h4.w); }
                unsigned above = loc;
#pragma unroll
                for (int o = 1; o < 64; o <<= 1) { const unsigned vv = __shfl_down(above, o); if (lane + o < 64) above += vv; }
                const unsigned excl = above - loc;
                const bool mine = (excl < (unsigned)need) && ((unsigned)need <= above);
                const unsigned long long bal = __ballot(mine);
                const int owner = (int)__builtin_ctzll(bal ? bal : 1ull);
                unsigned run = excl; int bsel = 0; unsigned abv = excl, cb = 0u; bool found = false;
#pragma unroll 1
                for (int i = 7; i >= 0; --i) { const u32x4 h4 = *(const LAS u32x4*)(hist + 32 * lane + 4 * i); const unsigned hv[4] = {h4.x, h4.y, h4.z, h4.w};
#pragma unroll
                    for (int k = 3; k >= 0; --k) { const unsigned nr = run + hv[k]; const bool hit = !found && (nr >= (unsigned)need); bsel = hit ? 4 * i + k : bsel; abv = hit ? run : abv; cb = hit ? hv[k] : cb; found = found || hit; run = nr; } }
                const unsigned bin = (unsigned)__shfl(32 * lane + bsel, owner); const unsigned abv_b = (unsigned)__shfl((int)abv, owner); cbin = (unsigned)__shfl((int)cb, owner);
                pfx |= bin << nsh; need -= (int)abv_b; sh = nsh;
                if (cbin <= (unsigned)CAP || sh == 0) break;
            }
            const bool alleq = (sh == 0) && (cbin > (unsigned)CAP);
            const unsigned pv = pfx >> sh;
            int base = 0, ccount = 0;
            if (!alleq) {
                { u32x4 v[8];
#pragma unroll 1
                for (int c0 = 0; c0 < L; c0 += 4096) {
                    CHUNK_LOAD(v, c0);
                    int l8 = 8 * lane; asm volatile("" : "+v"(l8));
#pragma unroll
                    for (int k = 0; k < 8; ++k) { const int idx = c0 + 512 * k + l8; const bool ok = idx < L;
#pragma unroll
                        for (int c = 0; c < 8; ++c) { const unsigned u = KEY16(v[k], c); const unsigned hi = u >> sh;
                            const bool sure = ok && hi > pv, isc = ok && hi == pv;
                            const unsigned long long bt = __ballot(sure), bc = __ballot(isc);
                            if (bt | bc) {
                                if (sure) sel[base + (int)__builtin_popcountll(bt & lt_mask)] = idx + c;
                                if (isc) cand[ccount + (int)__builtin_popcountll(bc & lt_mask)] = ((unsigned long long)u << 32) | (unsigned long long)(0xFFFFFFFFu - (unsigned)(idx + c));
                                base += (int)__builtin_popcountll(bt); ccount += (int)__builtin_popcountll(bc); } } }
                } }
                LDS_WAIT(); asm volatile("" ::: "memory");
                bool done = false;
                if (sh >= 8 && ccount > 64) {
                    *(LAS u32x4*)(hist2 + 4 * lane) = (u32x4){zz, zz, zz, zz};
                    LDS_WAIT(); asm volatile("" ::: "memory");
                    const int s2 = 32 + sh - 8;
#pragma unroll 1
                    for (int j0 = 0; j0 < ccount; j0 += 64) { const int j = j0 + lane; if (j < ccount) __hip_atomic_fetch_add(hist2 + (unsigned)((cand[j] >> s2) & 255ull), 1u, __ATOMIC_RELAXED, __HIP_MEMORY_SCOPE_WORKGROUP); }
                    LDS_WAIT(); asm volatile("" ::: "memory");
                    const u32x4 h4 = *(const LAS u32x4*)(hist2 + 4 * lane); const unsigned loc2 = (h4.x + h4.y) + (h4.z + h4.w);
                    unsigned ab2 = loc2;
#pragma unroll
                    for (int o = 1; o < 64; o <<= 1) { const unsigned vv = __shfl_down(ab2, o); if (lane + o < 64) ab2 += vv; }
                    const unsigned ex2 = ab2 - loc2; const bool mine2 = (ex2 < (unsigned)need) && ((unsigned)need <= ab2);
                    const unsigned long long bal2 = __ballot(mine2); const int own2 = (int)__builtin_ctzll(bal2 ? bal2 : 1ull);
                    unsigned run2 = ex2; int bs2 = 0; unsigned av2 = ex2, cb2 = 0u; bool f2 = false; const unsigned hv2[4] = {h4.x, h4.y, h4.z, h4.w};
#pragma unroll
                    for (int k = 3; k >= 0; --k) { const unsigned nr = run2 + hv2[k]; const bool hit = !f2 && (nr >= (unsigned)need); bs2 = hit ? k : bs2; av2 = hit ? run2 : av2; cb2 = hit ? hv2[k] : cb2; f2 = f2 || hit; run2 = nr; }
                    const unsigned bin2 = (unsigned)__shfl(4 * lane + bs2, own2); const unsigned abv2 = (unsigned)__shfl((int)av2, own2); const unsigned cnt2 = (unsigned)__shfl((int)cb2, own2);
                    if (cnt2 <= (unsigned)CAP2) {
                        int c2 = 0;
#pragma unroll 1
                        for (int j0 = 0; j0 < ccount; j0 += 64) { const int j = j0 + lane; const bool act = j < ccount; const unsigned long long kj = act ? cand[j] : 0ull;
                            const unsigned sub = (unsigned)((kj >> s2) & 255ull); const bool sure2 = act && sub > bin2, isc2 = act && sub == bin2;
                            APPEND(sure2, sel, base, (int)(0xFFFFFFFFu - (unsigned)kj));
                            APPEND(isc2, cand2, c2, kj); }
                        LDS_WAIT(); asm volatile("" ::: "memory");
                        const int need2 = need - (int)abv2;
                        RANK_TAKE(cand2, c2, need2);
                        done = true;
                    }
                }
                if (!done) RANK_TAKE(cand, ccount, need);
            } else {
#pragma unroll 2
                for (int i0 = 0; i0 < L; i0 += 64) { const int s = i0 + lane; const bool valid = s < L;
                    const unsigned u = valid ? (unsigned)srow[s < L ? s : L - 1] : 0u;
                    const bool sure = valid && u > pv, isc = valid && u == pv;
                    const unsigned long long bc = __ballot(isc); const int crank = ccount + (int)__builtin_popcountll(bc & lt_mask);
                    const bool take = sure || (isc && crank < need);
                    ccount += (int)__builtin_popcountll(bc);
                    APPEND(take, sel, base, s); }
            }
#undef CHUNK_LOAD
#undef KEY16
        }
        LDS_WAIT(); asm volatile("" ::: "memory");
#pragma unroll
        for (int i = 0; i < 4; ++i) { const int jj = 64 * i + lane; bkt[jj] = t5_bucket(((jj < nsel) ? sel[jj] : t) - t) * 8; }
        bf16x8 qb[4];
#pragma unroll
        for (int kk = 0; kk < 4; ++kk) { bf16x8 z = {0, 0, 0, 0, 0, 0, 0, 0}; qb[kk] = (hn < 8) ? *(const bf16x8*)(P + row * ODP + OC_Q + hn * 128 + kk * 32 + g4 * 8) : z; }
        f32x4 sa[16];
#pragma unroll
        for (int tb = 0; tb < 4; ++tb) {
            bf16x8 ka[4][4]; int hno = hn; asm volatile("" : "+v"(hno));
#pragma unroll
            for (int u = 0; u < 4; ++u) { const int jj = 16 * (4 * tb + u) + hno; const int key = (jj < nsel) ? sel[jj] : 0; const unsigned koff = (unsigned)(key * ODP + OC_K + g4 * 8) * 2u;
#pragma unroll
                for (int kk = 0; kk < 4; ++kk) ka[u][kk] = *(const bf16x8*)((const char*)Pb + koff + kk * 64); }
#pragma unroll
            for (int u = 0; u < 4; ++u) { f32x4 acc = {0.f, 0.f, 0.f, 0.f};
#pragma unroll
                for (int kk = 0; kk < 4; ++kk) acc = __builtin_amdgcn_mfma_f32_16x16x32_bf16(ka[u][kk], qb[kk], acc, 0, 0, 0);
                sa[4 * tb + u] = acc; }
            asm volatile("" ::: "memory");
        }
        bf16x8 vr0[8], vr1[8];
#define V_LOAD(dst, c) do { int g4o_ = g4; asm volatile("" : "+v"(g4o_)); _Pragma("unroll") for (int i_ = 0; i_ < 8; ++i_) { const int jj_ = 32 * (c) + g4o_ + 4 * i_; const int key_ = (jj_ < nsel) ? sel[jj_] : 0; \
            dst[i_] = *(const bf16x8*)((const char*)Pb + (unsigned)(key_ * ODP + OC_V + hn * 8) * 2u); } } while (0)
#define V_WRITE(src) do { _Pragma("unroll") for (int i_ = 0; i_ < 8; ++i_) *(LAS bf16x8*)(uintptr_t)(vwr + 4 * i_ * VPITCH) = src[i_]; } while (0)
        V_LOAD(vr0, 0); V_LOAD(vr1, 1);
        float mx = -1e30f; int g4b = 4 * g4; asm volatile("" : "+v"(g4b));
#pragma unroll
        for (int tl = 0; tl < 16; ++tl) { const i32x4 b4 = *(const LAS i32x4*)(bkt + 16 * tl + 4 * g4); const int bb[4] = {b4.x, b4.y, b4.z, b4.w};
#pragma unroll
            for (int i = 0; i < 4; ++i) { const int jj = 16 * tl + g4b + i; const bool ok = jj < nsel;
                const float bias = btab[bb[i] + (hn & 7)];
                const float s = ok ? sa[tl][i] * 0.088388347648318440f + bias : -1e30f; sa[tl][i] = s; mx = fmaxf(mx, s); } }
        mx = fmaxf(mx, __shfl_xor(mx, 16)); mx = fmaxf(mx, __shfl_xor(mx, 32));
        float sum = 0.f;
#pragma unroll
        for (int tl = 0; tl < 16; ++tl)
#pragma unroll
            for (int i = 0; i < 4; ++i) { const float p = __builtin_amdgcn_exp2f((sa[tl][i] - mx) * 1.4426950408889634f); sa[tl][i] = p; sum += p; }
        sum += __shfl_xor(sum, 16); sum += __shfl_xor(sum, 32);
        const float rs = 1.0f / sum;
        f32x4 oc[8];
#pragma unroll
        for (int d = 0; d < 8; ++d) oc[d] = (f32x4){0.f, 0.f, 0.f, 0.f};
#define PV_CHUNK(c, cur) do { \
            if ((c) + 1 < 8) asm volatile("s_waitcnt vmcnt(8)" ::: "memory"); else asm volatile("s_waitcnt vmcnt(0)" ::: "memory"); \
            V_WRITE(cur); if ((c) + 2 < 8) V_LOAD(cur, (c) + 2); \
            const f32x4 pa_ = sa[2 * (c)] * rs, pb_ = sa[2 * (c) + 1] * rs; \
            u32x4 pw; pw.x = cvtpk(pa_[0], pa_[1]); pw.y = cvtpk(pa_[2], pa_[3]); pw.z = cvtpk(pb_[0], pb_[1]); pw.w = cvtpk(pb_[2], pb_[3]); \
            const bf16x8 pf = __builtin_bit_cast(bf16x8, pw); \
            LDS_WAIT(); asm volatile("" ::: "memory"); \
            pv_chunk(oc, vrd, pf); } while (0)
        PV_CHUNK(0, vr0); PV_CHUNK(1, vr1); PV_CHUNK(2, vr0); PV_CHUNK(3, vr1); PV_CHUNK(4, vr0); PV_CHUNK(5, vr1); PV_CHUNK(6, vr0); PV_CHUNK(7, vr1);
#undef PV_CHUNK
#undef V_LOAD
#undef V_WRITE
        if (g4 < 2) {
#pragma unroll
            for (int dt = 0; dt < 8; ++dt)
#pragma unroll
                for (int i = 0; i < 4; ++i) OM[row * 1024 + (4 * g4 + i) * 128 + 16 * dt + hn] = om_fp8(oc[dt][i]);
        }
        LDS_WAIT(); asm volatile("" ::: "memory");
    }
#undef APPEND
#undef RANK_TAKE
}
}
typedef __attribute__((address_space(1))) unsigned char gu8_t;
#define PH_ARGS const KArgs& ka, unsigned lds_off
#define PH_SETUP PArgs a{ka, opaque_ws(ka.ws)}; LAS unsigned char* lds = (LAS unsigned char*)(uintptr_t)lds_off; unsigned char* ws = a.ws; (void)ws; (void)lds; \
    int G_ = gridDim.x, bx_ = blockIdx.x; asm volatile("" : "+s"(G_), "+s"(bx_)); const int G = G_, bx = bx_; const int vcu = (G % 8 == 0) ? (bx % 8) * (G / 8) + bx / 8 : bx; (void)vcu

__device__ __forceinline__ void ph_prologue(PH_ARGS) { PH_SETUP; phase_prologue(a, lds, vcu, G); }
__device__ __forceinline__ void ph_inproj(PH_ARGS, int layer) { PH_SETUP;
    const int jl = layer >> 1; const bool even = (layer & 1) == 0; const int N = even ? EVP : ODP;
    const bf16_t* Bt = even ? (const bf16_t*)(ws + WS_WINE + jl * SZ_WINE) : (const bf16_t*)(ws + WS_WINO + jl * SZ_WINO);
    pg8::DenseOrder S; S.init(MROWS, N, G, bx);
    pg8::EpiBf16 E{(bf16_t*)(ws + WS_P), N, 1.0f / FP8_WSCALE};
    pg8::gemm_phase<pg8::EpiBf16, pg8::DenseOrder, true>(lds, (const bf16_t*)(ws + WS_HB8), DM / 2, Bt, DM / 2, S, E);
}
__device__ __forceinline__ void ph_latent(PH_ARGS, int jl) { PH_SETUP; phase_latent_norm(a, jl, vcu, G); }
__device__ __forceinline__ void ph_upq(PH_ARGS, int jl) { PH_SETUP;
    pg8::DenseOrder S; S.init(MROWS, 768, G, bx);
    pg8::EpiQ E{(bf16_t*)(ws + WS_QM), (const float*)(ws + WS_ROPE)};
    pg8::gemm_phase<pg8::EpiQ, pg8::DenseOrder>(lds, (const bf16_t*)(ws + WS_QN), 512, (const bf16_t*)(ws + WS_WUQ + jl * SZ_WUQ), 512, S, E);
}
__device__ __forceinline__ void ph_upkv(PH_ARGS, int jl) { PH_SETUP;
    pg8::DenseOrder S; S.init(MROWS, 1024, G, bx);
    pg8::EpiKV E{(bf16_t*)(ws + WS_KN), (bf16_t*)(ws + WS_VM)};
    pg8::gemm_phase<pg8::EpiKV, pg8::DenseOrder>(lds, (const bf16_t*)(ws + WS_KVN), 256, (const bf16_t*)(ws + WS_WUKV + jl * SZ_WUKV), 256, S, E);
}
__device__ __forceinline__ void ph_attn(PH_ARGS, int layer) { PH_SETUP; att::phase_attention(a, lds, layer); }
__device__ __forceinline__ void ph_indexer(PH_ARGS) { PH_SETUP; idx::phase_indexer(a, lds, vcu, G); }
__device__ __forceinline__ void ph_select(PH_ARGS) { PH_SETUP; idx::phase_select_attend(a, lds, vcu, G); }
__device__ __forceinline__ void ph_outproj(PH_ARGS, int layer) { PH_SETUP;
    const int jl = layer >> 1; const bool even = (layer & 1) == 0;
    const bf16_t* Bt = even ? (const bf16_t*)(ws + WS_WOUTE + jl * SZ_WOUT) : (const bf16_t*)(ws + WS_WOUTO + jl * SZ_WOUT);
    pg8::DenseOrder S; S.init(MROWS, DM, G, bx);
    pg8::EpiOut E{(const bf16_t*)(ws + WS_HB), (bf16_t*)(ws + WS_Y), (float*)(ws + WS_STAT)};
    pg8::gemm_phase<pg8::EpiOut, pg8::DenseOrder, true>(lds, (const bf16_t*)(ws + WS_OM), 1024 / 2, Bt, 1024 / 2, S, E);
}
__device__ __forceinline__ void ph_lnroute(PH_ARGS, int layer, int cslot) { PH_SETUP; phase_ln_route(a, layer, cslot, lds, vcu, G); }
__device__ __forceinline__ void ph_expert_up(PH_ARGS, int layer) { PH_SETUP;
    const unsigned* cnt = (const unsigned*)(ws + WS_CTL) + CW_CNT + 2048 * layer; LAS int* tstart = (LAS int*)(lds + TBL_OFF);
    build_tile_table(cnt, tstart);
    pg8::MoeOrder S{tstart, cnt, (const int*)(ws + WS_ROWTOK), 4, G, vcu, true, false};
    pg8::EpiSwiglu E{(bf16_t*)(ws + WS_ACT), a.in(I_EBIN) + (size_t)layer * NEXP * 1024};
    pg8::gemm_phase<pg8::EpiSwiglu, pg8::MoeOrder, true>(lds, (const bf16_t*)(ws + WS_HB8), DM / 2, (const bf16_t*)(ws + WS_WEI + (size_t)layer * NEXP * SZ_WEI), DM / 2, S, E);
}
__device__ __forceinline__ void ph_expert_down(PH_ARGS, int layer) { PH_SETUP;
    const unsigned* cnt = (const unsigned*)(ws + WS_CTL) + CW_CNT + 2048 * layer; LAS int* tstart = (LAS int*)(lds + TBL_OFF);
    pg8::MoeOrder S{tstart, cnt, (const int*)(ws + WS_ROWTOK), 8, G, vcu, false, false};
    pg8::EpiDown E{(unsigned char*)(ws + WS_YEXP), a.in(I_EBOUT) + (size_t)layer * NEXP * DM};
    pg8::gemm_phase<pg8::EpiDown, pg8::MoeOrder, true>(lds, (const bf16_t*)(ws + WS_ACT), DFF / 2, (const bf16_t*)(ws + WS_WEO + (size_t)layer * NEXP * SZ_WEO), DFF / 2, S, E);
}
__device__ __forceinline__ void ph_combine(PH_ARGS, int layer, bool dummy) { PH_SETUP;
    if (layer == DEPTH - 1) phase_combine_ln<true>(a, layer, (const LAS int*)(lds + TBL_OFF), vcu, G, dummy); else phase_combine_ln<false>(a, layer, (const LAS int*)(lds + TBL_OFF), vcu, G, dummy); }

__global__ void __launch_bounds__(512, 2) mk_fwd(KArgs a) {
    extern __shared__ __attribute__((aligned(16))) unsigned char lds_raw[];
    LAS unsigned char* lds = (LAS unsigned char*)lds_raw;
    const int tid = threadIdx.x;
    for (int u = tid; u < (LDS_BYTES - LDS_CTL) / 4; u += 512) ((LAS unsigned*)(lds + LDS_CTL))[u] = 0u;
    __syncthreads();
    const unsigned lo = (unsigned)(uintptr_t)lds;
    gu32_t* barw = (gu32_t*)(a.ws + WS_CTL) + CW_BAR; const unsigned st_off = lo + MISC_OFF + 32;
    const unsigned xcc = xcd_barrier_post((unsigned*)barw, (volatile LAS unsigned*)(uintptr_t)st_off).x;
#define GRID_BAR() xcd_barrier(barw, xcc, st_off)

    ph_prologue(a, lo);
    GRID_BAR();
#pragma unroll 1
    for (int layer = 0; layer < DEPTH; ++layer) {
        const int jl = layer >> 1; const bool even = (layer & 1) == 0;
        ph_inproj(a, lo, layer);
        GRID_BAR();
        if (even) {
            ph_latent(a, lo, jl);
            GRID_BAR();
            ph_upq(a, lo, jl);
            ph_upkv(a, lo, jl);
            GRID_BAR();
            ph_attn(a, lo, layer);
            GRID_BAR();
        } else {
            ph_indexer(a, lo);
            GRID_BAR();
            ph_select(a, lo);
            GRID_BAR();
        }
        ph_outproj(a, lo, layer);
        GRID_BAR();
        ph_lnroute(a, lo, layer, layer);
        GRID_BAR();
        ph_expert_up(a, lo, layer);
        GRID_BAR();
        ph_expert_down(a, lo, layer);
        GRID_BAR();
        ph_combine(a, lo, layer, false);
        if (layer + 1 < DEPTH) GRID_BAR();
    }
}

extern "C" void kernel_launch(void* const* d_in, const int* in_sizes, int n_in, void* d_out, int out_size, void* d_ws, size_t ws_size, hipStream_t stream) {
    static int grid = 0;
    if (grid == 0) {
        if (n_in != 19 || ws_size < WS_END) { fprintf(stderr, "kernel_launch: n_in %d (want 19), ws %zu (need %zu)\n", n_in, ws_size, (size_t)WS_END); grid = -1; return; }
        int dev = 0, cus = 0, per_cu = 0;
        if (hipGetDevice(&dev) != hipSuccess || hipDeviceGetAttribute(&cus, hipDeviceAttributeMultiprocessorCount, dev) != hipSuccess) { grid = -1; return; }
        if (hipFuncSetAttribute((const void*)mk_fwd, hipFuncAttributeMaxDynamicSharedMemorySize, LDS_BYTES) != hipSuccess) { fprintf(stderr, "kernel_launch: hipFuncSetAttribute failed\n"); grid = -1; return; }
        if (hipOccupancyMaxActiveBlocksPerMultiprocessor(&per_cu, (const void*)mk_fwd, 512, LDS_BYTES) != hipSuccess || per_cu < 1)
            fprintf(stderr, "kernel_launch: occupancy query reports %d workgroups per CU\n", per_cu);
        (void)hipGetLastError();
        grid = cus > 0 ? cus : 256;
    }
    if (grid < 0) return;
    if (hipMemsetAsync((char*)d_ws + WS_CTL, 0, CTL_BYTES, stream) != hipSuccess) return;
    KArgs a{};
    for (int i = 0; i < 19; ++i) a.in[i] = (const float*)d_in[i];
    a.out = (float*)d_out; a.ws = (unsigned char*)d_ws;
    hipLaunchKernelGGL(mk_fwd, dim3(grid), dim3(512), LDS_BYTES, stream, a);
    (void)hipPeekAtLastError();
}
```

```cpp
#include <hip/hip_runtime.h>
#include <cstdio>
#include <cstdint>

#define LAS __attribute__((address_space(3)))
typedef unsigned short bf16_t;
typedef short bf16x8 __attribute__((ext_vector_type(8)));
typedef short s16x4 __attribute__((ext_vector_type(4)));
typedef float f32x2 __attribute__((ext_vector_type(2)));
typedef float f32x4 __attribute__((ext_vector_type(4)));
typedef float f32x16 __attribute__((ext_vector_type(16)));
typedef unsigned u32x2 __attribute__((ext_vector_type(2)));
typedef unsigned u32x4 __attribute__((ext_vector_type(4)));
typedef int i32x4 __attribute__((ext_vector_type(4)));

constexpr int BATCH = 4, NTOK = 8320, MROWS = BATCH * NTOK, DM = 2048, SEQ = 8192, NMETA = 16, DEPTH = 4;
constexpr int NEXP = 32, DFF = 512;
constexpr float DN_ALPHA = 1.6817928305074290f;
constexpr float LN_EPS = 1e-5f, RMS_EPS = 1e-6f;
constexpr int EVP = 2560;
constexpr int ODP = 2048;
constexpr int MAXSLOT = MROWS * 4 + NEXP * 256;
constexpr int EC_QLAT = 0, EC_KVLAT = 512, EC_SBQ = 768, EC_SBK = 1280, EC_SBV = 1792, EC_KROPE = 2304;
constexpr int OC_Q = 0, OC_K = 1024, OC_V = 1152, OC_IQ = 1280, OC_IK = 1792, OC_IW = 1856;

constexpr size_t MiB = 1u << 20;
constexpr size_t alignup(size_t x) { return (x + 4095) & ~(size_t)4095; }
constexpr size_t WS_CTL = 0, CTL_BYTES = 1 * MiB;
constexpr size_t SZ_WINE = (size_t)EVP * DM * 2, SZ_WUQ = 768 * 512 * 2, SZ_WUKV = 1024 * 256 * 2, SZ_WOUT = (size_t)DM * 1024 * 2, SZ_WINO = (size_t)ODP * DM * 2;
constexpr size_t SZ_WEI = (size_t)1024 * DM, SZ_WEO = (size_t)DM * DFF  , SZ_WR = (size_t)32 * DM * 2;
constexpr size_t WS_WINE = WS_CTL + CTL_BYTES;
constexpr size_t WS_WUQ = WS_WINE + 2 * SZ_WINE;
constexpr size_t WS_WUKV = WS_WUQ + 2 * SZ_WUQ;
constexpr size_t WS_WOUTE = WS_WUKV + 2 * SZ_WUKV;
constexpr size_t WS_WINO = WS_WOUTE + 2 * SZ_WOUT;
constexpr size_t WS_WOUTO = WS_WINO + 2 * SZ_WINO;
constexpr size_t WS_WEI = WS_WOUTO + 2 * SZ_WOUT;
constexpr size_t WS_WEO = WS_WEI + (size_t)DEPTH * NEXP * SZ_WEI;
constexpr size_t WS_WRH = WS_WEO + (size_t)DEPTH * NEXP * SZ_WEO;
constexpr size_t WS_WRL = WS_WRH + DEPTH * SZ_WR;
constexpr size_t WS_ROPE = WS_WRL + DEPTH * SZ_WR;
constexpr size_t WS_H = alignup(WS_ROPE + (size_t)NTOK * 64 * 4);
constexpr size_t WS_HB8 = WS_H;
constexpr size_t WS_HB = WS_H + (size_t)MROWS * DM * 4;
constexpr size_t WS_Y = WS_HB + (size_t)MROWS * DM * 2;
constexpr size_t WS_STAT = WS_Y + (size_t)MROWS * DM * 4;
constexpr size_t WS_P = WS_STAT + (size_t)MROWS * 64 * 4;
constexpr size_t WS_QN = WS_P + (size_t)MROWS * EVP * 2;
constexpr size_t WS_KVN = WS_QN + (size_t)MROWS * 512 * 2;
constexpr size_t WS_QM = WS_KVN + (size_t)MROWS * 256 * 2;
constexpr size_t WS_KN = WS_QM + (size_t)MROWS * 768 * 2;
constexpr size_t WS_VM = WS_KN + (size_t)MROWS * 512 * 2;
constexpr size_t WS_KR = WS_VM + (size_t)MROWS * 512 * 2;
constexpr size_t WS_OM = WS_KR + (size_t)MROWS * 64 * 2;
constexpr size_t WS_TOPE = WS_OM + (size_t)MROWS * 1024 * 2;
constexpr size_t WS_TOPP = WS_TOPE + (size_t)MROWS * 16;
constexpr size_t WS_TOPG = WS_TOPP + (size_t)MROWS * 16;
constexpr size_t WS_ROWTOK = WS_TOPG + (size_t)MROWS * 16;
constexpr size_t WS_BIG = alignup(WS_ROWTOK + (size_t)NEXP * MROWS * 4);
constexpr size_t SZ_SCORES = (size_t)BATCH * NTOK * NTOK * 4;
constexpr size_t WS_ACT = WS_BIG, WS_YEXP = WS_BIG + alignup((size_t)MAXSLOT * DFF * 2);
constexpr size_t WS_END = WS_BIG + SZ_SCORES;
static_assert(WS_YEXP + (size_t)MAXSLOT * DM * 2 <= WS_END, "alias region");
constexpr size_t WS_ARGTAB = 512 * 1024;
constexpr int CW_BAR = 4096, CW_CNT = 16384  , CW_Q = 32768  , CW_ERR = 65536;

constexpr int LDS_BYTES = 147456, LDS_CTL = 131072, MISC_OFF = LDS_CTL + 320, TBL_OFF = LDS_CTL + 1024;

#define LDS_WAIT() asm volatile("s_waitcnt lgkmcnt(0)" ::: "memory")
#define VM_WAIT() asm volatile("s_waitcnt vmcnt(0)" ::: "memory")
#define SBAR() __builtin_amdgcn_sched_barrier(0)

__device__ __forceinline__ unsigned cvtpk(float lo, float hi) { unsigned r; asm volatile("v_cvt_pk_bf16_f32 %0, %1, %2" : "=v"(r) : "v"(lo), "v"(hi)); return r; }
typedef int i32x8 __attribute__((ext_vector_type(8)));
__device__ __forceinline__ unsigned cvt4_fp8(float a, float b, float c, float d) { int w = __builtin_amdgcn_cvt_pk_fp8_f32(a, b, 0, false); w = __builtin_amdgcn_cvt_pk_fp8_f32(c, d, w, true); return (unsigned)w; }
constexpr float OM_SCALE = 64.0f;
__device__ __forceinline__ unsigned char om_fp8(float v) { v = fminf(fmaxf(v * OM_SCALE, -448.0f), 448.0f); return (unsigned char)(__builtin_amdgcn_cvt_pk_fp8_f32(v, v, 0, false) & 0xff); }
constexpr float FP8_WSCALE = 32.0f;
__device__ __forceinline__ float bf2f(unsigned short b) { return __uint_as_float(((unsigned)b) << 16); }
__device__ __forceinline__ float bflo(unsigned w) { return __uint_as_float(w << 16); }
__device__ __forceinline__ float bfhi(unsigned w) { return __uint_as_float(w & 0xffff0000u); }
__device__ __forceinline__ float wave_sum(float v) {
#pragma unroll
    for (int o = 1; o < 64; o <<= 1) v += __shfl_xor(v, o);
    return v;
}
typedef __attribute__((address_space(1))) unsigned char gu8_t;
__device__ __forceinline__ int opaque_tid() { int t = (int)threadIdx.x; asm volatile("" : "+v"(t)); return t; }
__device__ __forceinline__ unsigned char* opaque_ws(unsigned char* p) { size_t z = 0; asm volatile("" : "+s"(z)); return p + z; }
__device__ __forceinline__ int chunk_end(int t) { return t < NMETA ? NMETA : NMETA + 64 * ((t - NMETA) / 64 + 1); }

#define XB_TMO      128
#define XB_XCNT(j)  (256  + 64 * (j))
#define XB_XSUB(j)  (1280 + 64 * (j))
#define XB_XGEN(j)  (2304 + 64 * (j))
#define XB_TOP      3328
#define XB_TOPGEN   3392
#define XCD_BAR_WORDS 3456
#define XB_SPIN_CAP (1u << 18)
__device__ __forceinline__ unsigned xb_ld(unsigned* p)              { return __hip_atomic_load(p, __ATOMIC_RELAXED, __HIP_MEMORY_SCOPE_AGENT); }
__device__ __forceinline__ unsigned xb_add(unsigned* p, unsigned v) { return __hip_atomic_fetch_add(p, v, __ATOMIC_RELAXED, __HIP_MEMORY_SCOPE_AGENT); }
__device__ __forceinline__ unsigned xb_xcc_id() { return (unsigned)__builtin_amdgcn_s_getreg((3 << 11) | 20) & 0xFu; }
#define XB_SPIN(cond, bar) do { unsigned _sp = 0; while (cond) { __builtin_amdgcn_s_sleep(1); \
    if ((++_sp & 255u) == 0u) { if (xb_ld(&(bar)[XB_TMO])) break; if (_sp > XB_SPIN_CAP) { atomicAdd(&(bar)[XB_TMO], 1u); break; } } } } while (0)
struct XcdBarrier { unsigned* bar; unsigned x; volatile LAS unsigned* st; };
__device__ __forceinline__ XcdBarrier xcd_barrier_post(unsigned* bar, volatile LAS unsigned* st) {
    XcdBarrier b; b.bar = bar; b.x = xb_xcc_id(); b.st = st;
    if (threadIdx.x == 0) (void)xb_add(&bar[XB_XCNT(b.x)], 1u);
    return b;
}
__device__ __forceinline__ void xcd_barrier_complete(unsigned* bar, unsigned x, unsigned& nloc, unsigned& nx) {
    const unsigned G = gridDim.x * gridDim.y * gridDim.z;
    unsigned sum, cnt, mine, sp = 0u;
    for (;;) {
        sum = 0u; cnt = 0u; mine = 0u;
#pragma unroll
        for (unsigned j = 0; j < 16; ++j) { const unsigned c = xb_ld(&bar[XB_XCNT(j)]); sum += c; cnt += (c > 0u) ? 1u : 0u; mine = (j == x) ? c : mine; }
        if (sum == G) break;
        __builtin_amdgcn_s_sleep(1);
        if ((++sp & 255u) == 0u) { if (xb_ld(&bar[XB_TMO])) break; if (sp > XB_SPIN_CAP) { atomicAdd(&bar[XB_TMO], 1u); break; } }
    }
    nloc = mine > 0u ? mine : 1u; nx = cnt > 0u ? cnt : 1u;
}
typedef __attribute__((address_space(1))) unsigned gu32_t;
__device__ __forceinline__ void xcd_barrier_body(const XcdBarrier& b) {
    asm volatile("s_waitcnt vmcnt(0)" ::: "memory");
    __syncthreads();
    if (opaque_tid() == 0) {
        size_t z_ = 0; asm volatile("" : "+s"(z_));
        unsigned* bar = b.bar + z_; unsigned bxx = b.x; asm volatile("" : "+s"(bxx));
        __builtin_amdgcn_s_waitcnt(0);
        unsigned nloc = b.st[0], nx = b.st[1];
        if (nloc == 0u) { xcd_barrier_complete(bar, bxx, nloc, nx); b.st[0] = nloc; b.st[1] = nx; }
        const unsigned old = xb_add(&bar[XB_XSUB(bxx)], 1u);
        const unsigned gen = old / nloc;
        if (old + 1u == (gen + 1u) * nloc) {
            __builtin_amdgcn_fence(__ATOMIC_RELEASE, "agent");
            asm volatile("s_waitcnt vmcnt(0)" ::: "memory");
            const unsigned og = xb_add(&bar[XB_TOP], 1u);
            const unsigned tg = og / nx;
            if (og + 1u == (tg + 1u) * nx) xb_add(&bar[XB_TOPGEN], 1u);
            else XB_SPIN(xb_ld(&bar[XB_TOPGEN]) == tg, bar);
            __builtin_amdgcn_fence(__ATOMIC_ACQUIRE, "agent");
            xb_add(&bar[XB_XGEN(bxx)], 1u);
            asm volatile("s_waitcnt vmcnt(0)" ::: "memory");
        } else {
            XB_SPIN(xb_ld(&bar[XB_XGEN(bxx)]) == gen, bar);
            __builtin_amdgcn_fence(__ATOMIC_ACQUIRE, "agent");
            asm volatile("s_waitcnt vmcnt(0)" ::: "memory");
        }
    }
    __syncthreads();
}

__device__ __forceinline__ void xcd_barrier(gu32_t* barg, unsigned x, unsigned st_off) {
    XcdBarrier b; b.bar = (unsigned*)barg; b.x = x; b.st = (volatile LAS unsigned*)(uintptr_t)st_off;
    xcd_barrier_body(b);
}

namespace pg8 {
constexpr int BM = 256, BK = 64, HALF = 128, HTB = HALF * BK * 2, STAGE_BYTES = 8 * HTB, NXCD = 8, WGM = 8;
__device__ __forceinline__ int lds_byte(int r, int c) { const int st = (r >> 4) * 2 + (c >> 5), rr = r & 15, cc = c & 31, ob = rr * 64 + cc * 2; return st * 1024 + (ob ^ (((ob >> 9) & 1) << 5)); }
__device__ __forceinline__ void stage_rc(int b, int& R, int& C) { const int st = b / 1024, sb = b % 1024, swz = sb ^ (((sb >> 9) & 1) << 5); R = (st >> 1) * 16 + swz / 64; C = (st & 1) * 32 + (swz % 64) / 2; }
__device__ __forceinline__ int perm16(int R) { return (R >> 5) * 64 + ((R >> 2) & 3) * 16 + ((R >> 4) & 1) * 4 + (R & 3); }
__device__ __forceinline__ int perm32(int rho) { const int n = rho >> 4, i = rho & 15; return 8 * (i >> 2) + 4 * n + (i & 3); }
struct Unit { int pm, pn, pb, e, j, half; };

struct DenseOrder {
    int nM, nN, nwg, G, c;
    __device__ __forceinline__ void init(int M, int N, int G_, int c_) { nM = M / BM; nN = N / BM; nwg = nM * nN; G = G_; c = c_; }
    __device__ __forceinline__ bool next(int i, Unit& u) const {
        const long L = (long)i * G + c; if (L >= nwg) return false;
        int wgid = (int)L; { const int q = nwg / NXCD, r = nwg % NXCD, xcd = wgid % NXCD, off = wgid / NXCD; wgid = (xcd < r ? xcd * (q + 1) : r * (q + 1) + (xcd - r) * q) + off; }
        const int nig = WGM * nN, gid = wgid / nig, fm = gid * WGM, gsz = (nM - fm) < WGM ? (nM - fm) : WGM;
        u.pm = fm + ((wgid % nig) % gsz); u.pn = (wgid % nig) / gsz; u.pb = u.pn; u.e = 0; u.j = 0; u.half = 0; return true;
    }
    __device__ __forceinline__ int arow(const Unit& u, int r) const { return u.pm * BM + r; }
    __device__ __forceinline__ void arow4(const Unit& u, const int (&r)[4], int (&o)[4]) const { for (int q = 0; q < 4; ++q) o[q] = u.pm * BM + r[q]; }
    __device__ __forceinline__ void arow4_issue(const Unit&, const int (&)[4], int (&)[4]) const {}
    __device__ __forceinline__ int arow4_fin(const Unit& u, int r, int) const { return u.pm * BM + r; }
};

template <class Epi, class Sched, bool FP8 = false>
__device__ __forceinline__ void gemm_phase(LAS unsigned char* lds, const bf16_t* Ag, int lda, const bf16_t* Btg, int K, const Sched& S, const Epi& E) {
    const int tid = opaque_tid(), wid = __builtin_amdgcn_readfirstlane(tid >> 6), lane = tid & 63, wr = wid >> 2, wc = wid & 3, fr = lane & 15, fq = lane >> 4;
    const int nt = K / BK;
    unsigned voffB[2];
#pragma unroll
    for (int i = 0; i < 2; ++i) { int R, C; stage_rc(tid * 16 + i * 8192, R, C); const int Rb = (int)Epi::PERM == 2 ? perm16(R) : Epi::PERM ? ((R & ~31) + perm32(R & 31)) : R; voffB[i] = (unsigned)(Rb * K + C) * 2u; }
    const size_t kstep = (size_t)(BK * 2);
    const size_t tstep = (size_t)2 * HALF * K * 2;
    const size_t hstep = (size_t)((int)Epi::PERM == 2 ? 8 : HALF) * K * 2;
    const unsigned ldsw = (unsigned)wid * 1024u;
    const int aoff = lds_byte(wr * 64 + fr, fq * 8), boff = lds_byte(wc * 32 + fr, fq * 8);
#define PG8_SA(b, h) (((b) * 2 + (h)) * HTB)
#define PG8_SB(b, h) ((4 + (b) * 2 + (h)) * HTB)
#define PG8_STAGE(bufoff, gbase, voff) do { _Pragma("unroll") for (int _i = 0; _i < 2; ++_i) \
        __builtin_amdgcn_global_load_lds((const unsigned*)((const char*)(gbase) + (voff)[_i]), (LAS unsigned*)(lds + (bufoff) + ldsw + _i * 8192), 16, 0, 0); } while (0)
#define PG8_LDA(dst, b, h) do { _Pragma("unroll") for (int m = 0; m < 4; ++m) _Pragma("unroll") for (int k = 0; k < 2; ++k) dst[m][k] = *(const LAS bf16x8*)(lds + PG8_SA(b, h) + aoff + m * 2048 + k * 1024); } while (0)
#define PG8_LDB(dst, b, h) do { _Pragma("unroll") for (int n = 0; n < 2; ++n) _Pragma("unroll") for (int k = 0; k < 2; ++k) dst[n][k] = *(const LAS bf16x8*)(lds + PG8_SB(b, h) + boff + n * 2048 + k * 1024); } while (0)
#define PG8_MMA(ai, bj, At, Bt) do { __builtin_amdgcn_s_setprio(1); _Pragma("unroll") for (int m = 0; m < 4; ++m) _Pragma("unroll") for (int n = 0; n < 2; ++n) { \
        if constexpr (FP8) { const i32x4 a0_ = __builtin_bit_cast(i32x4, At[m][0]), a1_ = __builtin_bit_cast(i32x4, At[m][1]), b0_ = __builtin_bit_cast(i32x4, Bt[n][0]), b1_ = __builtin_bit_cast(i32x4, Bt[n][1]); \
            const i32x8 a8_ = __builtin_shufflevector(a0_, a1_, 0, 1, 2, 3, 4, 5, 6, 7), b8_ = __builtin_shufflevector(b0_, b1_, 0, 1, 2, 3, 4, 5, 6, 7); \
            acc[ai][bj][m][n] = __builtin_amdgcn_mfma_scale_f32_16x16x128_f8f6f4(b8_, a8_, acc[ai][bj][m][n], 0, 0, 0, sc1_, 0, sc1_); } \
        else { _Pragma("unroll") for (int k = 0; k < 2; ++k) acc[ai][bj][m][n] = __builtin_amdgcn_mfma_f32_16x16x32_bf16(Bt[n][k], At[m][k], acc[ai][bj][m][n], 0, 0, 0); } } \
        __builtin_amdgcn_s_setprio(0); } while (0)
#define PG8_WAIT_V(n) asm volatile("s_waitcnt vmcnt(" #n ")" ::: "memory")
#define PG8_WAIT_L(n) asm volatile("s_waitcnt lgkmcnt(" #n ")" ::: "memory")
#define PG8_BAR __builtin_amdgcn_s_barrier()
#define PG8_SCHED __builtin_amdgcn_sched_barrier(0)
#define PG8_AOFF(dst, u) do { int _t = tid; asm volatile("" : "+v"(_t)); int _rw[4], _cc[4]; _Pragma("unroll") for (int _h = 0; _h < 2; ++_h) _Pragma("unroll") for (int _i = 0; _i < 2; ++_i) { int _R, _C; stage_rc(_t * 16 + _i * 8192, _R, _C); \
        _rw[_h * 2 + _i] = _h * HALF + _R; _cc[_h * 2 + _i] = _C; } \
        int _ar[4]; S.arow4(u, _rw, _ar);                                        \
        _Pragma("unroll") for (int _q = 0; _q < 4; ++_q) dst[_q >> 1][_q & 1] = (unsigned)(_ar[_q] * lda + _cc[_q]) * 2u; } while (0)
#define PG8_AOFF_ISSUE(raw, u) do { int _t = tid; asm volatile("" : "+v"(_t)); int _rw[4]; _Pragma("unroll") for (int _h = 0; _h < 2; ++_h) _Pragma("unroll") for (int _i = 0; _i < 2; ++_i) { int _R, _C; stage_rc(_t * 16 + _i * 8192, _R, _C); _rw[_h * 2 + _i] = _h * HALF + _R; } \
        S.arow4_issue(u, _rw, raw); } while (0)
#define PG8_AOFF_FIN(dst, raw, u) do { int _t = tid; asm volatile("" : "+v"(_t)); _Pragma("unroll") for (int _h = 0; _h < 2; ++_h) _Pragma("unroll") for (int _i = 0; _i < 2; ++_i) { int _R, _C; stage_rc(_t * 16 + _i * 8192, _R, _C); \
        dst[_h][_i] = (unsigned)(S.arow4_fin(u, _h * HALF + _R, raw[_h * 2 + _i]) * lda + _C) * 2u; } } while (0)
    Unit cur, nxt; int ui = 0; cur.e = 0;
    if (!S.next(0, cur)) return;
    f32x4 acc[2][2][4][2];
    int sc1_ = 0x7f7f7f7f; float z0_ = 0.f; asm volatile("" : "+v"(sc1_), "+v"(z0_));
    (void)sc1_;
#pragma unroll
    for (int a = 0; a < 2; ++a)
#pragma unroll
        for (int b = 0; b < 2; ++b)
#pragma unroll
            for (int m = 0; m < 4; ++m)
#pragma unroll
                for (int n = 0; n < 2; ++n) acc[a][b][m][n] = (f32x4){z0_, z0_, z0_, z0_};
    bf16x8 At[4][2], B0[2][2], B1[2][2];
    unsigned vA[2][2];
    PG8_AOFF(vA, cur);
    const char* cA = (const char*)Ag;
    const char* cB = (const char*)Btg + (size_t)cur.pb * tstep;
    PG8_STAGE(PG8_SB(0, 0), cB, voffB); PG8_STAGE(PG8_SB(0, 1), cB + hstep, voffB); PG8_STAGE(PG8_SA(0, 0), cA, vA[0]); PG8_STAGE(PG8_SA(0, 1), cA, vA[1]);
    if (wr == 1) PG8_BAR;
    PG8_WAIT_V(2); PG8_BAR;
    PG8_STAGE(PG8_SB(1, 0), cB + kstep, voffB); PG8_STAGE(PG8_SA(1, 0), cA + kstep, vA[0]); PG8_STAGE(PG8_SB(1, 1), cB + hstep + kstep, voffB);
    PG8_WAIT_V(6); PG8_BAR;
    for (;;) {
        nxt.e = cur.e;
        const bool has_next = S.next(ui + 1, nxt);
        const char* nB = has_next ? (const char*)Btg + (size_t)nxt.pb * tstep : cB;
        int rawn[4] = {0, 0, 0, 0}; if (has_next) PG8_AOFF_ISSUE(rawn, nxt);
#pragma unroll 1
        for (int t = 0; t < nt; t += 2) {
            const bool last = (t == nt - 2);
            const char* a1 = cA + (size_t)(t + 1) * kstep;
            const char* a2 = last ? cA : cA + (size_t)(t + 2) * kstep; const char* b2 = last ? nB : cB + (size_t)(t + 2) * kstep;
            const char* a3 = a2 + kstep; const char* b3 = b2 + kstep;
            PG8_LDB(B0, 0, 0); PG8_LDB(B1, 0, 1); PG8_SCHED; PG8_LDA(At, 0, 0); PG8_STAGE(PG8_SA(1, 1), a1, vA[1]);
            if (last && has_next) { PG8_AOFF_FIN(vA, rawn, nxt); }
            PG8_WAIT_V(8); PG8_WAIT_L(0); PG8_BAR; PG8_MMA(0, 0, At, B0); PG8_MMA(0, 1, At, B1); PG8_BAR; PG8_SCHED;
            PG8_LDA(At, 0, 1); PG8_STAGE(PG8_SB(0, 0), b2, voffB); PG8_STAGE(PG8_SB(0, 1), b2 + hstep, voffB); PG8_STAGE(PG8_SA(0, 0), a2, vA[0]);
            PG8_WAIT_V(8); PG8_WAIT_L(0); PG8_BAR; PG8_MMA(1, 0, At, B0); PG8_MMA(1, 1, At, B1); PG8_BAR; PG8_SCHED;
            PG8_LDB(B0, 1, 0); PG8_LDB(B1, 1, 1); PG8_SCHED; PG8_LDA(At, 1, 0); PG8_STAGE(PG8_SA(0, 1), a2, vA[1]);
            PG8_WAIT_V(8); PG8_WAIT_L(0); PG8_BAR; PG8_MMA(0, 0, At, B0); PG8_MMA(0, 1, At, B1); PG8_BAR; PG8_SCHED;
            PG8_LDA(At, 1, 1); PG8_STAGE(PG8_SB(1, 0), b3, voffB); PG8_STAGE(PG8_SB(1, 1), b3 + hstep, voffB); PG8_STAGE(PG8_SA(1, 0), a3, vA[0]);
            PG8_WAIT_V(8); PG8_WAIT_L(0); PG8_BAR; PG8_MMA(1, 0, At, B0); PG8_MMA(1, 1, At, B1); PG8_BAR; PG8_SCHED;
        }
        if (wr == 0) PG8_BAR;
        { const int l_ = opaque_tid() & 63; E(acc, cur, wr, wc, l_ & 15, l_ >> 4); }
        if (!has_next) break;
#pragma unroll
        for (int a = 0; a < 2; ++a)
#pragma unroll
            for (int b = 0; b < 2; ++b)
#pragma unroll
                for (int m = 0; m < 4; ++m)
#pragma unroll
                    for (int n = 0; n < 2; ++n) acc[a][b][m][n] = (f32x4){z0_, z0_, z0_, z0_};
        cur = nxt; cB = nB; ++ui;
        if (wr == 1) PG8_BAR;
    }
    PG8_WAIT_V(0);
    PG8_BAR;
#undef PG8_SA
#undef PG8_SB
#undef PG8_STAGE
#undef PG8_LDA
#undef PG8_LDB
#undef PG8_MMA
#undef PG8_WAIT_V
#undef PG8_WAIT_L
#undef PG8_BAR
#undef PG8_SCHED
#undef PG8_AOFF
#undef PG8_AOFF_ISSUE
#undef PG8_AOFF_FIN
}
}
namespace pg8 {
#define ST16(base, boff, v) (*(u32x4*)((char*)(base) + (boff)) = (v))
#define PACK8(v0, v1) ({ u32x4 w_; w_.x = cvtpk((v0)[0], (v0)[1]); w_.y = cvtpk((v0)[2], (v0)[3]); w_.z = cvtpk((v1)[0], (v1)[1]); w_.w = cvtpk((v1)[2], (v1)[3]); w_; })
struct EpiBf16 {
    static constexpr bool PERM = true;
    bf16_t* O; int ldc; float sc;
    __device__ __forceinline__ void operator()(const f32x4 (&acc)[2][2][4][2], const Unit& u, int wr, int wc, int fr, int fq) const {
        const unsigned o0 = (unsigned)((u.pm * BM + wr * 64 + fr) * ldc + u.pn * BM + wc * 32 + 8 * fq) * 2u;
#pragma unroll
        for (int ai = 0; ai < 2; ++ai)
#pragma unroll
            for (int m = 0; m < 4; ++m) { const unsigned ro = o0 + (unsigned)((ai * HALF + m * 16) * ldc) * 2u;
#pragma unroll
                for (int bj = 0; bj < 2; ++bj) ST16(O, ro + bj * HALF * 2, PACK8(acc[ai][bj][m][0] * sc, acc[ai][bj][m][1] * sc)); }
    }
};
struct EpiQ {
    static constexpr bool PERM = true;
    bf16_t* QM; const float* rope;
    __device__ __forceinline__ void operator()(const f32x4 (&acc)[2][2][4][2], const Unit& u, int wr, int wc, int fr, int fq) const {
        const int row0 = u.pm * BM + wr * 64 + fr;
        if (u.pn < 2) {
            const unsigned o0 = (unsigned)(row0 * 768 + 2 * u.pn * 192 + wc * 32 + 8 * fq) * 2u;
#pragma unroll
            for (int ai = 0; ai < 2; ++ai)
#pragma unroll
                for (int m = 0; m < 4; ++m) { const unsigned ro = o0 + (unsigned)((ai * HALF + m * 16) * 768) * 2u;
#pragma unroll
                    for (int bj = 0; bj < 2; ++bj) ST16(QM, ro + bj * 192 * 2, PACK8(acc[ai][bj][m][0], acc[ai][bj][m][1])); }
        } else {
            const int g8 = 4 * (wc & 1) + fq;
            const unsigned o0 = (unsigned)(row0 * 768 + (wc >> 1) * 192 + 128 + 4 * g8) * 2u;
#pragma unroll
            for (int ai = 0; ai < 2; ++ai) {
                f32x4 csa[4], csb[4];
#pragma unroll
                for (int m = 0; m < 4; ++m) { const int t_ = (row0 + ai * HALF + m * 16) % NTOK; const unsigned co_ = (unsigned)(t_ * 32 + 4 * g8) * 8u;
                    csa[m] = *(const f32x4*)((const char*)rope + co_); csb[m] = *(const f32x4*)((const char*)rope + co_ + 16); }
                asm volatile("" ::: "memory");
#pragma unroll
                for (int m = 0; m < 4; ++m) {
                    const f32x4 cs0 = csa[m], cs1 = csb[m];
                    const float c[4] = {cs0[0], cs0[2], cs1[0], cs1[2]}, s[4] = {cs0[1], cs0[3], cs1[1], cs1[3]};
                    const unsigned ro = o0 + (unsigned)((ai * HALF + m * 16) * 768) * 2u;
#pragma unroll
                    for (int bj = 0; bj < 2; ++bj) { const f32x4 x1 = acc[ai][bj][m][0], x2 = acc[ai][bj][m][1];
                        float o1[4], o2[4];
#pragma unroll
                        for (int i = 0; i < 4; ++i) { o1[i] = x1[i] * c[i] - x2[i] * s[i]; o2[i] = x1[i] * s[i] + x2[i] * c[i]; }
                        u32x2 w1, w2; w1.x = cvtpk(o1[0], o1[1]); w1.y = cvtpk(o1[2], o1[3]); w2.x = cvtpk(o2[0], o2[1]); w2.y = cvtpk(o2[2], o2[3]);
                        *(u32x2*)((char*)QM + ro + bj * 2 * 192 * 2) = w1; *(u32x2*)((char*)QM + ro + bj * 2 * 192 * 2 + 64) = w2; }
                    asm volatile("" ::: "memory"); }
            }
        }
    }
};
struct EpiKV {
    static constexpr bool PERM = true;
    bf16_t* KN; bf16_t* VM;
    __device__ __forceinline__ void operator()(const f32x4 (&acc)[2][2][4][2], const Unit& u, int wr, int wc, int fr, int fq) const {
        const unsigned o0 = (unsigned)((u.pm * BM + wr * 64 + fr) * 512 + u.pn * 128 + wc * 32 + 8 * fq) * 2u;
#pragma unroll
        for (int ai = 0; ai < 2; ++ai)
#pragma unroll
            for (int m = 0; m < 4; ++m) { const unsigned ro = o0 + (unsigned)((ai * HALF + m * 16) * 512) * 2u;
                ST16(KN, ro, PACK8(acc[ai][0][m][0], acc[ai][0][m][1])); ST16(VM, ro, PACK8(acc[ai][1][m][0], acc[ai][1][m][1])); }
    }
};
struct EpiOut {
    static constexpr bool PERM = false;
    const bf16_t* HB; bf16_t* Y; float* STAT;
    __device__ __forceinline__ void operator()(const f32x4 (&acc)[2][2][4][2], const Unit& u, int wr, int wc, int fr, int fq) const {
        const int row0 = u.pm * BM + wr * 64 + fr, col0 = u.pn * BM + wc * 32 + 4 * fq;
#pragma unroll
        for (int ai = 0; ai < 2; ++ai) {
            u32x2 hres[4][2][2];
#pragma unroll
            for (int m = 0; m < 4; ++m) { const unsigned off = (unsigned)((row0 + ai * HALF + m * 16) * DM + col0) * 4u;
#pragma unroll
                for (int bj = 0; bj < 2; ++bj)
#pragma unroll
                    for (int n = 0; n < 2; ++n) hres[m][bj][n] = *(const u32x2*)((const char*)HB + ((off + (bj * HALF + n * 16) * 4) >> 1)); }
            asm volatile("" ::: "memory");
#pragma unroll
            for (int m = 0; m < 4; ++m) { const int row = row0 + ai * HALF + m * 16; float s = 0.f, q = 0.f;
                const unsigned yb = (unsigned)((((row >> 5) * 128 + (col0 >> 4)) * 32 + (row & 31)) * 16 + (col0 & 15)) * 2u;
#pragma unroll
                for (int bj = 0; bj < 2; ++bj)
#pragma unroll
                    for (int n = 0; n < 2; ++n) { const u32x2 hw = hres[m][bj][n]; const f32x4 hv = {bflo(hw.x), bfhi(hw.x), bflo(hw.y), bfhi(hw.y)}; const f32x4 y = acc[ai][bj][m][n] * (1.0f / (FP8_WSCALE * OM_SCALE)) + hv * DN_ALPHA;
                        { u32x2 yw; yw.x = cvtpk(y[0], y[1]); yw.y = cvtpk(y[2], y[3]); *(u32x2*)((char*)Y + yb + (unsigned)(((bj * HALF + n * 16) >> 4) * 32 * 16) * 2u) = yw; } s += (y[0] + y[1]) + (y[2] + y[3]); q += (y[0] * y[0] + y[1] * y[1]) + (y[2] * y[2] + y[3] * y[3]); }
                s += __shfl_xor(s, 16); s += __shfl_xor(s, 32); q += __shfl_xor(q, 16); q += __shfl_xor(q, 32);
                if (fq == 0) *(f32x2*)((char*)STAT + (unsigned)(row * 32 + u.pn * 4 + wc) * 8u) = (f32x2){s, q}; }
        }
    }
};
struct EpiSwiglu {
    static constexpr bool PERM = true;
    bf16_t* ACT; const float* b_in;
    __device__ __forceinline__ void operator()(const f32x4 (&acc)[2][2][4][2], const Unit& u, int wr, int wc, int fr, int fq) const {
        const int col = u.pn * 128 + wc * 32 + 8 * fq;
        const unsigned o0 = (unsigned)((u.pm * BM + wr * 64 + fr) * DFF + col);
        const float* bg = b_in + (size_t)u.e * 1024 + col; const float* bu = bg + 512;
        const f32x4 bg0 = *(const f32x4*)bg, bg1 = *(const f32x4*)(bg + 4), bu0 = *(const f32x4*)bu, bu1 = *(const f32x4*)(bu + 4);
#pragma unroll
        for (int ai = 0; ai < 2; ++ai)
#pragma unroll
            for (int m = 0; m < 4; ++m) { float a[8];
#pragma unroll
                for (int n = 0; n < 2; ++n) { const f32x4 g4 = acc[ai][0][m][n] * (1.0f / FP8_WSCALE) + (n ? bg1 : bg0), u4 = acc[ai][1][m][n] * (1.0f / FP8_WSCALE) + (n ? bu1 : bu0);
#pragma unroll
                    for (int i = 0; i < 4; ++i) { const float g = fminf(g4[i], 7.0f), up = fminf(fmaxf(u4[i], -7.0f), 7.0f);
                        const float sg = __builtin_amdgcn_rcpf(1.0f + __builtin_amdgcn_exp2f(-1.702f * 1.4426950408889634f * g));
                        a[4 * n + i] = g * sg * (up + 1.0f); } }
                u32x2 w; w.x = cvt4_fp8(a[0], a[1], a[2], a[3]); w.y = cvt4_fp8(a[4], a[5], a[6], a[7]);
                *(u32x2*)((char*)ACT + o0 + (unsigned)((ai * HALF + m * 16) * DFF)) = w;
                asm volatile("" ::: "memory"); }
    }
};
struct EpiDown {
    static constexpr int PERM = 2;
    unsigned char* YE; const float* b_out;
    __device__ __forceinline__ void operator()(const f32x4 (&acc)[2][2][4][2], const Unit& u, int wr, int wc, int fr, int fq) const {
        const int col0 = u.pn * BM + wc * 64 + 16 * fq;
        const unsigned o0 = (unsigned)((u.pm * BM + wr * 64 + fr) * DM + col0);
        const unsigned bo = (unsigned)(u.e * DM + col0) * 4u;
        f32x4 bb[2][2];
#pragma unroll
        for (int bj = 0; bj < 2; ++bj)
#pragma unroll
            for (int n = 0; n < 2; ++n) bb[bj][n] = *(const f32x4*)((const char*)b_out + bo + (bj * 8 + n * 4) * 4);
#pragma unroll
        for (int ai = 0; ai < 2; ++ai)
#pragma unroll
            for (int m = 0; m < 4; ++m) { u32x4 w;
                { const f32x4 v = acc[ai][0][m][0] * (1.0f / FP8_WSCALE) + bb[0][0]; w.x = cvt4_fp8(v[0], v[1], v[2], v[3]); }
                { const f32x4 v = acc[ai][0][m][1] * (1.0f / FP8_WSCALE) + bb[0][1]; w.y = cvt4_fp8(v[0], v[1], v[2], v[3]); }
                { const f32x4 v = acc[ai][1][m][0] * (1.0f / FP8_WSCALE) + bb[1][0]; w.z = cvt4_fp8(v[0], v[1], v[2], v[3]); }
                { const f32x4 v = acc[ai][1][m][1] * (1.0f / FP8_WSCALE) + bb[1][1]; w.w = cvt4_fp8(v[0], v[1], v[2], v[3]); }
                *(u32x4*)(YE + o0 + (unsigned)((ai * HALF + m * 16) * DM)) = w; }
    }
};
struct MoeOrder {
    const LAS int* tstart; const unsigned* cnt; const int* rowtok; int nN, G, c; bool gather; bool runs;
    __device__ __forceinline__ bool next(int i, Unit& u) const {
        const int total = tstart[NEXP];
        const int per = (total * nN + G - 1) / G;
        const long L = runs ? (long)c * per + i : (long)i * G + c; if (L >= (long)total * nN || (runs && i >= per)) return false;
        const int mt = (int)(L / nN), pn = (int)(L % nN);
        int e = (u.e > 0 && u.e < NEXP && tstart[u.e] <= mt) ? u.e : 0;
#pragma unroll 1
        while (e + 1 < NEXP && tstart[e + 1] <= mt) ++e;
        u.pm = mt; u.pn = pn; u.e = e; u.j = mt - tstart[e]; u.pb = e * nN + pn; u.half = 0; return true;
    }
    __device__ __forceinline__ int arow(const Unit& u, int r) const {
        if (!gather) return u.pm * BM + r;
        const int p = u.j * BM + r; const int n = tstart[64 + u.e];
        const int v = rowtok[(size_t)u.e * MROWS + (p < n ? p : 0)];
        return (p < n) ? v : 0;
    }
    __device__ __forceinline__ void arow4_issue(const Unit& u, const int (&r)[4], int (&raw)[4]) const {
        if (!gather) return;
        const int n = tstart[64 + u.e];
#pragma unroll
        for (int q = 0; q < 4; ++q) { const int p = u.j * BM + r[q]; raw[q] = rowtok[(size_t)u.e * MROWS + (p < n ? p : 0)]; }
    }
    __device__ __forceinline__ int arow4_fin(const Unit& u, int r, int raw) const {
        if (!gather) return u.pm * BM + r;
        const int p = u.j * BM + r; const int n = tstart[64 + u.e]; return (p < n) ? raw : 0;
    }
    __device__ __forceinline__ void arow4(const Unit& u, const int (&r)[4], int (&o)[4]) const {
        if (!gather) { for (int q = 0; q < 4; ++q) o[q] = u.pm * BM + r[q]; return; }
        const int n = tstart[64 + u.e]; int v[4];
#pragma unroll
        for (int q = 0; q < 4; ++q) { const int p = u.j * BM + r[q]; v[q] = rowtok[(size_t)u.e * MROWS + (p < n ? p : 0)]; }
        asm volatile("" ::: "memory");
#pragma unroll
        for (int q = 0; q < 4; ++q) { const int p = u.j * BM + r[q]; o[q] = (p < n) ? v[q] : 0; }
    }
};
}
struct KArgs { const float* in[19]; float* out; unsigned char* ws; };
struct PArgs { const KArgs& k; unsigned char* ws;
    __device__ __forceinline__ const float* in(int i) const { return k.in[i]; }
    __device__ __forceinline__ float* out() const { return k.out; } };
enum { I_X = 0, I_META, I_REL, I_EVWIN, I_QNORM, I_KVNORM, I_WUQ, I_WUKV, I_EVWOUT, I_ODWIN, I_ODWOUT, I_LNG, I_LNB, I_RW, I_RB, I_EWIN, I_EBIN, I_EWOUT, I_EBOUT };

__device__ __forceinline__ int rowmap(int kind, int n) {
    switch (kind) {
    case 0: {
        if (n < 768) return n; if (n < 832) return EC_KROPE + (n - 768); if (n < 2368) return n - 64; return n; }
    case 1: {
        const int head = n / 192, d = n % 192; if (d < 128) return head * 128 + d;
        const int i = d - 128; if (i < 32) return 512 + head * 64 + 8 * (i >> 2) + (i & 3); const int i2 = i - 32; return 512 + head * 64 + 8 * (i2 >> 2) + 4 + (i2 & 3); }
    case 2: {
        if (n < 512) return 256 * (n >> 7) + (n & 127); const int j = n - 512; return 256 * (j >> 7) + 128 + (j & 127); }
    default: return n;
    }
}
__device__ __forceinline__ void ti_load(f32x4 (&v)[8], const float* W, int Nsrc, int nblk, int item, int lane) {
    const int kb = item / nblk, nb = item % nblk, k0 = 64 * kb, n0 = 32 * nb; const int nq = n0 + 4 * (lane & 7);
#pragma unroll
    for (int i = 0; i < 8; ++i) { const int kk = 8 * i + (lane >> 3); v[i] = (nq < Nsrc) ? *(const f32x4*)(W + (size_t)(k0 + kk) * Nsrc + nq) : (f32x4){0.f, 0.f, 0.f, 0.f}; }
}
__device__ __forceinline__ void ti_finish(const f32x4 (&v)[8], int K, int nblk, bf16_t* WT, int kind, LAS float* scr, int item, int lane) {
    const int kb = item / nblk, nb = item % nblk, k0 = 64 * kb, n0 = 32 * nb;
#pragma unroll
    for (int i = 0; i < 8; ++i) { const int kk = 8 * i + (lane >> 3); LAS float* d = scr + kk * 33 + 4 * (lane & 7); d[0] = v[i][0]; d[1] = v[i][1]; d[2] = v[i][2]; d[3] = v[i][3]; }
    LDS_WAIT(); asm volatile("" ::: "memory");
    const int c = lane & 7;
#pragma unroll
    for (int j = 0; j < 4; ++j) { const int n = (lane >> 3) + 8 * j; const LAS float* s = scr + (8 * c) * 33 + n;
        u32x4 o; o.x = cvtpk(s[0 * 33], s[1 * 33]); o.y = cvtpk(s[2 * 33], s[3 * 33]); o.z = cvtpk(s[4 * 33], s[5 * 33]); o.w = cvtpk(s[6 * 33], s[7 * 33]);
        *(u32x4*)(WT + (size_t)rowmap(kind, n0 + n) * K + k0 + 8 * c) = o; }
    LDS_WAIT(); asm volatile("" ::: "memory");
}
__device__ __forceinline__ void ti_finish8(const f32x4 (&v)[8], int K, int nblk, unsigned char* WT8, int kind, LAS float* scr, int item, int lane) {
    const int kb = item / nblk, nb = item % nblk, k0 = 64 * kb, n0 = 32 * nb;
#pragma unroll
    for (int i = 0; i < 8; ++i) { const int kk = 8 * i + (lane >> 3); LAS float* d = scr + kk * 33 + 4 * (lane & 7); d[0] = v[i][0]; d[1] = v[i][1]; d[2] = v[i][2]; d[3] = v[i][3]; }
    LDS_WAIT(); asm volatile("" ::: "memory");
    const int c = lane & 7;
#pragma unroll
    for (int j = 0; j < 4; ++j) { const int n = (lane >> 3) + 8 * j; const LAS float* s = scr + (8 * c) * 33 + n;
        u32x2 o; o.x = cvt4_fp8(s[0 * 33] * FP8_WSCALE, s[1 * 33] * FP8_WSCALE, s[2 * 33] * FP8_WSCALE, s[3 * 33] * FP8_WSCALE);
        o.y = cvt4_fp8(s[4 * 33] * FP8_WSCALE, s[5 * 33] * FP8_WSCALE, s[6 * 33] * FP8_WSCALE, s[7 * 33] * FP8_WSCALE);
        *(u32x2*)(WT8 + (size_t)rowmap(kind, n0 + n) * K + k0 + 8 * c) = o; }
    LDS_WAIT(); asm volatile("" ::: "memory");
}
__device__ __forceinline__ void transpose_item8(const float* W, int K, int Nsrc, int nblk, unsigned char* WT8, int kind, LAS float* scr, int item, int lane) {
    f32x4 v[8]; ti_load(v, W, Nsrc, nblk, item, lane); ti_finish8(v, K, nblk, WT8, kind, scr, item, lane);
}
__device__ __forceinline__ void transpose_item(const float* W, int K, int Nsrc, int nblk, bf16_t* WT, int kind, LAS float* scr, int item, int lane) {
    f32x4 v[8]; ti_load(v, W, Nsrc, nblk, item, lane); ti_finish(v, K, nblk, WT, kind, scr, item, lane);
}
__device__ __forceinline__ void phase_prologue(const PArgs& a, LAS unsigned char* lds, int vcu, int G) {
    const int tid = opaque_tid(), lane = tid & 63, wave = __builtin_amdgcn_readfirstlane(tid >> 6);
    LAS float* scr = (LAS float*)(lds + wave * 16384);
    const int gw = vcu * 8 + wave, NGW = G * 8;
    unsigned char* ws = a.ws;
    constexpr int I_EVIN = (DM / 64) * (EVP / 32), I_UQ = (512 / 64) * (768 / 32), I_UKV = (256 / 64) * (1024 / 32), I_OUT = (1024 / 64) * (DM / 32), I_ODIN = (DM / 64) * (ODP / 32);
    constexpr int I_EI = (DM / 64) * (1024 / 32), I_EO = (DFF / 64) * (DM / 32);
    constexpr int N_SMALL = 2 * (I_EVIN + I_UQ + I_UKV + I_OUT + I_ODIN + I_OUT);
    constexpr long N_ALL = (long)N_SMALL;
    for (long it = gw; it < N_ALL; it += NGW) {
        long r = it;
        if (r < N_SMALL) {
            const int j = (int)(r & 1); r >>= 1;
            if (r < I_EVIN) { transpose_item8(a.in(I_EVWIN) + (size_t)j * DM * 2368, DM, 2368, EVP / 32, ws + WS_WINE + j * SZ_WINE, 0, scr, (int)r, lane); continue; } r -= I_EVIN;
            if (r < I_UQ) { transpose_item(a.in(I_WUQ) + (size_t)j * 512 * 768, 512, 768, 768 / 32, (bf16_t*)(ws + WS_WUQ + j * SZ_WUQ), 1, scr, (int)r, lane); continue; } r -= I_UQ;
            if (r < I_UKV) { transpose_item(a.in(I_WUKV) + (size_t)j * 256 * 1024, 256, 1024, 1024 / 32, (bf16_t*)(ws + WS_WUKV + j * SZ_WUKV), 3, scr, (int)r, lane); continue; } r -= I_UKV;
            if (r < I_OUT) { transpose_item8(a.in(I_EVWOUT) + (size_t)j * 1024 * DM, 1024, DM, DM / 32, ws + WS_WOUTE + j * SZ_WOUT, 3, scr, (int)r, lane); continue; } r -= I_OUT;
            if (r < I_ODIN) { transpose_item8(a.in(I_ODWIN) + (size_t)j * DM * 1864, DM, 1864, ODP / 32, ws + WS_WINO + j * SZ_WINO, 3, scr, (int)r, lane); continue; } r -= I_ODIN;
            transpose_item8(a.in(I_ODWOUT) + (size_t)j * 1024 * DM, 1024, DM, DM / 32, ws + WS_WOUTO + j * SZ_WOUT, 3, scr, (int)r, lane); continue;
        }
    }
    {   constexpr int PER = I_EI + I_EO; constexpr long NEXI = (long)DEPTH * NEXP * PER;
#define EXP_DESC(idx, Wp, Kd, Ns, nb, Tp, kd, qi) const int le_ = (int)((idx) / PER), q_ = (int)((idx) % PER); const bool ei_ = q_ < I_EI; \
        const float* Wp = ei_ ? a.in(I_EWIN) + (size_t)le_ * DM * 1024 : a.in(I_EWOUT) + (size_t)le_ * DFF * DM; const int Kd = ei_ ? DM : DFF, Ns = ei_ ? 1024 : DM, nb = ei_ ? 1024 / 32 : DM / 32; \
        unsigned char* Tp = ei_ ? (ws + WS_WEI + (size_t)le_ * SZ_WEI) : (ws + WS_WEO + (size_t)le_ * SZ_WEO); const int kd = ei_ ? 2 : 3, qi = ei_ ? q_ : q_ - I_EI
        f32x4 va[8], vb[8];
        long it = gw;
        if (it < NEXI) { EXP_DESC(it, W0, K0, N0, B0, T0, D0, Q0); (void)K0; (void)T0; (void)D0; ti_load(va, W0, N0, B0, Q0, lane); }
        for (; it < NEXI; it += 2 * NGW) {
            const long i1 = it + NGW, i2 = it + 2 * NGW;
            if (i1 < NEXI) { EXP_DESC(i1, W1, K1, N1, B1, T1, D1, Q1); (void)K1; (void)T1; (void)D1; ti_load(vb, W1, N1, B1, Q1, lane); }
            { EXP_DESC(it, W0, K0, N0, B0, T0, D0, Q0); (void)W0; (void)N0; ti_finish8(va, K0, B0, T0, D0, scr, Q0, lane); }
            if (i2 < NEXI) { EXP_DESC(i2, W2, K2, N2, B2, T2, D2, Q2); (void)K2; (void)T2; (void)D2; ti_load(va, W2, N2, B2, Q2, lane); }
            if (i1 < NEXI) { EXP_DESC(i1, W1, K1, N1, B1, T1, D1, Q1); (void)W1; (void)N1; ti_finish8(vb, K1, B1, T1, D1, scr, Q1, lane); }
        }
#undef EXP_DESC
    }
    for (int i = gw * 64 + lane; i < DEPTH * 32 * DM; i += NGW * 64) {
        const int l = i / (32 * DM), e = (i / DM) % 32, k = i % DM;
        const float w = a.in(I_RW)[((size_t)l * DM + k) * 32 + e];
        const unsigned hi = cvtpk(w, 0.f) & 0xffffu; const float lo = w - bflo(hi);
        ((bf16_t*)(ws + WS_WRH))[i] = (bf16_t)hi; ((bf16_t*)(ws + WS_WRL))[i] = (bf16_t)(cvtpk(lo, 0.f) & 0xffffu);
    }
    for (int i = gw * 64 + lane; i < NTOK * 32; i += NGW * 64) {
        const int t = i >> 5, k = i & 31;
        const float inv = powf(10000.0f, -(float)k / 32.0f); const float ang = (float)t * inv;
        float sn, cs; sincosf(ang, &sn, &cs);
        *(f32x2*)((float*)(ws + WS_ROPE) + (size_t)i * 2) = (f32x2){cs, sn};
    }
    bf16_t* HB = (bf16_t*)(ws + WS_HB);
    for (int m = gw; m < MROWS; m += NGW) {
        const int b = m / NTOK, t = m % NTOK;
        const float* src = (t < NMETA) ? a.in(I_META) + (size_t)t * DM : a.in(I_X) + ((size_t)b * SEQ + (t - NMETA)) * DM;
        const bool zero = t >= NMETA + SEQ;
        f32x4 v8[8];
#pragma unroll
        for (int j = 0; j < 8; ++j) v8[j] = zero ? (f32x4){0.f, 0.f, 0.f, 0.f} : *(const f32x4*)(src + 4 * lane + 256 * j);
        asm volatile("" ::: "memory");
#pragma unroll
        for (int j = 0; j < 8; ++j) { const int c = 4 * lane + 256 * j; const f32x4 v = v8[j];
            u32x2 w; w.x = cvtpk(v[0], v[1]); w.y = cvtpk(v[2], v[3]); *(u32x2*)(HB + (size_t)m * DM + c) = w;
            *(unsigned*)(ws + WS_HB8 + (size_t)m * DM + c) = cvt4_fp8(v[0], v[1], v[2], v[3]); }
    }
}

__device__ __forceinline__ void phase_latent_norm(const PArgs& a, int jl, int vcu, int G) {
    const int tid = opaque_tid(), lane = tid & 63, wave = __builtin_amdgcn_readfirstlane(tid >> 6);
    const int gw = vcu * 8 + wave, NGW = G * 8;
    unsigned char* ws = a.ws;
    const bf16_t* P = (const bf16_t*)(ws + WS_P); bf16_t* QN = (bf16_t*)(ws + WS_QN); bf16_t* KVN = (bf16_t*)(ws + WS_KVN); bf16_t* KR = (bf16_t*)(ws + WS_KR);
    const float* rope = (const float*)(ws + WS_ROPE);
    const float* gq = a.in(I_QNORM) + jl * 512; const float* gkv = a.in(I_KVNORM) + jl * 256;
    f32x4 g0 = *(const f32x4*)(gq + 8 * lane), g1 = *(const f32x4*)(gq + 8 * lane + 4), gk = *(const f32x4*)(gkv + 4 * lane);
    const int lr = lane & 31;
#define LAT_LOAD(m_, qv_, kv_, x1_, x2_, cs_) do { const bf16_t* pr_ = P + (size_t)(m_) * EVP; qv_ = *(const u32x4*)(pr_ + EC_QLAT + 8 * lane); kv_ = *(const u32x2*)(pr_ + EC_KVLAT + 4 * lane); \
        x1_ = pr_[EC_KROPE + lr]; x2_ = pr_[EC_KROPE + 32 + lr]; cs_ = *(const f32x2*)(rope + ((size_t)((m_) % NTOK) * 32 + lr) * 2); } while (0)
    u32x4 qv = {0u, 0u, 0u, 0u}, qvn = qv; u32x2 kv = {0u, 0u}, kvn = kv; bf16_t x1b = 0, x2b = 0, x1n = 0, x2n = 0; f32x2 cs = {0.f, 0.f}, csn = cs;
    if (gw < MROWS) LAT_LOAD(gw, qv, kv, x1b, x2b, cs);
    for (int m = gw; m < MROWS; m += NGW) {
        const int mn = (m + NGW < MROWS) ? m + NGW : m;
        LAT_LOAD(mn, qvn, kvn, x1n, x2n, csn);
        asm volatile("" ::: "memory");
        float q[8] = {bflo(qv.x), bfhi(qv.x), bflo(qv.y), bfhi(qv.y), bflo(qv.z), bfhi(qv.z), bflo(qv.w), bfhi(qv.w)};
        float k[4] = {bflo(kv.x), bfhi(kv.x), bflo(kv.y), bfhi(kv.y)};
        float sq = 0.f, sk = 0.f;
#pragma unroll
        for (int i = 0; i < 8; ++i) sq += q[i] * q[i];
#pragma unroll
        for (int i = 0; i < 4; ++i) sk += k[i] * k[i];
        sq = wave_sum(sq); sk = wave_sum(sk);
        const float rq = 1.0f / sqrtf(sq * (1.0f / 512.0f) + RMS_EPS), rk = 1.0f / sqrtf(sk * (1.0f / 256.0f) + RMS_EPS);
        u32x4 wq; wq.x = cvtpk(q[0] * rq * g0[0], q[1] * rq * g0[1]); wq.y = cvtpk(q[2] * rq * g0[2], q[3] * rq * g0[3]);
        wq.z = cvtpk(q[4] * rq * g1[0], q[5] * rq * g1[1]); wq.w = cvtpk(q[6] * rq * g1[2], q[7] * rq * g1[3]);
        *(u32x4*)(QN + (size_t)m * 512 + 8 * lane) = wq;
        u32x2 wk; wk.x = cvtpk(k[0] * rk * gk[0], k[1] * rk * gk[1]); wk.y = cvtpk(k[2] * rk * gk[2], k[3] * rk * gk[3]);
        *(u32x2*)(KVN + (size_t)m * 256 + 4 * lane) = wk;
        if (lane < 32) {
            const float x1 = bf2f(x1b), x2 = bf2f(x2b);
            KR[(size_t)m * 64 + lane] = (bf16_t)(cvtpk(x1 * cs[0] - x2 * cs[1], 0.f) & 0xffffu);
            KR[(size_t)m * 64 + 32 + lane] = (bf16_t)(cvtpk(x1 * cs[1] + x2 * cs[0], 0.f) & 0xffffu);
        }
        qv = qvn; kv = kvn; x1b = x1n; x2b = x2n; cs = csn;
    }
#undef LAT_LOAD
}

__device__ __forceinline__ void phase_ln_route(const PArgs& a, int layer, int cslot, LAS unsigned char* lds, int vcu, int G) {
    const int tid = opaque_tid(), lane = tid & 63, wave = __builtin_amdgcn_readfirstlane(tid >> 6);
    const int r32 = lane & 31, hh = lane >> 5;
    unsigned char* ws = a.ws;
    const bf16_t* Y = (const bf16_t*)(ws + WS_Y); const float* STAT = (const float*)(ws + WS_STAT);
    bf16_t* HB = (bf16_t*)(ws + WS_HB);
    const bf16_t* WRH = (const bf16_t*)(ws + WS_WRH) + (size_t)layer * 32 * DM; const bf16_t* WRL = (const bf16_t*)(ws + WS_WRL) + (size_t)layer * 32 * DM;
    const float* g = a.in(I_LNG) + (size_t)(layer * 2 + 0) * DM; const float* bta = a.in(I_LNB) + (size_t)(layer * 2 + 0) * DM;
    const float* rb = a.in(I_RB) + layer * 32;
    unsigned* cnt = (unsigned*)(ws + WS_CTL) + CW_CNT + 2048 * cslot;
    int* TOPE = (int*)(ws + WS_TOPE); int* TOPP = (int*)(ws + WS_TOPP); float* TOPG = (float*)(ws + WS_TOPG); int* ROWTOK = (int*)(ws + WS_ROWTOK);
    LAS float* part = (LAS float*)lds;
    LAS float* tot = part + 8 * 16 * 64;
    LAS float* gbl = tot + 16 * 64 + wave * 512;
    LAS unsigned* lcnt0 = (LAS unsigned*)(tot + 16 * 64 + 8 * 512);
    float* LOGIT = (float*)(ws + WS_QN);
    LAS unsigned char* stg = lds + 57344 + wave * 7168;
    const int cbase = 256 * wave, lcol = 16 * hh;
    bf16x8 whf[16], wlf[16];
#pragma unroll
    for (int s = 0; s < 16; ++s) { const int col = cbase + 32 * (s >> 1) + lcol + 8 * (s & 1);
        whf[s] = *(const bf16x8*)(WRH + (size_t)r32 * DM + col); wlf[s] = *(const bf16x8*)(WRL + (size_t)r32 * DM + col); }
    { const f32x4 gv = *(const f32x4*)(g + cbase + 4 * lane), bv = *(const f32x4*)(bta + cbase + 4 * lane);
      *(LAS f32x4*)(gbl + 4 * lane) = gv; *(LAS f32x4*)(gbl + 256 + 4 * lane) = bv; }
    LDS_WAIT(); asm volatile("" ::: "memory");
    for (int grp = vcu; grp < MROWS / 32; grp += G) {
        const int row = grp * 32 + r32;
        float s = 0.f, q = 0.f;
        { const f32x4* st = (const f32x4*)(STAT + (size_t)row * 64);
#pragma unroll
          for (int i = 0; i < 16; ++i) { const f32x4 v = st[i]; s += v[0] + v[2]; q += v[1] + v[3]; } }
        const float mean = s * (1.0f / DM); const float var = fmaxf(q * (1.0f / DM) - mean * mean, 0.f); const float rstd = 1.0f / sqrtf(var + LN_EPS);
        f32x16 acc;
#pragma unroll
        for (int i = 0; i < 16; ++i) acc[i] = 0.f;
        const size_t ro = (size_t)row * DM + cbase + lcol;
        u32x4 yAv[4], yBv[4];
#pragma unroll
        for (int p = 0; p < 8; ++p) {
            if ((p & 3) == 0) {
#pragma unroll
                for (int pp = 0; pp < 4; ++pp) { const bf16_t* yp = Y + ((size_t)(grp * 128 + 16 * wave + 2 * (p + pp) + hh) * 32 + r32) * 16;
                    yAv[pp] = *(const u32x4*)(yp); yBv[pp] = *(const u32x4*)(yp + 8); }
                asm volatile("" ::: "memory"); }
            const u32x4 yA = yAv[p & 3], yB = yBv[p & 3];
            const f32x4 y0 = {bflo(yA.x), bfhi(yA.x), bflo(yA.y), bfhi(yA.y)}, y1 = {bflo(yA.z), bfhi(yA.z), bflo(yA.w), bfhi(yA.w)}, y2 = {bflo(yB.x), bfhi(yB.x), bflo(yB.y), bfhi(yB.y)}, y3 = {bflo(yB.z), bfhi(yB.z), bflo(yB.w), bfhi(yB.w)};
            const LAS float* gp = gbl + 32 * p + lcol;
            const f32x4 g0 = *(const LAS f32x4*)(gp), g1 = *(const LAS f32x4*)(gp + 4), g2 = *(const LAS f32x4*)(gp + 8), g3 = *(const LAS f32x4*)(gp + 12);
            const f32x4 b0 = *(const LAS f32x4*)(gp + 256), b1 = *(const LAS f32x4*)(gp + 260), b2 = *(const LAS f32x4*)(gp + 264), b3 = *(const LAS f32x4*)(gp + 268);
            const f32x4 h0 = (y0 - mean) * rstd * g0 + b0, h1 = (y1 - mean) * rstd * g1 + b1, h2 = (y2 - mean) * rstd * g2 + b2, h3 = (y3 - mean) * rstd * g3 + b3;
            u32x4 hiA, hiB; hiA.x = cvtpk(h0[0], h0[1]); hiA.y = cvtpk(h0[2], h0[3]); hiA.z = cvtpk(h1[0], h1[1]); hiA.w = cvtpk(h1[2], h1[3]);
            hiB.x = cvtpk(h2[0], h2[1]); hiB.y = cvtpk(h2[2], h2[3]); hiB.z = cvtpk(h3[0], h3[1]); hiB.w = cvtpk(h3[2], h3[3]);
            { LAS unsigned char* sH = stg + r32 * 144 + (p & 1) * 64 + hh * 32; *(LAS u32x4*)(sH) = hiA; *(LAS u32x4*)(sH + 16) = hiB;
              u32x4 q8; q8.x = cvt4_fp8(h0[0], h0[1], h0[2], h0[3]); q8.y = cvt4_fp8(h1[0], h1[1], h1[2], h1[3]); q8.z = cvt4_fp8(h2[0], h2[1], h2[2], h2[3]); q8.w = cvt4_fp8(h3[0], h3[1], h3[2], h3[3]);
              *(LAS u32x4*)(stg + 4608 + r32 * 80 + (p & 1) * 32 + hh * 16) = q8; }
            if (p & 1) {
                LDS_WAIT(); asm volatile("" ::: "memory");
                int ln_ = lane; asm volatile("" : "+v"(ln_));
                const size_t cq = (size_t)cbase + 64 * (p >> 1);
#pragma unroll
                for (int i = 0; i < 4; ++i) { const int id = i * 64 + ln_, rw = id >> 3, c = id & 7; const u32x4 w = *(const LAS u32x4*)(stg + rw * 144 + c * 16);
                    *(u32x4*)((unsigned char*)HB + ((size_t)(grp * 32 + rw) * DM + cq) * 2 + c * 16) = w; }
#pragma unroll
                for (int i = 0; i < 2; ++i) { const int id = i * 64 + ln_, rw = id >> 2, c = id & 3; const u32x4 w = *(const LAS u32x4*)(stg + 4608 + rw * 80 + c * 16);
                    *(u32x4*)((unsigned char*)(ws + WS_HB8) + (size_t)(grp * 32 + rw) * DM + cq + c * 16) = w; }
                asm volatile("" ::: "memory");
            }
            u32x4 loA, loB; loA.x = cvtpk(h0[0] - bflo(hiA.x), h0[1] - bfhi(hiA.x)); loA.y = cvtpk(h0[2] - bflo(hiA.y), h0[3] - bfhi(hiA.y));
            loA.z = cvtpk(h1[0] - bflo(hiA.z), h1[1] - bfhi(hiA.z)); loA.w = cvtpk(h1[2] - bflo(hiA.w), h1[3] - bfhi(hiA.w));
            loB.x = cvtpk(h2[0] - bflo(hiB.x), h2[1] - bfhi(hiB.x)); loB.y = cvtpk(h2[2] - bflo(hiB.y), h2[3] - bfhi(hiB.y));
            loB.z = cvtpk(h3[0] - bflo(hiB.z), h3[1] - bfhi(hiB.z)); loB.w = cvtpk(h3[2] - bflo(hiB.w), h3[3] - bfhi(hiB.w));
            const bf16x8 hiAf = __builtin_bit_cast(bf16x8, hiA), hiBf = __builtin_bit_cast(bf16x8, hiB), loAf = __builtin_bit_cast(bf16x8, loA), loBf = __builtin_bit_cast(bf16x8, loB);
            acc = __builtin_amdgcn_mfma_f32_32x32x16_bf16(whf[2 * p], hiAf, acc, 0, 0, 0);
            acc = __builtin_amdgcn_mfma_f32_32x32x16_bf16(whf[2 * p], loAf, acc, 0, 0, 0);
            acc = __builtin_amdgcn_mfma_f32_32x32x16_bf16(wlf[2 * p], hiAf, acc, 0, 0, 0);
            acc = __builtin_amdgcn_mfma_f32_32x32x16_bf16(whf[2 * p + 1], hiBf, acc, 0, 0, 0);
            acc = __builtin_amdgcn_mfma_f32_32x32x16_bf16(whf[2 * p + 1], loBf, acc, 0, 0, 0);
            acc = __builtin_amdgcn_mfma_f32_32x32x16_bf16(wlf[2 * p + 1], hiBf, acc, 0, 0, 0);
        }
#pragma unroll
        for (int r = 0; r < 16; ++r) part[(wave * 16 + r) * 64 + lane] = acc[r];
        LDS_WAIT(); __syncthreads();
#pragma unroll
        for (int rr = 0; rr < 2; ++rr) { const int r = 2 * wave + rr; float t = 0.f;
#pragma unroll
            for (int w = 0; w < 8; ++w) t += part[(w * 16 + r) * 64 + lane];
            LOGIT[((size_t)grp * 16 + r) * 64 + lane] = t; }
        LDS_WAIT(); __syncthreads();
    }
    __syncthreads();
    LAS unsigned* lcnt = lcnt0 + wave * 64;
    for (int grp = vcu + wave * G; grp < MROWS / 32; grp += 8 * G) {
        const int row = grp * 32 + r32;
        {
            float v[16];
#pragma unroll
            for (int r = 0; r < 16; ++r) v[r] = LOGIT[((size_t)grp * 16 + r) * 64 + lane] + rb[(r & 3) + 8 * (r >> 2) + 4 * hh];
            float bv[4]; int bi[4];
#pragma unroll
            for (int k = 0; k < 4; ++k) { float best = -3.0e38f; int br = 0;
#pragma unroll
                for (int r = 0; r < 16; ++r) { const bool gt = v[r] > best; best = gt ? v[r] : best; br = gt ? r : br; }
#pragma unroll
                for (int r = 0; r < 16; ++r) v[r] = (r == br) ? -3.0e38f : v[r];
                bv[k] = best; bi[k] = (br & 3) + 8 * (br >> 2) + 4 * hh; }
            float ov[4]; int oi[4];
#pragma unroll
            for (int k = 0; k < 4; ++k) { ov[k] = __shfl_xor(bv[k], 32); oi[k] = __shfl_xor(bi[k], 32); }
            float tv[4]; int ti[4]; int pa = 0, pb = 0;
#pragma unroll
            for (int k = 0; k < 4; ++k) {
                float av = bv[0], ovv = ov[0]; int ai = bi[0], oii = oi[0];
#pragma unroll
                for (int z = 1; z < 4; ++z) { av = (pa == z) ? bv[z] : av; ai = (pa == z) ? bi[z] : ai; ovv = (pb == z) ? ov[z] : ovv; oii = (pb == z) ? oi[z] : oii; }
                const bool takeA = (av > ovv) || (av == ovv && ai < oii);
                tv[k] = takeA ? av : ovv; ti[k] = takeA ? ai : oii; pa += takeA ? 1 : 0; pb += takeA ? 0 : 1; }
            if (hh == 0) {
                const float e1 = __expf(tv[1] - tv[0]), e2 = __expf(tv[2] - tv[0]), e3 = __expf(tv[3] - tv[0]); const float inv = 1.0f / (1.0f + e1 + e2 + e3);
                const float gt[4] = {inv, e1 * inv, e2 * inv, e3 * inv};
                lcnt[lane] = 0u; LDS_WAIT(); asm volatile("" ::: "memory");
                unsigned lr[4];
#pragma unroll
                for (int k = 0; k < 4; ++k) lr[k] = __hip_atomic_fetch_add(lcnt + ti[k], 1u, __ATOMIC_RELAXED, __HIP_MEMORY_SCOPE_WORKGROUP);
                LDS_WAIT(); asm volatile("" ::: "memory");
                { const unsigned n = lcnt[lane]; unsigned bs = 0u; if (n) bs = __hip_atomic_fetch_add(cnt + 64 * lane, n, __ATOMIC_RELAXED, __HIP_MEMORY_SCOPE_AGENT); lcnt[32 + lane] = bs; }
                LDS_WAIT(); asm volatile("" ::: "memory");
                int ps[4];
#pragma unroll
                for (int k = 0; k < 4; ++k) { ps[k] = (int)(lcnt[32 + ti[k]] + lr[k]); ROWTOK[(size_t)ti[k] * MROWS + ps[k]] = row; }
                *(i32x4*)(TOPE + (size_t)row * 4) = (i32x4){ti[0], ti[1], ti[2], ti[3]};
                *(i32x4*)(TOPP + (size_t)row * 4) = (i32x4){ps[0], ps[1], ps[2], ps[3]};
                *(f32x4*)(TOPG + (size_t)row * 4) = (f32x4){gt[0], gt[1], gt[2], gt[3]};
            }
        }
    }
    __syncthreads();
}

__device__ __forceinline__ void build_tile_table(const unsigned* cnt, LAS int* tstart) {
    const int tid_ = opaque_tid();
    if (tid_ < 64) {
        const int lane = tid_; const int n = (lane < NEXP) ? (int)__hip_atomic_load(cnt + 64 * lane, __ATOMIC_RELAXED, __HIP_MEMORY_SCOPE_AGENT) : 0;
        const int tiles = (n + 255) >> 8; int incl = tiles;
#pragma unroll
        for (int o = 1; o < 64; o <<= 1) { const int v = __shfl_up(incl, o); if (lane >= o) incl += v; }
        if (lane <= NEXP) tstart[lane] = incl - tiles;
        if (lane < NEXP) tstart[64 + lane] = n;
    }
    LDS_WAIT(); __syncthreads();
}

struct CombRow { f32x4 z[8]; };
template <bool last>
__device__ __forceinline__ void phase_combine_ln(const PArgs& a, int layer, const LAS int* tstart, int vcu, int G, bool dummy) {
    const int tid = opaque_tid(), lane = tid & 63, wave = __builtin_amdgcn_readfirstlane(tid >> 6);
    LAS unsigned char* lds_b = (LAS unsigned char*)tstart - TBL_OFF;
    const int gw = vcu * 8 + wave, NGW = G * 8;
    unsigned char* ws = a.ws;
    const bf16_t* HBin = (const bf16_t*)(ws + WS_HB); const unsigned char* YE = (const unsigned char*)(ws + WS_YEXP);
    bf16_t* HB = dummy ? (bf16_t*)(ws + WS_P) : (bf16_t*)(ws + WS_HB);
    unsigned char* H8 = ws + WS_HB8;
    const int* TOPE = (const int*)(ws + WS_TOPE); const int* TOPP = (const int*)(ws + WS_TOPP); const float* TOPG = (const float*)(ws + WS_TOPG);
    const float* g = a.in(I_LNG) + (size_t)(layer * 2 + 1) * DM; const float* bta = a.in(I_LNB) + (size_t)(layer * 2 + 1) * DM;
    float* outp = dummy ? (float*)(ws + WS_Y) : a.out();
    LAS float* gl = (LAS float*)(lds_b);
    { const int tid_ = tid; *(LAS f32x4*)(gl + 4 * tid_) = *(const f32x4*)(g + 4 * tid_); *(LAS f32x4*)(gl + 2048 + 4 * tid_) = *(const f32x4*)(bta + 4 * tid_); }
    LDS_WAIT(); __syncthreads();
#define IDX_LOAD(te_, tp_, tg_, m) do { te_ = *(const i32x4*)(TOPE + (size_t)(m) * 4); tp_ = *(const i32x4*)(TOPP + (size_t)(m) * 4); tg_ = *(const f32x4*)(TOPG + (size_t)(m) * 4); } while (0)
#define RAW_ISSUE(m, te_, tp_) do { \
        const unsigned o0_ = (unsigned)((tstart[te_[0]] * 256 + tp_[0])) , o1_ = (unsigned)((tstart[te_[1]] * 256 + tp_[1])), o2_ = (unsigned)((tstart[te_[2]] * 256 + tp_[2])), o3_ = (unsigned)((tstart[te_[3]] * 256 + tp_[3])); \
        _Pragma("unroll") for (int j = 0; j < 8; ++j) { const int c = 4 * lane + 256 * j; hwv[j] = *(const u32x2*)(HBin + (size_t)(m) * DM + c); \
            wv[j][0] = *(const unsigned*)(YE + (size_t)o0_ * DM + c); wv[j][1] = *(const unsigned*)(YE + (size_t)o1_ * DM + c); wv[j][2] = *(const unsigned*)(YE + (size_t)o2_ * DM + c); wv[j][3] = *(const unsigned*)(YE + (size_t)o3_ * DM + c); } } while (0)
#define COMB_CONVERT(R, tg_) do { _Pragma("unroll") for (int j = 0; j < 8; ++j) { const u32x2 hw_ = hwv[j]; f32x4 v_ = (f32x4){bflo(hw_.x), bfhi(hw_.x), bflo(hw_.y), bfhi(hw_.y)} * DN_ALPHA; \
            const unsigned w0_ = wv[j][0], w1_ = wv[j][1], w2_ = wv[j][2], w3_ = wv[j][3]; \
            const f32x2 a0_ = __builtin_amdgcn_cvt_pk_f32_fp8((int)w0_, false), c0_ = __builtin_amdgcn_cvt_pk_f32_fp8((int)w0_, true), a1_ = __builtin_amdgcn_cvt_pk_f32_fp8((int)w1_, false), c1_ = __builtin_amdgcn_cvt_pk_f32_fp8((int)w1_, true); \
            const f32x2 a2_ = __builtin_amdgcn_cvt_pk_f32_fp8((int)w2_, false), c2_ = __builtin_amdgcn_cvt_pk_f32_fp8((int)w2_, true), a3_ = __builtin_amdgcn_cvt_pk_f32_fp8((int)w3_, false), c3_ = __builtin_amdgcn_cvt_pk_f32_fp8((int)w3_, true); \
            v_[0] += tg_[0] * a0_[0] + tg_[1] * a1_[0] + tg_[2] * a2_[0] + tg_[3] * a3_[0]; \
            v_[1] += tg_[0] * a0_[1] + tg_[1] * a1_[1] + tg_[2] * a2_[1] + tg_[3] * a3_[1]; \
            v_[2] += tg_[0] * c0_[0] + tg_[1] * c1_[0] + tg_[2] * c2_[0] + tg_[3] * c3_[0]; \
            v_[3] += tg_[0] * c0_[1] + tg_[1] * c1_[1] + tg_[2] * c2_[1] + tg_[3] * c3_[1]; \
            (R).z[j] = v_; } } while (0)
#define COMB_FINISH(R, m) do { float s_ = 0.f; _Pragma("unroll") for (int j = 0; j < 8; ++j) s_ += ((R).z[j][0] + (R).z[j][1]) + ((R).z[j][2] + (R).z[j][3]); \
        const float mean_ = wave_sum(s_) * (1.0f / DM); float s2_ = 0.f; \
        _Pragma("unroll") for (int j = 0; j < 8; ++j) { (R).z[j] = (R).z[j] - mean_; s2_ += ((R).z[j][0] * (R).z[j][0] + (R).z[j][1] * (R).z[j][1]) + ((R).z[j][2] * (R).z[j][2] + (R).z[j][3] * (R).z[j][3]); } \
        const float rstd_ = 1.0f / sqrtf(wave_sum(s2_) * (1.0f / DM) + LN_EPS); const int b_ = (m) / NTOK, t_ = (m) % NTOK; \
        _Pragma("unroll") for (int j = 0; j < 8; ++j) { const int c = 4 * lane + 256 * j; \
            const f32x4 o_ = (R).z[j] * rstd_ * *(const LAS f32x4*)(gl + c) + *(const LAS f32x4*)(gl + 2048 + c); \
            if (!last) { u32x2 w_; w_.x = cvtpk(o_[0], o_[1]); w_.y = cvtpk(o_[2], o_[3]); *(u32x2*)(HB + (size_t)(m) * DM + c) = w_; \
                *(unsigned*)(H8 + (size_t)(m) * DM + c) = cvt4_fp8(o_[0], o_[1], o_[2], o_[3]); } \
            else if (t_ >= NMETA && t_ < NMETA + SEQ) *(f32x4*)(outp + ((size_t)b_ * SEQ + (t_ - NMETA)) * DM + c) = o_; } } while (0)
    if (gw < MROWS) {
        i32x4 teA, tpA, teB, tpB; f32x4 tgA, tgB, tgC; u32x2 hwv[8]; unsigned wv[8][4]; CombRow r;
        IDX_LOAD(teA, tpA, tgA, gw);
        RAW_ISSUE(gw, teA, tpA); tgC = tgA;
        { const int m1 = (gw + NGW < MROWS) ? gw + NGW : gw; IDX_LOAD(teB, tpB, tgB, m1); }
        int m = gw;
#define COMB_STEP(teX, tpX, tgX, teY, tpY, tgY) do { const int m1 = (m + NGW < MROWS) ? m + NGW : m, m2 = (m + 2 * NGW < MROWS) ? m + 2 * NGW : m; \
            COMB_CONVERT(r, tgC);                              \
            RAW_ISSUE(m1, teX, tpX); tgC = tgX;                \
            IDX_LOAD(teY, tpY, tgY, m2);                       \
            asm volatile("" ::: "memory"); } while (0)
        COMB_STEP(teB, tpB, tgB, teA, tpA, tgA);
        for (;;) {
            COMB_FINISH(r, m);
            m += NGW; if (m >= MROWS) break;
            COMB_STEP(teA, tpA, tgA, teB, tpB, tgB);
            COMB_FINISH(r, m);
            m += NGW; if (m >= MROWS) break;
            COMB_STEP(teB, tpB, tgB, teA, tpA, tgA);
        }
#undef COMB_STEP
    }
#undef IDX_LOAD
#undef RAW_ISSUE
#undef COMB_CONVERT
#undef COMB_FINISH
}
namespace att {
constexpr int KVBLK = 64;
constexpr int BUF_BYTES = 40960, OFF_KN = 0, OFF_KR = 16384, OFF_V = 24576, OFF_WS = 2 * BUF_BYTES, OFF_FLAG = OFF_WS + 8 * 256;
#define KSWZ(row, colB) ((row) * 256 + ((colB) ^ (((row) & 7) << 4)))
#define KRSWZ(row, colB) ((row) * 128 + ((colB) ^ (((row) & 7) << 4)))
__device__ __forceinline__ int crow(int r, int hi) { return (r & 3) + 8 * (r >> 2) + 4 * hi; }
__device__ __forceinline__ int v_st(int k, int c) { const int kk = (k & ~0xC) | ((k & 4) << 1) | ((k & 8) >> 1); return ((kk >> 3) * 4 + (c >> 5)) * 512 + ((kk & 7) * 32 + (c & 31)) * 2; }
__device__ __forceinline__ int v_rd_base(int lane) { return ((lane & 3) << 3) | (((lane >> 2) & 3) << 6) | (((lane >> 4) & 1) << 5) | (((lane >> 5) & 1) << 8); }
constexpr int v_rd_off(int d0, int ks, int half) { return d0 * 512 + ks * 4096 + half * 2048; }
template <int OFF> __device__ __forceinline__ s16x4 tr_read(int vb) { s16x4 r; asm volatile("ds_read_b64_tr_b16 %0, %1 offset:%2" : "=&v"(r) : "v"(vb), "i"(OFF) : "memory"); return r; }
template <int D0> __device__ __forceinline__ void pv_one(f32x16& od, int vb, bf16x8 pa0, bf16x8 pa1, bf16x8 pa2, bf16x8 pa3) {
    const s16x4 l0 = tr_read<v_rd_off(D0, 0, 0)>(vb), h0 = tr_read<v_rd_off(D0, 0, 1)>(vb), l1 = tr_read<v_rd_off(D0, 1, 0)>(vb), h1 = tr_read<v_rd_off(D0, 1, 1)>(vb);
    const s16x4 l2 = tr_read<v_rd_off(D0, 2, 0)>(vb), h2 = tr_read<v_rd_off(D0, 2, 1)>(vb), l3 = tr_read<v_rd_off(D0, 3, 0)>(vb), h3 = tr_read<v_rd_off(D0, 3, 1)>(vb);
    asm volatile("s_waitcnt lgkmcnt(0)" ::: "memory"); SBAR();
#define PK(L, H) (bf16x8){L[0], L[1], L[2], L[3], H[0], H[1], H[2], H[3]}
    od = __builtin_amdgcn_mfma_f32_32x32x16_bf16(pa0, PK(l0, h0), od, 0, 0, 0);
    od = __builtin_amdgcn_mfma_f32_32x32x16_bf16(pa1, PK(l1, h1), od, 0, 0, 0);
    od = __builtin_amdgcn_mfma_f32_32x32x16_bf16(pa2, PK(l2, h2), od, 0, 0, 0);
    od = __builtin_amdgcn_mfma_f32_32x32x16_bf16(pa3, PK(l3, h3), od, 0, 0, 0);
#undef PK
}
__device__ __forceinline__ void pv_d0(f32x16* o, int vb, bf16x8 pa0, bf16x8 pa1, bf16x8 pa2, bf16x8 pa3) {
    pv_one<0>(o[0], vb, pa0, pa1, pa2, pa3); pv_one<1>(o[1], vb, pa0, pa1, pa2, pa3); pv_one<2>(o[2], vb, pa0, pa1, pa2, pa3); pv_one<3>(o[3], vb, pa0, pa1, pa2, pa3);
}
__device__ __forceinline__ void pack_p(const f32x16& p0, const f32x16& p1, bf16x8& pa0, bf16x8& pa1, bf16x8& pa2, bf16x8& pa3) {
#define PK4(P, BASE, OUT) do { unsigned a0 = cvtpk(P[BASE + 0], P[BASE + 1]), a1 = cvtpk(P[BASE + 2], P[BASE + 3]);   \
    unsigned b0 = cvtpk(P[BASE + 4], P[BASE + 5]), b1 = cvtpk(P[BASE + 6], P[BASE + 7]);                              \
    auto r0 = __builtin_amdgcn_permlane32_swap(a0, b0, false, false); auto r1 = __builtin_amdgcn_permlane32_swap(a1, b1, false, false); \
    u32x4 w = {r0[0], r1[0], r0[1], r1[1]}; OUT = __builtin_bit_cast(bf16x8, w); } while (0)
    PK4(p0, 0, pa0); PK4(p0, 8, pa1); PK4(p1, 0, pa2); PK4(p1, 8, pa3);
#undef PK4
}
__device__ __forceinline__ float xhalf_max(float v) { auto rr = __builtin_amdgcn_permlane32_swap(__float_as_uint(v), __float_as_uint(v), false, false); return fmaxf(__uint_as_float(rr[0]), __uint_as_float(rr[1])); }
__device__ __forceinline__ float xhalf_sum(float v) { auto rr = __builtin_amdgcn_permlane32_swap(__float_as_uint(v), __float_as_uint(v), false, false); return __uint_as_float(rr[0]) + __uint_as_float(rr[1]); }

template <bool MLA>
__device__ __forceinline__ void attn_unit(LAS unsigned char* lds, const bf16_t* __restrict__ Qp, int ldq, const bf16_t* __restrict__ Kn, int ldk, const bf16_t* __restrict__ Kr,
                                          const bf16_t* __restrict__ Vp, int ldv, unsigned char* __restrict__ Op, int ldo, int q0) {
    constexpr int NQ = MLA ? 12 : 8, NQR = 8;
    const int tid = opaque_tid(), wid = __builtin_amdgcn_readfirstlane(tid >> 6), lane = tid & 63, r32 = lane & 31, hi = lane >> 5;
    LAS float* wsl = (LAS float*)(lds + OFF_WS) + wid * 64; LAS float* li_l = wsl; LAS float* al_l = wsl + 32;
    volatile LAS unsigned* flags = (volatile LAS unsigned*)(lds + OFF_FLAG);
    const int t = q0 + wid * 32 + r32;
    const int tq = t < NTOK ? t : NTOK - 1;
    float m_reg = -1e30f, l_reg = 0.f, R = 0.f; f32x16 o[4];
#pragma unroll
    for (int d = 0; d < 4; ++d)
#pragma unroll
        for (int r = 0; r < 16; ++r) o[d][r] = 0.f;
    bf16x8 qr[NQR];
    const bf16_t* Qw = Qp + (size_t)tq * ldq + hi * 8;
#pragma unroll
    for (int d0 = 0; d0 < NQR; ++d0) qr[d0] = *(const bf16x8*)(Qw + d0 * 16);
    const int sr = tid >> 4, sc = (tid & 15) * 8, vst0 = v_st(sr, sc), vst1 = v_st(32 + sr, sc);
    const int krr = tid >> 3, krc = (tid & 7) * 8;
    const int vb0 = (int)(uintptr_t)(lds + OFF_V) + v_rd_base(lane);
    bf16x8 vs0, vs1, ks0, ks1, kr0;
    const unsigned offV0 = (unsigned)(sr * ldv + sc) * 2u, offV1 = (unsigned)((32 + sr) * ldv + sc) * 2u, offK0 = (unsigned)(sr * ldk + sc) * 2u, offK1 = (unsigned)((32 + sr) * ldk + sc) * 2u, offR = (unsigned)(krr * 64 + krc) * 2u;
#define SLOAD(k0) do { const char* vb_ = (const char*)(Vp + (size_t)(k0) * ldv); const char* kb_ = (const char*)(Kn + (size_t)(k0) * ldk); \
    vs0 = *(const bf16x8*)(vb_ + offV0); vs1 = *(const bf16x8*)(vb_ + offV1); ks0 = *(const bf16x8*)(kb_ + offK0); ks1 = *(const bf16x8*)(kb_ + offK1); \
    if (MLA) kr0 = *(const bf16x8*)((const char*)(Kr + (size_t)(k0) * 64) + offR); } while (0)
#define SWRITE(b) do { LAS unsigned char* bb = lds + (b) * BUF_BYTES; *(LAS bf16x8*)(bb + OFF_V + vst0) = vs0; *(LAS bf16x8*)(bb + OFF_V + vst1) = vs1; \
    *(LAS bf16x8*)(bb + OFF_KN + KSWZ(sr, sc * 2)) = ks0; *(LAS bf16x8*)(bb + OFF_KN + KSWZ(32 + sr, sc * 2)) = ks1; \
    if (MLA) *(LAS bf16x8*)(bb + OFF_KR + KRSWZ(krr, krc * 2)) = kr0; } while (0)
    int NT, jfirst, jstep;
    if (MLA) { const int emax = chunk_end(q0 + 255 < NTOK ? q0 + 255 : NTOK - 1); NT = (emax + 63) / 64; if (NT > NTOK / 64) NT = NTOK / 64; jfirst = 0; jstep = 1; }
    else { int jh = (q0 + 255) / 64; if (jh > NTOK / 64 - 1) jh = NTOK / 64 - 1; NT = jh + 1; jfirst = jh; jstep = -1; }
    const int emin = MLA ? chunk_end(q0) : 0;
    const int e_t = chunk_end(tq);
    constexpr float SC = MLA ? 0.072168783648703220f : 0.088388347648318440f;
    constexpr float C = SC * 1.4426950408889634f;
    SLOAD(jfirst * KVBLK); VM_WAIT(); SWRITE(0); LDS_WAIT(); __syncthreads();
    for (int it = 0; it < NT; ++it) {
        const int j = jfirst + it * jstep; const int cb = it & 1;
        const bool more = (it + 1 < NT);
        if (more) SLOAD((j + jstep) * KVBLK);
        SBAR();
        f32x16 p0, p1;
#pragma unroll
        for (int r = 0; r < 16; ++r) { p0[r] = 0.f; p1[r] = 0.f; }
        { const LAS unsigned char* Ks = lds + cb * BUF_BYTES + OFF_KN; const LAS unsigned char* Krs = lds + cb * BUF_BYTES + OFF_KR;
#pragma unroll
          for (int d0 = 0; d0 < NQ; ++d0) {
              bf16x8 b0, b1;
              if (d0 < 8) { const int cbb = (d0 * 16 + hi * 8) * 2; b0 = *(const LAS bf16x8*)(Ks + KSWZ(r32, cbb)); b1 = *(const LAS bf16x8*)(Ks + KSWZ(32 + r32, cbb)); }
              else { const int cbb = ((d0 - 8) * 16 + hi * 8) * 2; b0 = *(const LAS bf16x8*)(Krs + KRSWZ(r32, cbb)); b1 = *(const LAS bf16x8*)(Krs + KRSWZ(32 + r32, cbb)); }
              const bf16x8 qf = (d0 < NQR) ? qr[d0 < NQR ? d0 : 0] : *(const bf16x8*)(Qw + d0 * 16);
              p0 = __builtin_amdgcn_mfma_f32_32x32x16_bf16(b0, qf, p0, 0, 0, 0);
              p1 = __builtin_amdgcn_mfma_f32_32x32x16_bf16(b1, qf, p1, 0, 0, 0); } }
        const int kbase = j * KVBLK;
        if (MLA) {
            if (kbase + KVBLK > emin) {
#pragma unroll
                for (int r = 0; r < 16; ++r) { const int k0 = kbase + crow(r, hi); p0[r] = (k0 < e_t) ? p0[r] : -1e30f; p1[r] = (k0 + 32 < e_t) ? p1[r] : -1e30f; } }
            float pmax = p0[0];
#pragma unroll
            for (int r = 1; r < 16; ++r) pmax = fmaxf(pmax, p0[r]);
#pragma unroll
            for (int r = 0; r < 16; ++r) pmax = fmaxf(pmax, p1[r]);
            pmax = xhalf_max(pmax);
            const float mn = fmaxf(m_reg, pmax); const float alpha = __builtin_amdgcn_exp2f((m_reg - mn) * C); m_reg = mn;
            const float mnC = -mn * C; float ps = 0.f;
#pragma unroll
            for (int r = 0; r < 16; ++r) { p0[r] = __builtin_amdgcn_exp2f(fmaf(p0[r], C, mnC)); p1[r] = __builtin_amdgcn_exp2f(fmaf(p1[r], C, mnC)); ps += p0[r] + p1[r]; }
            ps = xhalf_sum(ps); l_reg = l_reg * alpha + ps;
            if (__any(alpha < 1.f)) { if (hi == 0) al_l[r32] = alpha; LDS_WAIT();
#pragma unroll
                for (int d = 0; d < 4; ++d)
#pragma unroll
                    for (int r = 0; r < 16; ++r) o[d][r] *= al_l[crow(r, hi)]; }
        } else {
#define SB_LK(zz, kk) (((kk) < t) ? -(fmaxf((zz), 0.f) + 0.6931471805599453f * __builtin_amdgcn_logf(1.0f + __builtin_amdgcn_exp2f(-fabsf(zz) * 1.4426950408889634f))) : 0.f)
#pragma unroll
            for (int r = 0; r < 16; ++r) { p0[r] *= SC; p1[r] *= SC; }
            float abv[2][4]; float run = 0.f;
#pragma unroll
            for (int tt = 1; tt >= 0; --tt)
#pragma unroll
                for (int c = 3; c >= 0; --c) {
                    float mine = 0.f;
#pragma unroll
                    for (int i = 0; i < 4; ++i) { const int r = 4 * c + i; const int kk = kbase + 32 * tt + crow(r, hi); mine += SB_LK(tt ? p1[r] : p0[r], kk); }
                    const float other = __shfl_xor(mine, 32);
                    const float g_hi1 = hi ? mine : other, g_hi0 = hi ? other : mine;
                    abv[tt][c] = hi ? run : run + g_hi1;
                    run += g_hi1 + g_hi0; }
#pragma unroll
            for (int tt = 0; tt < 2; ++tt)
#pragma unroll
                for (int c = 0; c < 4; ++c) {
                    float cum = R + abv[tt][c];
#pragma unroll
                    for (int i = 3; i >= 0; --i) { const int r = 4 * c + i; const int kk = kbase + 32 * tt + crow(r, hi);
                        const float z = tt ? p1[r] : p0[r]; cum += SB_LK(z, kk);
                        const float av = (kk < t) ? __builtin_amdgcn_exp2f((z + cum) * 1.4426950408889634f) : 0.f;
                        if (tt) p1[r] = av; else p0[r] = av; } }
#undef SB_LK
            R += run;
        }
        bf16x8 pa0, pa1, pa2, pa3; pack_p(p0, p1, pa0, pa1, pa2, pa3);
        SBAR();
        pv_d0(o, vb0 + cb * BUF_BYTES, pa0, pa1, pa2, pa3);
        if (!MLA) { const bool done = __all((R < -60.f) || (t >= NTOK)); if (lane == 0) flags[(it & 1) * 8 + wid] = done ? 1u : 0u; }
        if (more) { VM_WAIT(); SWRITE(cb ^ 1); }
        LDS_WAIT(); __syncthreads();
        if (!MLA) { unsigned alld = 1u;
#pragma unroll
            for (int w = 0; w < 8; ++w) alld &= flags[(it & 1) * 8 + w];
            if (alld) break; }
    }
    float rli[16];
    if (MLA) { if (hi == 0) li_l[r32] = l_reg; LDS_WAIT();
#pragma unroll
        for (int r = 0; r < 16; ++r) rli[r] = __builtin_amdgcn_rcpf(li_l[crow(r, hi)]); }
    else {
#pragma unroll
        for (int r = 0; r < 16; ++r) rli[r] = 1.f; }
#pragma unroll
    for (int r = 0; r < 16; ++r) { const int orow = q0 + wid * 32 + crow(r, hi);
        if (orow < NTOK) {
#pragma unroll
            for (int d0 = 0; d0 < 4; ++d0) Op[(size_t)orow * ldo + d0 * 32 + r32] = om_fp8(o[d0][r] * rli[r]); } }
    __syncthreads();
#undef SLOAD
#undef SWRITE
}
#undef KSWZ
#undef KRSWZ

__device__ __forceinline__ void phase_attention(const PArgs& a, LAS unsigned char* lds, int layer) {
    unsigned char* ws = a.ws;
    unsigned* qctr = (unsigned*)(ws + WS_CTL) + CW_Q + 64 * layer;
    const bf16_t* P = (const bf16_t*)(ws + WS_P); const bf16_t* QM = (const bf16_t*)(ws + WS_QM); const bf16_t* KN = (const bf16_t*)(ws + WS_KN);
    const bf16_t* KR = (const bf16_t*)(ws + WS_KR); const bf16_t* VM = (const bf16_t*)(ws + WS_VM); unsigned char* OM = ws + WS_OM;
    volatile LAS unsigned* slot = (volatile LAS unsigned*)(lds + OFF_FLAG + 128);
    constexpr int NQB = 33, NU = 16 * NQB;
    for (;;) {
        if (opaque_tid() == 0) slot[0] = __hip_atomic_fetch_add(qctr, 1u, __ATOMIC_RELAXED, __HIP_MEMORY_SCOPE_AGENT);
        LDS_WAIT(); __syncthreads();
        const unsigned u = slot[0];
        __syncthreads();
        if (u >= 2u * NU) break;
        if (u < (unsigned)NU) {
            const int qb = NQB - 1 - (int)(u / 16), bh = (int)(u % 16), b = bh >> 2, h = bh & 3; const size_t r0 = (size_t)b * NTOK;
            attn_unit<true>(lds, QM + r0 * 768 + h * 192, 768, KN + r0 * 512 + h * 128, 512, KR + r0 * 64, VM + r0 * 512 + h * 128, 512, OM + r0 * 1024 + h * 128, 1024, qb * 256);
        } else {
            const int v = (int)u - NU; const int qb = NQB - 1 - v / 16, bh = v % 16, b = bh >> 2, h = bh & 3; const size_t r0 = (size_t)b * NTOK;
            attn_unit<false>(lds, P + r0 * EVP + EC_SBQ + h * 128, EVP, P + r0 * EVP + EC_SBK + h * 128, EVP, nullptr, P + r0 * EVP + EC_SBV + h * 128, EVP, OM + r0 * 1024 + 512 + h * 128, 1024, qb * 256);
        }
    }
}
}
namespace idx {
__device__ __forceinline__ int crow(int r, int hi) { return (r & 3) + 8 * (r >> 2) + 4 * hi; }
constexpr int KCH = 256;
constexpr int NCH = (NTOK + KCH - 1) / KCH;
constexpr int NITEMS = 17680;
constexpr int NQG = MROWS / 32;

constexpr int SPITCH = 136;
__device__ __forceinline__ unsigned short score_key(float f) { unsigned h; asm volatile("v_cvt_f16_f32 %0, %1" : "=v"(h) : "v"(f)); const int m = ((int)(h << 16)) >> 31; return (unsigned short)(h ^ ((unsigned)m | 0x8000u)); }
__device__ __forceinline__ void phase_indexer(const PArgs& a, LAS unsigned char* lds, int vcu, int G) {
    const int tid = opaque_tid(), lane = tid & 63, wave = __builtin_amdgcn_readfirstlane(tid >> 6), r32 = lane & 31, hh = lane >> 5;
    const int gw = vcu * 8 + wave, NGW = G * 8;
    unsigned char* ws = a.ws;
    const bf16_t* P = (const bf16_t*)(ws + WS_P); unsigned short* SCO = (unsigned short*)(ws + WS_BIG);
    LAS float* wtab = (LAS float*)(lds + wave * 16384);
    LAS unsigned char* stg = lds + wave * 16384 + 1024;
    const int lo = (int)((long)gw * NITEMS / NGW), hi = (int)((long)(gw + 1) * NITEMS / NGW);
    int b = lo / 4420, g = 0, ck = lo % 4420;
#pragma unroll 1
    for (;;) { const int ng_ = (g + 2) / 8 + 1; if (ck < ng_) break; ck -= ng_; ++g; }
    for (int item = lo; item < hi; ) {
        const int nchunk = (g + 2) / 8 + 1; const int take = (hi - item < nchunk - ck) ? hi - item : nchunk - ck;
        const int t0 = g * 32;
        const int lmax = chunk_end(t0 + 31) < NTOK ? chunk_end(t0 + 31) : NTOK;
        const int k0 = ck * KCH;
        const int kend = (k0 + take * KCH < lmax) ? k0 + take * KCH : lmax; const int ntile = (kend - k0 + 31) / 32;
        item += take; ck += take;
        const int b_cur = b, g_done = (ck == nchunk);
        if (g_done) { ck = 0; ++g; if (g == NQG / BATCH) { g = 0; ++b; } }
        const size_t qrow = (size_t)b_cur * NTOK + t0 + r32;
        bf16x8 qa[8][4];
#pragma unroll
        for (int h = 0; h < 8; ++h)
#pragma unroll
            for (int s = 0; s < 4; ++s) qa[h][s] = *(const bf16x8*)(P + qrow * ODP + OC_IQ + h * 64 + s * 16 + hh * 8);
        if (hh == 0) { const u32x4 wv = *(const u32x4*)(P + qrow * ODP + OC_IW);
            const float w8[8] = {bflo(wv.x), bfhi(wv.x), bflo(wv.y), bfhi(wv.y), bflo(wv.z), bfhi(wv.z), bflo(wv.w), bfhi(wv.w)};
#pragma unroll
            for (int h = 0; h < 8; ++h) wtab[h * 32 + r32] = w8[h] * 0.044194173824159216f; }
        LDS_WAIT(); asm volatile("" ::: "memory");
        bf16x8 kb[4], kn[4];
        { const size_t krow = (size_t)b_cur * NTOK + k0 + r32;
#pragma unroll
          for (int s = 0; s < 4; ++s) kb[s] = *(const bf16x8*)(P + krow * ODP + OC_IK + s * 16 + hh * 8); }
        for (int tl = 0; tl < ntile; ++tl) {
            asm volatile("" ::: "memory");
            const int key0 = k0 + 32 * tl;
            { const int kx = (tl + 1 < ntile) ? key0 + 32 : key0; const size_t krow = (size_t)b_cur * NTOK + kx + r32;
#pragma unroll
              for (int s = 0; s < 4; ++s) kn[s] = *(const bf16x8*)(P + krow * ODP + OC_IK + s * 16 + hh * 8); }
            float sc[16];
#pragma unroll
            for (int r = 0; r < 16; ++r) sc[r] = 0.f;
#pragma unroll
            for (int h = 0; h < 8; h += 2) {
                f32x16 xa, xb;
#pragma unroll
                for (int r = 0; r < 16; ++r) { xa[r] = 0.f; xb[r] = 0.f; }
#pragma unroll
                for (int s = 0; s < 4; ++s) { xa = __builtin_amdgcn_mfma_f32_32x32x16_bf16(qa[h][s], kb[s], xa, 0, 0, 0);
                    xb = __builtin_amdgcn_mfma_f32_32x32x16_bf16(qa[h + 1][s], kb[s], xb, 0, 0, 0); SBAR(); }
#pragma unroll
                for (int c = 0; c < 4; ++c) { const f32x4 wa4 = *(const LAS f32x4*)(wtab + h * 32 + 8 * c + 4 * hh), wb4 = *(const LAS f32x4*)(wtab + (h + 1) * 32 + 8 * c + 4 * hh);
#pragma unroll
                    for (int i = 0; i < 4; i += 2) {
                        const int a0 = __float_as_int(xa[4 * c + i]), a1 = __float_as_int(xa[4 * c + i + 1]), b0 = __float_as_int(xb[4 * c + i]), b1 = __float_as_int(xb[4 * c + i + 1]);
                        const f32x2 ra = {__int_as_float(a0 > 0 ? a0 : 0), __int_as_float(a1 > 0 ? a1 : 0)}, rb = {__int_as_float(b0 > 0 ? b0 : 0), __int_as_float(b1 > 0 ? b1 : 0)};
                        const f32x2 wa = {wa4[i], wa4[i + 1]}, wb = {wb4[i], wb4[i + 1]}; f32x2 s2 = {sc[4 * c + i], sc[4 * c + i + 1]};
                        s2 = __builtin_elementwise_fma(wa, ra, s2); s2 = __builtin_elementwise_fma(wb, rb, s2); sc[4 * c + i] = s2[0]; sc[4 * c + i + 1] = s2[1]; } }
            }
            { int cb2 = ((tl & 3) * 32 + r32 + 4 * hh * SPITCH) * 2; asm volatile("" : "+v"(cb2));
#pragma unroll
              for (int r = 0; r < 16; ++r) *(LAS unsigned short*)(stg + cb2 + ((r & 3) + 8 * (r >> 2)) * SPITCH * 2) = score_key(sc[r]); }
            if ((tl & 3) == 3 || tl == ntile - 1) {
                const int ncol = 32 * ((tl & 3) + 1);
                char* gbase = (char*)(SCO + ((size_t)b_cur * NTOK + t0) * NTOK + k0 + 128 * (tl >> 2));
                LDS_WAIT(); asm volatile("" ::: "memory");
                int ln = lane; asm volatile("" : "+v"(ln));
                const int c8 = 8 * (ln & 15); const unsigned goff = (unsigned)((ln >> 4) * NTOK + c8) * 2u; const int soff = ((ln >> 4) * SPITCH + c8) * 2;
                if (c8 < ncol) {
#pragma unroll 1
                    for (int i = 0; i < 8; ++i) { const u32x4 pv = *(const LAS u32x4*)(stg + soff + i * 4 * SPITCH * 2); *(u32x4*)(gbase + goff + (size_t)i * 4 * NTOK * 2) = pv; }
                }
                asm volatile("" ::: "memory");
            }
#pragma unroll
            for (int s = 0; s < 4; ++s) kb[s] = kn[s];
        }
        LDS_WAIT(); asm volatile("" ::: "memory");
    }
}

__device__ __forceinline__ int t5_bucket(int rel) {
    const int base = rel > 0 ? 16 : 0; const int n = rel < 0 ? -rel : rel;
    if (n < 8) return base + n;
    int large = 8 + (31 - __builtin_clz((unsigned)(n * n))) - 6; large = large < 15 ? large : 15;
    return base + large;
}
__device__ __forceinline__ unsigned ord_key(float f) { const unsigned u = __float_as_uint(f); return (u & 0x80000000u) ? ~u : (u | 0x80000000u); }

constexpr int VPITCH = 272;
template <int OFF> __device__ __forceinline__ s16x4 tr_read_i(int vb) { s16x4 r; asm volatile("ds_read_b64_tr_b16 %0, %1 offset:%2" : "=&v"(r) : "v"(vb), "i"(OFF) : "memory"); return r; }
__device__ __forceinline__ void pv_chunk(f32x4 (&oc)[8], int vb, bf16x8 pa) {
    s16x4 lo[8], hi[8];
#define PV_RD(d) lo[d] = tr_read_i<(d) * 32>(vb); hi[d] = tr_read_i<(d) * 32 + 16 * VPITCH>(vb)
    PV_RD(0); PV_RD(1); PV_RD(2); PV_RD(3); PV_RD(4); PV_RD(5); PV_RD(6); PV_RD(7);
#undef PV_RD
    asm volatile("s_waitcnt lgkmcnt(0)" ::: "memory"); SBAR();
#pragma unroll
    for (int d = 0; d < 8; ++d) { const bf16x8 vf = {lo[d][0], lo[d][1], lo[d][2], lo[d][3], hi[d][0], hi[d][1], hi[d][2], hi[d][3]};
        oc[d] = __builtin_amdgcn_mfma_f32_16x16x32_bf16(pa, vf, oc[d], 0, 0, 0); }
}
__device__ __forceinline__ void phase_select_attend(const PArgs& a, LAS unsigned char* lds, int vcu, int G) {
    const int tid = opaque_tid(), lane = tid & 63, wave = __builtin_amdgcn_readfirstlane(tid >> 6);
    const int gw = vcu * 8 + wave, NGW = G * 8;
    unsigned char* ws = a.ws;
    const bf16_t* P = (const bf16_t*)(ws + WS_P); const unsigned short* SCO = (const unsigned short*)(ws + WS_BIG); unsigned char* OM = ws + WS_OM;
    LAS unsigned char* wl = lds + wave * 16384;
    LAS unsigned* hist = (LAS unsigned*)wl;
    LAS unsigned long long* cand = (LAS unsigned long long*)wl;
    LAS unsigned* hist2 = (LAS unsigned*)(wl + 8704);
    LAS unsigned long long* cand2 = (LAS unsigned long long*)(wl + 9728);
    LAS int* bkt = (LAS int*)(wl + 13312);
    LAS float* btab = (LAS float*)(wl + 14336);
    LAS int* sel = (LAS int*)(wl + 15360);
    constexpr int CAP = 1024, CAP2 = 448;
    const unsigned long long lt_mask = (1ull << lane) - 1ull;
    const int hn = lane & 15, g4 = lane >> 4;
    const int vwr = (int)(uintptr_t)wl + (g4 * VPITCH + hn * 16);
    const int vrd = (int)(uintptr_t)wl + ((4 * g4 + (hn >> 2)) * VPITCH + (hn & 3) * 8);
    { const f32x4 tv = *(const f32x4*)(a.in(I_REL) + 4 * lane); *(LAS f32x4*)(btab + 4 * lane) = tv; }
    LDS_WAIT(); asm volatile("" ::: "memory");
#define APPEND(flag, list, count, value) do { const unsigned long long b_ = __ballot(flag); if (flag) (list)[(count) + (int)__builtin_popcountll(b_ & lt_mask)] = (value); (count) += (int)__builtin_popcountll(b_); } while (0)
#define RANK_TAKE(lst, n, nd) do { _Pragma("unroll 1") for (int j0_ = 0; j0_ < (n); j0_ += 64) { const int j_ = j0_ + lane; const bool act_ = j_ < (n); \
        const unsigned long long kj_ = act_ ? (lst)[j_] : 0ull; int rank_ = 0; \
        _Pragma("unroll 4") for (int k_ = 0; k_ < (n); ++k_) rank_ += ((lst)[k_] > kj_) ? 1 : 0; \
        const bool take_ = act_ && rank_ < (nd); APPEND(take_, sel, base, (int)(0xFFFFFFFFu - (unsigned)kj_)); } } while (0)
    const bool paired = (G % 8 == 0); const int cpx = paired ? G / 8 : 1;
    const int nwl = paired ? 16 * cpx : NGW; const int wl0 = paired ? ((vcu / cpx) & 1) * 8 * cpx + (vcu % cpx) * 8 + wave : gw;
    const int qend = paired ? NTOK : MROWS;
    for (int qq = wl0; qq < qend; qq += nwl) {
        const int qi = paired ? (vcu / (2 * cpx)) * NTOK + qq : qq;
        const int b = qi / NTOK, t = qi % NTOK; const size_t row = (size_t)b * NTOK + t;
        const int L = chunk_end(t) < NTOK ? chunk_end(t) : NTOK;
        const bf16_t* Pb = P + (size_t)b * NTOK * ODP;
        int nsel;
        if (L <= 256) {
            nsel = L;
#pragma unroll
            for (int i = 0; i < 4; ++i) sel[64 * i + lane] = 64 * i + lane;
        } else {
            nsel = 256;
            const unsigned short* srow = SCO + row * NTOK;
            unsigned zz = 0u; asm volatile("" : "+v"(zz));
            int sh = 16; unsigned pfx = 0u; int need = 256; unsigned cbin = 0u;
#define CHUNK_LOAD(dst, c0_) do { int l8_ = 8 * lane; asm volatile("" : "+v"(l8_)); _Pragma("unroll") for (int k = 0; k < 8; ++k) { const int idx_ = (c0_) + 512 * k + l8_; dst[k] = __builtin_nontemporal_load((const u32x4*)(srow + (idx_ < L ? idx_ : 0))); } } while (0)
#define KEY16(w, c) (((c) & 1) ? ((w)[(c) >> 1] >> 16) : ((w)[(c) >> 1] & 0xffffu))
#pragma unroll 1
            for (;;) {
                const int nb = sh >= 11 ? 11 : sh; const int nsh = sh - nb; const unsigned dmask = (1u << nb) - 1u; const bool first = (sh == 16); const unsigned pv0 = first ? 0u : (pfx >> sh);
#pragma unroll 1
                for (int i = 0; i < 8; ++i) *(LAS u32x4*)(wl + i * 1024 + lane * 16) = (u32x4){zz, zz, zz, zz};
                u32x4 v[8];
                LDS_WAIT(); asm volatile("" ::: "memory");
#pragma unroll 1
                for (int c0 = 0; c0 < L; c0 += 4096) {
                    CHUNK_LOAD(v, c0);
                    int l8 = 8 * lane; asm volatile("" : "+v"(l8));
#pragma unroll
                    for (int k = 0; k < 8; ++k) { const bool ok = (c0 + 512 * k + l8) < L;
#pragma unroll
                        for (int c = 0; c < 8; ++c) { const unsigned u = KEY16(v[k], c); const bool match = ok && (first || ((u >> sh) == pv0));
                            if (match) __hip_atomic_fetch_add(hist + ((u >> nsh) & dmask), 1u, __ATOMIC_RELAXED, __HIP_MEMORY_SCOPE_WORKGROUP); } }
                }
                LDS_WAIT(); asm volatile("" ::: "memory");
                unsigned loc = 0u;
#pragma unroll
                for (int i = 0; i < 8; ++i) { const u32x4 h4 = *(const LAS u32x4*)(hist + 32 * lane + 4 * i); loc += (h4.x + h4.y) + (h4.z + h4.w); }
                unsigned above = loc;
#pragma unroll
                for (int o = 1; o < 64; o <<= 1) { const unsigned vv = __shfl_down(above, o); if (lane + o < 64) above += vv; }
                const unsigned excl = above - loc;
                const bool mine = (excl < (unsigned)need) && ((unsigned)need <= above);
                const unsigned long long bal = __ballot(mine);
                const int owner = (int)__builtin_ctzll(bal ? bal : 1ull);
                unsigned run = excl; int bsel = 0; unsigned abv = excl, cb = 0u; bool found = false;
#pragma unroll 1
                for (int i = 7; i >= 0; --i) { const u32x4 h4 = *(const LAS u32x4*)(hist + 32 * lane + 4 * i); const unsigned hv[4] = {h4.x, h4.y, h4.z, h4.w};
#pragma unroll
                    for (int k = 3; k >= 0; --k) { const unsigned nr = run + hv[k]; const bool hit = !found && (nr >= (unsigned)need); bsel = hit ? 4 * i + k : bsel; abv = hit ? run : abv; cb = hit ? hv[k] : cb; found = found || hit; run = nr; } }
                const unsigned bin = (unsigned)__shfl(32 * lane + bsel, owner); const unsigned abv_b = (unsigned)__shfl((int)abv, owner); cbin = (unsigned)__shfl((int)cb, owner);
                pfx |= bin << nsh; need -= (int)abv_b; sh = nsh;
                if (cbin <= (unsigned)CAP || sh == 0) break;
            }
            const bool alleq = (sh == 0) && (cbin > (unsigned)CAP);
            const unsigned pv = pfx >> sh;
            int base = 0, ccount = 0;
            if (!alleq) {
                { u32x4 v[8];
#pragma unroll 1
                for (int c0 = 0; c0 < L; c0 += 4096) {
                    CHUNK_LOAD(v, c0);
                    int l8 = 8 * lane; asm volatile("" : "+v"(l8));
#pragma unroll
                    for (int k = 0; k < 8; ++k) { const int idx = c0 + 512 * k + l8; const bool ok = idx < L;
#pragma unroll
                        for (int c = 0; c < 8; ++c) { const unsigned u = KEY16(v[k], c); const unsigned hi = u >> sh;
                            const bool sure = ok && hi > pv, isc = ok && hi == pv;
                            const unsigned long long bt = __ballot(sure), bc = __ballot(isc);
                            if (bt | bc) {
                                if (sure) sel[base + (int)__builtin_popcountll(bt & lt_mask)] = idx + c;
                                if (isc) cand[ccount + (int)__builtin_popcountll(bc & lt_mask)] = ((unsigned long long)u << 32) | (unsigned long long)(0xFFFFFFFFu - (unsigned)(idx + c));
                                base += (int)__builtin_popcountll(bt); ccount += (int)__builtin_popcountll(bc); } } }
                } }
                LDS_WAIT(); asm volatile("" ::: "memory");
                bool done = false;
                if (sh >= 8 && ccount > 64) {
                    *(LAS u32x4*)(hist2 + 4 * lane) = (u32x4){zz, zz, zz, zz};
                    LDS_WAIT(); asm volatile("" ::: "memory");
                    const int s2 = 32 + sh - 8;
#pragma unroll 1
                    for (int j0 = 0; j0 < ccount; j0 += 64) { const int j = j0 + lane; if (j < ccount) __hip_atomic_fetch_add(hist2 + (unsigned)((cand[j] >> s2) & 255ull), 1u, __ATOMIC_RELAXED, __HIP_MEMORY_SCOPE_WORKGROUP); }
                    LDS_WAIT(); asm volatile("" ::: "memory");
                    const u32x4 h4 = *(const LAS u32x4*)(hist2 + 4 * lane); const unsigned loc2 = (h4.x + h4.y) + (h4.z + h4.w);
                    unsigned ab2 = loc2;
#pragma unroll
                    for (int o = 1; o < 64; o <<= 1) { const unsigned vv = __shfl_down(ab2, o); if (lane + o < 64) ab2 += vv; }
                    const unsigned ex2 = ab2 - loc2; const bool mine2 = (ex2 < (unsigned)need) && ((unsigned)need <= ab2);
                    const unsigned long long bal2 = __ballot(mine2); const int own2 = (int)__builtin_ctzll(bal2 ? bal2 : 1ull);
                    unsigned run2 = ex2; int bs2 = 0; unsigned av2 = ex2, cb2 = 0u; bool f2 = false; const unsigned hv2[4] = {h4.x, h4.y, h4.z, h4.w};
#pragma unroll
                    for (int k = 3; k >= 0; --k) { const unsigned nr = run2 + hv2[k]; const bool hit = !f2 && (nr >= (unsigned)need); bs2 = hit ? k : bs2; av2 = hit ? run2 : av2; cb2 = hit ? hv2[k] : cb2; f2 = f2 || hit; run2 = nr; }
                    const unsigned bin2 = (unsigned)__shfl(4 * lane + bs2, own2); const unsigned abv2 = (unsigned)__shfl((int)av2, own2); const unsigned cnt2 = (unsigned)__shfl((int)cb2, own2);
                    if (cnt2 <= (unsigned)CAP2) {
                        int c2 = 0;
#pragma unroll 1
                        for (int j0 = 0; j0 < ccount; j0 += 64) { const int j = j0 + lane; const bool act = j < ccount; const unsigned long long kj = act ? cand[j] : 0ull;
                            const unsigned sub = (unsigned)((kj >> s2) & 255ull); const bool sure2 = act && sub > bin2, isc2 = act && sub == bin2;
                            APPEND(sure2, sel, base, (int)(0xFFFFFFFFu - (unsigned)kj));
                            APPEND(isc2, cand2, c2, kj); }
                        LDS_WAIT(); asm volatile("" ::: "memory");
                        const int need2 = need - (int)abv2;
                        RANK_TAKE(cand2, c2, need2);
                        done = true;
                    }
                }
                if (!done) RANK_TAKE(cand, ccount, need);
            } else {
#pragma unroll 2
                for (int i0 = 0; i0 < L; i0 += 64) { const int s = i0 + lane; const bool valid = s < L;
                    const unsigned u = valid ? (unsigned)srow[s < L ? s : L - 1] : 0u;
                    const bool sure = valid && u > pv, isc = valid && u == pv;
                    const unsigned long long bc = __ballot(isc); const int crank = ccount + (int)__builtin_popcountll(bc & lt_mask);
                    const bool take = sure || (isc && crank < need);
                    ccount += (int)__builtin_popcountll(bc);
                    APPEND(take, sel, base, s); }
            }
#undef CHUNK_LOAD
#undef KEY16
        }
        LDS_WAIT(); asm volatile("" ::: "memory");
#pragma unroll
        for (int i = 0; i < 4; ++i) { const int jj = 64 * i + lane; bkt[jj] = t5_bucket(((jj < nsel) ? sel[jj] : t) - t) * 8; }
        bf16x8 qb[4];
#pragma unroll
        for (int kk = 0; kk < 4; ++kk) { bf16x8 z = {0, 0, 0, 0, 0, 0, 0, 0}; qb[kk] = (hn < 8) ? *(const bf16x8*)(P + row * ODP + OC_Q + hn * 128 + kk * 32 + g4 * 8) : z; }
        f32x4 sa[16];
#pragma unroll
        for (int tb = 0; tb < 4; ++tb) {
            bf16x8 ka[4][4]; int hno = hn; asm volatile("" : "+v"(hno));
#pragma unroll
            for (int u = 0; u < 4; ++u) { const int jj = 16 * (4 * tb + u) + hno; const int key = (jj < nsel) ? sel[jj] : 0; const unsigned koff = (unsigned)(key * ODP + OC_K + g4 * 8) * 2u;
#pragma unroll
                for (int kk = 0; kk < 4; ++kk) ka[u][kk] = *(const bf16x8*)((const char*)Pb + koff + kk * 64); }
#pragma unroll
            for (int u = 0; u < 4; ++u) { f32x4 acc = {0.f, 0.f, 0.f, 0.f};
#pragma unroll
                for (int kk = 0; kk < 4; ++kk) acc = __builtin_amdgcn_mfma_f32_16x16x32_bf16(ka[u][kk], qb[kk], acc, 0, 0, 0);
                sa[4 * tb + u] = acc; }
            asm volatile("" ::: "memory");
        }
        bf16x8 vr0[8], vr1[8];
#define V_LOAD(dst, c) do { int g4o_ = g4; asm volatile("" : "+v"(g4o_)); _Pragma("unroll") for (int i_ = 0; i_ < 8; ++i_) { const int jj_ = 32 * (c) + g4o_ + 4 * i_; const int key_ = (jj_ < nsel) ? sel[jj_] : 0; \
            dst[i_] = *(const bf16x8*)((const char*)Pb + (unsigned)(key_ * ODP + OC_V + hn * 8) * 2u); } } while (0)
#define V_WRITE(src) do { _Pragma("unroll") for (int i_ = 0; i_ < 8; ++i_) *(LAS bf16x8*)(uintptr_t)(vwr + 4 * i_ * VPITCH) = src[i_]; } while (0)
        V_LOAD(vr0, 0); V_LOAD(vr1, 1);
        float mx = -1e30f; int g4b = 4 * g4; asm volatile("" : "+v"(g4b));
#pragma unroll
        for (int tl = 0; tl < 16; ++tl) { const i32x4 b4 = *(const LAS i32x4*)(bkt + 16 * tl + 4 * g4); const int bb[4] = {b4.x, b4.y, b4.z, b4.w};
#pragma unroll
            for (int i = 0; i < 4; ++i) { const int jj = 16 * tl + g4b + i; const bool ok = jj < nsel;
                const float bias = btab[bb[i] + (hn & 7)];
                const float s = ok ? sa[tl][i] * 0.088388347648318440f + bias : -1e30f; sa[tl][i] = s; mx = fmaxf(mx, s); } }
        mx = fmaxf(mx, __shfl_xor(mx, 16)); mx = fmaxf(mx, __shfl_xor(mx, 32));
        float sum = 0.f;
#pragma unroll
        for (int tl = 0; tl < 16; ++tl)
#pragma unroll
            for (int i = 0; i < 4; ++i) { const float p = __builtin_amdgcn_exp2f((sa[tl][i] - mx) * 1.4426950408889634f); sa[tl][i] = p; sum += p; }
        sum += __shfl_xor(sum, 16); sum += __shfl_xor(sum, 32);
        const float rs = 1.0f / sum;
        f32x4 oc[8];
#pragma unroll
        for (int d = 0; d < 8; ++d) oc[d] = (f32x4){0.f, 0.f, 0.f, 0.f};
#define PV_CHUNK(c, cur) do { \
            if ((c) + 1 < 8) asm volatile("s_waitcnt vmcnt(8)" ::: "memory"); else asm volatile("s_waitcnt vmcnt(0)" ::: "memory"); \
            V_WRITE(cur); if ((c) + 2 < 8) V_LOAD(cur, (c) + 2); \
            const f32x4 pa_ = sa[2 * (c)] * rs, pb_ = sa[2 * (c) + 1] * rs; \
            u32x4 pw; pw.x = cvtpk(pa_[0], pa_[1]); pw.y = cvtpk(pa_[2], pa_[3]); pw.z = cvtpk(pb_[0], pb_[1]); pw.w = cvtpk(pb_[2], pb_[3]); \
            const bf16x8 pf = __builtin_bit_cast(bf16x8, pw); \
            LDS_WAIT(); asm volatile("" ::: "memory"); \
            pv_chunk(oc, vrd, pf); } while (0)
        PV_CHUNK(0, vr0); PV_CHUNK(1, vr1); PV_CHUNK(2, vr0); PV_CHUNK(3, vr1); PV_CHUNK(4, vr0); PV_CHUNK(5, vr1); PV_CHUNK(6, vr0); PV_CHUNK(7, vr1);
#undef PV_CHUNK
#undef V_LOAD
#undef V_WRITE
        if (g4 < 2) {
#pragma unroll
            for (int dt = 0; dt < 8; ++dt)
#pragma unroll
                for (int i = 0; i < 4; ++i) OM[row * 1024 + (4 * g4 + i) * 128 + 16 * dt + hn] = om_fp8(oc[dt][i]);
        }
        LDS_WAIT(); asm volatile("" ::: "memory");
    }
#undef APPEND
#undef RANK_TAKE
}
}
typedef __attribute__((address_space(1))) unsigned char gu8_t;
#define PH_ARGS const KArgs& ka, unsigned lds_off
#define PH_SETUP PArgs a{ka, opaque_ws(ka.ws)}; LAS unsigned char* lds = (LAS unsigned char*)(uintptr_t)lds_off; unsigned char* ws = a.ws; (void)ws; (void)lds; \
    int G_ = gridDim.x, bx_ = blockIdx.x; asm volatile("" : "+s"(G_), "+s"(bx_)); const int G = G_, bx = bx_; const int vcu = (G % 8 == 0) ? (bx % 8) * (G / 8) + bx / 8 : bx; (void)vcu

__device__ __forceinline__ void ph_prologue(PH_ARGS) { PH_SETUP; phase_prologue(a, lds, vcu, G); }
__device__ __forceinline__ void ph_inproj(PH_ARGS, int layer) { PH_SETUP;
    const int jl = layer >> 1; const bool even = (layer & 1) == 0; const int N = even ? EVP : ODP;
    const bf16_t* Bt = even ? (const bf16_t*)(ws + WS_WINE + jl * SZ_WINE) : (const bf16_t*)(ws + WS_WINO + jl * SZ_WINO);
    pg8::DenseOrder S; S.init(MROWS, N, G, bx);
    pg8::EpiBf16 E{(bf16_t*)(ws + WS_P), N, 1.0f / FP8_WSCALE};
    pg8::gemm_phase<pg8::EpiBf16, pg8::DenseOrder, true>(lds, (const bf16_t*)(ws + WS_HB8), DM / 2, Bt, DM / 2, S, E);
}
__device__ __forceinline__ void ph_latent(PH_ARGS, int jl) { PH_SETUP; phase_latent_norm(a, jl, vcu, G); }
__device__ __forceinline__ void ph_upq(PH_ARGS, int jl) { PH_SETUP;
    pg8::DenseOrder S; S.init(MROWS, 768, G, bx);
    pg8::EpiQ E{(bf16_t*)(ws + WS_QM), (const float*)(ws + WS_ROPE)};
    pg8::gemm_phase<pg8::EpiQ, pg8::DenseOrder>(lds, (const bf16_t*)(ws + WS_QN), 512, (const bf16_t*)(ws + WS_WUQ + jl * SZ_WUQ), 512, S, E);
}
__device__ __forceinline__ void ph_upkv(PH_ARGS, int jl) { PH_SETUP;
    pg8::DenseOrder S; S.init(MROWS, 1024, G, bx);
    pg8::EpiKV E{(bf16_t*)(ws + WS_KN), (bf16_t*)(ws + WS_VM)};
    pg8::gemm_phase<pg8::EpiKV, pg8::DenseOrder>(lds, (const bf16_t*)(ws + WS_KVN), 256, (const bf16_t*)(ws + WS_WUKV + jl * SZ_WUKV), 256, S, E);
}
__device__ __forceinline__ void ph_attn(PH_ARGS, int layer) { PH_SETUP; att::phase_attention(a, lds, layer); }
__device__ __forceinline__ void ph_indexer(PH_ARGS) { PH_SETUP; idx::phase_indexer(a, lds, vcu, G); }
__device__ __forceinline__ void ph_select(PH_ARGS) { PH_SETUP; idx::phase_select_attend(a, lds, vcu, G); }
__device__ __forceinline__ void ph_outproj(PH_ARGS, int layer) { PH_SETUP;
    const int jl = layer >> 1; const bool even = (layer & 1) == 0;
    const bf16_t* Bt = even ? (const bf16_t*)(ws + WS_WOUTE + jl * SZ_WOUT) : (const bf16_t*)(ws + WS_WOUTO + jl * SZ_WOUT);
    pg8::DenseOrder S; S.init(MROWS, DM, G, bx);
    pg8::EpiOut E{(const bf16_t*)(ws + WS_HB), (bf16_t*)(ws + WS_Y), (float*)(ws + WS_STAT)};
    pg8::gemm_phase<pg8::EpiOut, pg8::DenseOrder, true>(lds, (const bf16_t*)(ws + WS_OM), 1024 / 2, Bt, 1024 / 2, S, E);
}
__device__ __forceinline__ void ph_lnroute(PH_ARGS, int layer, int cslot) { PH_SETUP; phase_ln_route(a, layer, cslot, lds, vcu, G); }
__device__ __forceinline__ void ph_expert_up(PH_ARGS, int layer) { PH_SETUP;
    const unsigned* cnt = (const unsigned*)(ws + WS_CTL) + CW_CNT + 2048 * layer; LAS int* tstart = (LAS int*)(lds + TBL_OFF);
    build_tile_table(cnt, tstart);
    pg8::MoeOrder S{tstart, cnt, (const int*)(ws + WS_ROWTOK), 4, G, vcu, true, false};
    pg8::EpiSwiglu E{(bf16_t*)(ws + WS_ACT), a.in(I_EBIN) + (size_t)layer * NEXP * 1024};
    pg8::gemm_phase<pg8::EpiSwiglu, pg8::MoeOrder, true>(lds, (const bf16_t*)(ws + WS_HB8), DM / 2, (const bf16_t*)(ws + WS_WEI + (size_t)layer * NEXP * SZ_WEI), DM / 2, S, E);
}
__device__ __forceinline__ void ph_expert_down(PH_ARGS, int layer) { PH_SETUP;
    const unsigned* cnt = (const unsigned*)(ws + WS_CTL) + CW_CNT + 2048 * layer; LAS int* tstart = (LAS int*)(lds + TBL_OFF);
    pg8::MoeOrder S{tstart, cnt, (const int*)(ws + WS_ROWTOK), 8, G, vcu, false, false};
    pg8::EpiDown E{(unsigned char*)(ws + WS_YEXP), a.in(I_EBOUT) + (size_t)layer * NEXP * DM};
    pg8::gemm_phase<pg8::EpiDown, pg8::MoeOrder, true>(lds, (const bf16_t*)(ws + WS_ACT), DFF / 2, (const bf16_t*)(ws + WS_WEO + (size_t)layer * NEXP * SZ_WEO), DFF / 2, S, E);
}
__device__ __forceinline__ void ph_combine(PH_ARGS, int layer, bool dummy) { PH_SETUP;
    if (layer == DEPTH - 1) phase_combine_ln<true>(a, layer, (const LAS int*)(lds + TBL_OFF), vcu, G, dummy); else phase_combine_ln<false>(a, layer, (const LAS int*)(lds + TBL_OFF), vcu, G, dummy); }

__global__ void __launch_bounds__(512, 2) mk_fwd(KArgs a) {
    extern __shared__ __attribute__((aligned(16))) unsigned char lds_raw[];
    LAS unsigned char* lds = (LAS unsigned char*)lds_raw;
    const int tid = threadIdx.x;
    for (int u = tid; u < (LDS_BYTES - LDS_CTL) / 4; u += 512) ((LAS unsigned*)(lds + LDS_CTL))[u] = 0u;
    __syncthreads();
    const unsigned lo = (unsigned)(uintptr_t)lds;
    gu32_t* barw = (gu32_t*)(a.ws + WS_CTL) + CW_BAR; const unsigned st_off = lo + MISC_OFF + 32;
    const unsigned xcc = xcd_barrier_post((unsigned*)barw, (volatile LAS unsigned*)(uintptr_t)st_off).x;
#define GRID_BAR() xcd_barrier(barw, xcc, st_off)

    ph_prologue(a, lo);
    GRID_BAR();
#pragma unroll 1
    for (int layer = 0; layer < DEPTH; ++layer) {
        const int jl = layer >> 1; const bool even = (layer & 1) == 0;
        ph_inproj(a, lo, layer);
        GRID_BAR();
        if (even) {
            ph_latent(a, lo, jl);
            GRID_BAR();
            ph_upq(a, lo, jl);
            ph_upkv(a, lo, jl);
            GRID_BAR();
            ph_attn(a, lo, layer);
            GRID_BAR();
        } else {
            ph_indexer(a, lo);
            GRID_BAR();
            ph_select(a, lo);
            GRID_BAR();
        }
        ph_outproj(a, lo, layer);
        GRID_BAR();
        ph_lnroute(a, lo, layer, layer);
        GRID_BAR();
        ph_expert_up(a, lo, layer);
        GRID_BAR();
        ph_expert_down(a, lo, layer);
        GRID_BAR();
        ph_combine(a, lo, layer, false);
        if (layer + 1 < DEPTH) GRID_BAR();
    }
}

extern "C" void kernel_launch(void* const* d_in, const int* in_sizes, int n_in, void* d_out, int out_size, void* d_ws, size_t ws_size, hipStream_t stream) {
    static int grid = 0;
    if (grid == 0) {
        if (n_in != 19 || ws_size < WS_END) { fprintf(stderr, "kernel_launch: n_in %d (want 19), ws %zu (need %zu)\n", n_in, ws_size, (size_t)WS_END); grid = -1; return; }
        int dev = 0, cus = 0, per_cu = 0;
        if (hipGetDevice(&dev) != hipSuccess || hipDeviceGetAttribute(&cus, hipDeviceAttributeMultiprocessorCount, dev) != hipSuccess) { grid = -1; return; }
        if (hipFuncSetAttribute((const void*)mk_fwd, hipFuncAttributeMaxDynamicSharedMemorySize, LDS_BYTES) != hipSuccess) { fprintf(stderr, "kernel_launch: hipFuncSetAttribute failed\n"); grid = -1; return; }
        if (hipOccupancyMaxActiveBlocksPerMultiprocessor(&per_cu, (const void*)mk_fwd, 512, LDS_BYTES) != hipSuccess || per_cu < 1)
            fprintf(stderr, "kernel_launch: occupancy query reports %d workgroups per CU\n", per_cu);
        (void)hipGetLastError();
        grid = cus > 0 ? cus : 256;
    }
    if (grid < 0) return;
    if (hipMemsetAsync((char*)d_ws + WS_CTL, 0, CTL_BYTES, stream) != hipSuccess) return;
    KArgs a{};
    for (int i = 0; i < 19; ++i) a.in[i] = (const float*)d_in[i];
    a.out = (float*)d_out; a.ws = (unsigned char*)d_ws;
    hipLaunchKernelGGL(mk_fwd, dim3(grid), dim3(512), LDS_BYTES, stream, a);
    (void)hipPeekAtLastError();
}
```

```cpp
#include <hip/hip_runtime.h>
#include <cstdio>
#include <cstdint>

#define LAS __attribute__((address_space(3)))
typedef unsigned short bf16_t;
typedef short bf16x8 __attribute__((ext_vector_type(8)));
typedef short s16x4 __attribute__((ext_vector_type(4)));
typedef float f32x2 __attribute__((ext_vector_type(2)));
typedef float f32x4 __attribute__((ext_vector_type(4)));
typedef float f32x16 __attribute__((ext_vector_type(16)));
typedef unsigned u32x2 __attribute__((ext_vector_type(2)));
typedef unsigned u32x4 __attribute__((ext_vector_type(4)));
typedef int i32x4 __attribute__((ext_vector_type(4)));

constexpr int BATCH = 4, NTOK = 8320, MROWS = BATCH * NTOK, DM = 2048, SEQ = 8192, NMETA = 16, DEPTH = 4;
constexpr int NEXP = 32, DFF = 512;
constexpr float DN_ALPHA = 1.6817928305074290f;
constexpr float LN_EPS = 1e-5f, RMS_EPS = 1e-6f;
constexpr int EVP = 2560;
constexpr int ODP = 2048;
constexpr int MAXSLOT = MROWS * 4 + NEXP * 256;
constexpr int EC_QLAT = 0, EC_KVLAT = 512, EC_SBQ = 768, EC_SBK = 1280, EC_SBV = 1792, EC_KROPE = 2304;
constexpr int OC_Q = 0, OC_K = 1024, OC_V = 1152, OC_IQ = 1280, OC_IK = 1792, OC_IW = 1856;

constexpr size_t MiB = 1u << 20;
constexpr size_t alignup(size_t x) { return (x + 4095) & ~(size_t)4095; }
constexpr size_t WS_CTL = 0, CTL_BYTES = 1 * MiB;
constexpr size_t SZ_WINE = (size_t)EVP * DM * 2, SZ_WUQ = 768 * 512 * 2, SZ_WUKV = 1024 * 256 * 2, SZ_WOUT = (size_t)DM * 1024 * 2, SZ_WINO = (size_t)ODP * DM * 2;
constexpr size_t SZ_WEI = (size_t)1024 * DM, SZ_WEO = (size_t)DM * DFF  , SZ_WR = (size_t)32 * DM * 2;
constexpr size_t WS_WINE = WS_CTL + CTL_BYTES;
constexpr size_t WS_WUQ = WS_WINE + 2 * SZ_WINE;
constexpr size_t WS_WUKV = WS_WUQ + 2 * SZ_WUQ;
constexpr size_t WS_WOUTE = WS_WUKV + 2 * SZ_WUKV;
constexpr size_t WS_WINO = WS_WOUTE + 2 * SZ_WOUT;
constexpr size_t WS_WOUTO = WS_WINO + 2 * SZ_WINO;
constexpr size_t WS_WEI = WS_WOUTO + 2 * SZ_WOUT;
constexpr size_t WS_WEO = WS_WEI + (size_t)DEPTH * NEXP * SZ_WEI;
constexpr size_t WS_WRH = WS_WEO + (size_t)DEPTH * NEXP * SZ_WEO;
constexpr size_t WS_WRL = WS_WRH + DEPTH * SZ_WR;
constexpr size_t WS_ROPE = WS_WRL + DEPTH * SZ_WR;
constexpr size_t WS_H = alignup(WS_ROPE + (size_t)NTOK * 64 * 4);
constexpr size_t WS_HB8 = WS_H;
constexpr size_t WS_HB = WS_H + (size_t)MROWS * DM * 4;
constexpr size_t WS_Y = WS_HB + (size_t)MROWS * DM * 2;
constexpr size_t WS_STAT = WS_Y + (size_t)MROWS * DM * 4;
constexpr size_t WS_P = WS_STAT + (size_t)MROWS * 64 * 4;
constexpr size_t WS_QN = WS_P + (size_t)MROWS * EVP * 2;
constexpr size_t WS_KVN = WS_QN + (size_t)MROWS * 512 * 2;
constexpr size_t WS_QM = WS_KVN + (size_t)MROWS * 256 * 2;
constexpr size_t WS_KN = WS_QM + (size_t)MROWS * 768 * 2;
constexpr size_t WS_VM = WS_KN + (size_t)MROWS * 512 * 2;
constexpr size_t WS_KR = WS_VM + (size_t)MROWS * 512 * 2;
constexpr size_t WS_OM = WS_KR + (size_t)MROWS * 64 * 2;
constexpr size_t WS_TOPE = WS_OM + (size_t)MROWS * 1024 * 2;
constexpr size_t WS_TOPP = WS_TOPE + (size_t)MROWS * 16;
constexpr size_t WS_TOPG = WS_TOPP + (size_t)MROWS * 16;
constexpr size_t WS_ROWTOK = WS_TOPG + (size_t)MROWS * 16;
constexpr size_t WS_BIG = alignup(WS_ROWTOK + (size_t)NEXP * MROWS * 4);
constexpr size_t SZ_SCORES = (size_t)BATCH * NTOK * NTOK * 4;
constexpr size_t WS_ACT = WS_BIG, WS_YEXP = WS_BIG + alignup((size_t)MAXSLOT * DFF * 2);
constexpr size_t WS_END = WS_BIG + SZ_SCORES;
static_assert(WS_YEXP + (size_t)MAXSLOT * DM * 2 <= WS_END, "alias region");
constexpr size_t WS_ARGTAB = 512 * 1024;
constexpr int CW_BAR = 4096, CW_CNT = 16384  , CW_Q = 32768  , CW_ERR = 65536;

constexpr int LDS_BYTES = 147456, LDS_CTL = 131072, MISC_OFF = LDS_CTL + 320, TBL_OFF = LDS_CTL + 1024;

#define LDS_WAIT() asm volatile("s_waitcnt lgkmcnt(0)" ::: "memory")
#define VM_WAIT() asm volatile("s_waitcnt vmcnt(0)" ::: "memory")
#define SBAR() __builtin_amdgcn_sched_barrier(0)

__device__ __forceinline__ unsigned cvtpk(float lo, float hi) { unsigned r; asm volatile("v_cvt_pk_bf16_f32 %0, %1, %2" : "=v"(r) : "v"(lo), "v"(hi)); return r; }
typedef int i32x8 __attribute__((ext_vector_type(8)));
__device__ __forceinline__ unsigned cvt4_fp8(float a, float b, float c, float d) { int w = __builtin_amdgcn_cvt_pk_fp8_f32(a, b, 0, false); w = __builtin_amdgcn_cvt_pk_fp8_f32(c, d, w, true); return (unsigned)w; }
constexpr float OM_SCALE = 64.0f;
__device__ __forceinline__ unsigned char om_fp8(float v) { v = fminf(fmaxf(v * OM_SCALE, -448.0f), 448.0f); return (unsigned char)(__builtin_amdgcn_cvt_pk_fp8_f32(v, v, 0, false) & 0xff); }
constexpr float FP8_WSCALE = 32.0f;
__device__ __forceinline__ float bf2f(unsigned short b) { return __uint_as_float(((unsigned)b) << 16); }
__device__ __forceinline__ float bflo(unsigned w) { return __uint_as_float(w << 16); }
__device__ __forceinline__ float bfhi(unsigned w) { return __uint_as_float(w & 0xffff0000u); }
__device__ __forceinline__ float wave_sum(float v) {
#pragma unroll
    for (int o = 1; o < 64; o <<= 1) v += __shfl_xor(v, o);
    return v;
}
typedef __attribute__((address_space(1))) unsigned char gu8_t;
__device__ __forceinline__ int opaque_tid() { int t = (int)threadIdx.x; asm volatile("" : "+v"(t)); return t; }
__device__ __forceinline__ unsigned char* opaque_ws(unsigned char* p) { size_t z = 0; asm volatile("" : "+s"(z)); return p + z; }
__device__ __forceinline__ int chunk_end(int t) { return t < NMETA ? NMETA : NMETA + 64 * ((t - NMETA) / 64 + 1); }

#define XB_TMO      128
#define XB_XCNT(j)  (256  + 64 * (j))
#define XB_XSUB(j)  (1280 + 64 * (j))
#define XB_XGEN(j)  (2304 + 64 * (j))
#define XB_TOP      3328
#define XB_TOPGEN   3392
#define XCD_BAR_WORDS 3456
#define XB_SPIN_CAP (1u << 18)
__device__ __forceinline__ unsigned xb_ld(unsigned* p)              { return __hip_atomic_load(p, __ATOMIC_RELAXED, __HIP_MEMORY_SCOPE_AGENT); }
__device__ __forceinline__ unsigned xb_add(unsigned* p, unsigned v) { return __hip_atomic_fetch_add(p, v, __ATOMIC_RELAXED, __HIP_MEMORY_SCOPE_AGENT); }
__device__ __forceinline__ unsigned xb_xcc_id() { return (unsigned)__builtin_amdgcn_s_getreg((3 << 11) | 20) & 0xFu; }
#define XB_SPIN(cond, bar) do { unsigned _sp = 0; while (cond) { __builtin_amdgcn_s_sleep(1); \
    if ((++_sp & 255u) == 0u) { if (xb_ld(&(bar)[XB_TMO])) break; if (_sp > XB_SPIN_CAP) { atomicAdd(&(bar)[XB_TMO], 1u); break; } } } } while (0)
struct XcdBarrier { unsigned* bar; unsigned x; volatile LAS unsigned* st; };
__device__ __forceinline__ XcdBarrier xcd_barrier_post(unsigned* bar, volatile LAS unsigned* st) {
    XcdBarrier b; b.bar = bar; b.x = xb_xcc_id(); b.st = st;
    if (threadIdx.x == 0) (void)xb_add(&bar[XB_XCNT(b.x)], 1u);
    return b;
}
__device__ __forceinline__ void xcd_barrier_complete(unsigned* bar, unsigned x, unsigned& nloc, unsigned& nx) {
    const unsigned G = gridDim.x * gridDim.y * gridDim.z;
    unsigned sum, cnt, mine, sp = 0u;
    for (;;) {
        sum = 0u; cnt = 0u; mine = 0u;
#pragma unroll
        for (unsigned j = 0; j < 16; ++j) { const unsigned c = xb_ld(&bar[XB_XCNT(j)]); sum += c; cnt += (c > 0u) ? 1u : 0u; mine = (j == x) ? c : mine; }
        if (sum == G) break;
        __builtin_amdgcn_s_sleep(1);
        if ((++sp & 255u) == 0u) { if (xb_ld(&bar[XB_TMO])) break; if (sp > XB_SPIN_CAP) { atomicAdd(&bar[XB_TMO], 1u); break; } }
    }
    nloc = mine > 0u ? mine : 1u; nx = cnt > 0u ? cnt : 1u;
}
typedef __attribute__((address_space(1))) unsigned gu32_t;
__device__ __forceinline__ void xcd_barrier_body(const XcdBarrier& b) {
    asm volatile("s_waitcnt vmcnt(0)" ::: "memory");
    __syncthreads();
    if (opaque_tid() == 0) {
        size_t z_ = 0; asm volatile("" : "+s"(z_));
        unsigned* bar = b.bar + z_; unsigned bxx = b.x; asm volatile("" : "+s"(bxx));
        __builtin_amdgcn_s_waitcnt(0);
        unsigned nloc = b.st[0], nx = b.st[1];
        if (nloc == 0u) { xcd_barrier_complete(bar, bxx, nloc, nx); b.st[0] = nloc; b.st[1] = nx; }
        const unsigned old = xb_add(&bar[XB_XSUB(bxx)], 1u);
        const unsigned gen = old / nloc;
        if (old + 1u == (gen + 1u) * nloc) {
            __builtin_amdgcn_fence(__ATOMIC_RELEASE, "agent");
            asm volatile("s_waitcnt vmcnt(0)" ::: "memory");
            const unsigned og = xb_add(&bar[XB_TOP], 1u);
            const unsigned tg = og / nx;
            if (og + 1u == (tg + 1u) * nx) xb_add(&bar[XB_TOPGEN], 1u);
            else XB_SPIN(xb_ld(&bar[XB_TOPGEN]) == tg, bar);
            __builtin_amdgcn_fence(__ATOMIC_ACQUIRE, "agent");
            xb_add(&bar[XB_XGEN(bxx)], 1u);
            asm volatile("s_waitcnt vmcnt(0)" ::: "memory");
        } else {
            XB_SPIN(xb_ld(&bar[XB_XGEN(bxx)]) == gen, bar);
            __builtin_amdgcn_fence(__ATOMIC_ACQUIRE, "agent");
            asm volatile("s_waitcnt vmcnt(0)" ::: "memory");
        }
    }
    __syncthreads();
}

__device__ __forceinline__ void xcd_barrier(gu32_t* barg, unsigned x, unsigned st_off) {
    XcdBarrier b; b.bar = (unsigned*)barg; b.x = x; b.st = (volatile LAS unsigned*)(uintptr_t)st_off;
    xcd_barrier_body(b);
}

namespace pg8 {
constexpr int BM = 256, BK = 64, HALF = 128, HTB = HALF * BK * 2, STAGE_BYTES = 8 * HTB, NXCD = 8, WGM = 8;
__device__ __forceinline__ int lds_byte(int r, int c) { const int st = (r >> 4) * 2 + (c >> 5), rr = r & 15, cc = c & 31, ob = rr * 64 + cc * 2; return st * 1024 + (ob ^ (((ob >> 9) & 1) << 5)); }
__device__ __forceinline__ void stage_rc(int b, int& R, int& C) { const int st = b / 1024, sb = b % 1024, swz = sb ^ (((sb >> 9) & 1) << 5); R = (st >> 1) * 16 + swz / 64; C = (st & 1) * 32 + (swz % 64) / 2; }
__device__ __forceinline__ int perm16(int R) { return (R >> 5) * 64 + ((R >> 2) & 3) * 16 + ((R >> 4) & 1) * 4 + (R & 3); }
__device__ __forceinline__ int perm32(int rho) { const int n = rho >> 4, i = rho & 15; return 8 * (i >> 2) + 4 * n + (i & 3); }
struct Unit { int pm, pn, pb, e, j, half; };

struct DenseOrder {
    int nM, nN, nwg, G, c;
    __device__ __forceinline__ void init(int M, int N, int G_, int c_) { nM = M / BM; nN = N / BM; nwg = nM * nN; G = G_; c = c_; }
    __device__ __forceinline__ bool next(int i, Unit& u) const {
        const long L = (long)i * G + c; if (L >= nwg) return false;
        int wgid = (int)L; { const int q = nwg / NXCD, r = nwg % NXCD, xcd = wgid % NXCD, off = wgid / NXCD; wgid = (xcd < r ? xcd * (q + 1) : r * (q + 1) + (xcd - r) * q) + off; }
        const int nig = WGM * nN, gid = wgid / nig, fm = gid * WGM, gsz = (nM - fm) < WGM ? (nM - fm) : WGM;
        u.pm = fm + ((wgid % nig) % gsz); u.pn = (wgid % nig) / gsz; u.pb = u.pn; u.e = 0; u.j = 0; u.half = 0; return true;
    }
    __device__ __forceinline__ int arow(const Unit& u, int r) const { return u.pm * BM + r; }
    __device__ __forceinline__ void arow4(const Unit& u, const int (&r)[4], int (&o)[4]) const { for (int q = 0; q < 4; ++q) o[q] = u.pm * BM + r[q]; }
    __device__ __forceinline__ void arow4_issue(const Unit&, const int (&)[4], int (&)[4]) const {}
    __device__ __forceinline__ int arow4_fin(const Unit& u, int r, int) const { return u.pm * BM + r; }
};

template <class Epi, class Sched, bool FP8 = false>
__device__ __forceinline__ void gemm_phase(LAS unsigned char* lds, const bf16_t* Ag, int lda, const bf16_t* Btg, int K, const Sched& S, const Epi& E) {
    const int tid = opaque_tid(), wid = __builtin_amdgcn_readfirstlane(tid >> 6), lane = tid & 63, wr = wid >> 2, wc = wid & 3, fr = lane & 15, fq = lane >> 4;
    const int nt = K / BK;
    unsigned voffB[2];
#pragma unroll
    for (int i = 0; i < 2; ++i) { int R, C; stage_rc(tid * 16 + i * 8192, R, C); const int Rb = (int)Epi::PERM == 2 ? perm16(R) : Epi::PERM ? ((R & ~31) + perm32(R & 31)) : R; voffB[i] = (unsigned)(Rb * K + C) * 2u; }
    const size_t kstep = (size_t)(BK * 2);
    const size_t tstep = (size_t)2 * HALF * K * 2;
    const size_t hstep = (size_t)((int)Epi::PERM == 2 ? 8 : HALF) * K * 2;
    const unsigned ldsw = (unsigned)wid * 1024u;
    const int aoff = lds_byte(wr * 64 + fr, fq * 8), boff = lds_byte(wc * 32 + fr, fq * 8);
#define PG8_SA(b, h) (((b) * 2 + (h)) * HTB)
#define PG8_SB(b, h) ((4 + (b) * 2 + (h)) * HTB)
#define PG8_STAGE(bufoff, gbase, voff) do { _Pragma("unroll") for (int _i = 0; _i < 2; ++_i) \
        __builtin_amdgcn_global_load_lds((const unsigned*)((const char*)(gbase) + (voff)[_i]), (LAS unsigned*)(lds + (bufoff) + ldsw + _i * 8192), 16, 0, 0); } while (0)
#define PG8_LDA(dst, b, h) do { _Pragma("unroll") for (int m = 0; m < 4; ++m) _Pragma("unroll") for (int k = 0; k < 2; ++k) dst[m][k] = *(const LAS bf16x8*)(lds + PG8_SA(b, h) + aoff + m * 2048 + k * 1024); } while (0)
#define PG8_LDB(dst, b, h) do { _Pragma("unroll") for (int n = 0; n < 2; ++n) _Pragma("unroll") for (int k = 0; k < 2; ++k) dst[n][k] = *(const LAS bf16x8*)(lds + PG8_SB(b, h) + boff + n * 2048 + k * 1024); } while (0)
#define PG8_MMA(ai, bj, At, Bt) do { __builtin_amdgcn_s_setprio(1); _Pragma("unroll") for (int m = 0; m < 4; ++m) _Pragma("unroll") for (int n = 0; n < 2; ++n) { \
        if constexpr (FP8) { const i32x4 a0_ = __builtin_bit_cast(i32x4, At[m][0]), a1_ = __builtin_bit_cast(i32x4, At[m][1]), b0_ = __builtin_bit_cast(i32x4, Bt[n][0]), b1_ = __builtin_bit_cast(i32x4, Bt[n][1]); \
            const i32x8 a8_ = __builtin_shufflevector(a0_, a1_, 0, 1, 2, 3, 4, 5, 6, 7), b8_ = __builtin_shufflevector(b0_, b1_, 0, 1, 2, 3, 4, 5, 6, 7); \
            acc[ai][bj][m][n] = __builtin_amdgcn_mfma_scale_f32_16x16x128_f8f6f4(b8_, a8_, acc[ai][bj][m][n], 0, 0, 0, sc1_, 0, sc1_); } \
        else { _Pragma("unroll") for (int k = 0; k < 2; ++k) acc[ai][bj][m][n] = __builtin_amdgcn_mfma_f32_16x16x32_bf16(Bt[n][k], At[m][k], acc[ai][bj][m][n], 0, 0, 0); } } \
        __builtin_amdgcn_s_setprio(0); } while (0)
#define PG8_WAIT_V(n) asm volatile("s_waitcnt vmcnt(" #n ")" ::: "memory")
#define PG8_WAIT_L(n) asm volatile("s_waitcnt lgkmcnt(" #n ")" ::: "memory")
#define PG8_BAR __builtin_amdgcn_s_barrier()
#define PG8_SCHED __builtin_amdgcn_sched_barrier(0)
#define PG8_AOFF(dst, u) do { int _t = tid; asm volatile("" : "+v"(_t)); int _rw[4], _cc[4]; _Pragma("unroll") for (int _h = 0; _h < 2; ++_h) _Pragma("unroll") for (int _i = 0; _i < 2; ++_i) { int _R, _C; stage_rc(_t * 16 + _i * 8192, _R, _C); \
        _rw[_h * 2 + _i] = _h * HALF + _R; _cc[_h * 2 + _i] = _C; } \
        int _ar[4]; S.arow4(u, _rw, _ar);                                        \
        _Pragma("unroll") for (int _q = 0; _q < 4; ++_q) dst[_q >> 1][_q & 1] = (unsigned)(_ar[_q] * lda + _cc[_q]) * 2u; } while (0)
#define PG8_AOFF_ISSUE(raw, u) do { int _t = tid; asm volatile("" : "+v"(_t)); int _rw[4]; _Pragma("unroll") for (int _h = 0; _h < 2; ++_h) _Pragma("unroll") for (int _i = 0; _i < 2; ++_i) { int _R, _C; stage_rc(_t * 16 + _i * 8192, _R, _C); _rw[_h * 2 + _i] = _h * HALF + _R; } \
        S.arow4_issue(u, _rw, raw); } while (0)
#define PG8_AOFF_FIN(dst, raw, u) do { int _t = tid; asm volatile("" : "+v"(_t)); _Pragma("unroll") for (int _h = 0; _h < 2; ++_h) _Pragma("unroll") for (int _i = 0; _i < 2; ++_i) { int _R, _C; stage_rc(_t * 16 + _i * 8192, _R, _C); \
        dst[_h][_i] = (unsigned)(S.arow4_fin(u, _h * HALF + _R, raw[_h * 2 + _i]) * lda + _C) * 2u; } } while (0)
    Unit cur, nxt; int ui = 0; cur.e = 0;
    if (!S.next(0, cur)) return;
    f32x4 acc[2][2][4][2];
    int sc1_ = 0x7f7f7f7f; float z0_ = 0.f; asm volatile("" : "+v"(sc1_), "+v"(z0_));
    (void)sc1_;
#pragma unroll
    for (int a = 0; a < 2; ++a)
#pragma unroll
        for (int b = 0; b < 2; ++b)
#pragma unroll
            for (int m = 0; m < 4; ++m)
#pragma unroll
                for (int n = 0; n < 2; ++n) acc[a][b][m][n] = (f32x4){z0_, z0_, z0_, z0_};
    bf16x8 At[4][2], B0[2][2], B1[2][2];
    unsigned vA[2][2];
    PG8_AOFF(vA, cur);
    const char* cA = (const char*)Ag;
    const char* cB = (const char*)Btg + (size_t)cur.pb * tstep;
    PG8_STAGE(PG8_SB(0, 0), cB, voffB); PG8_STAGE(PG8_SB(0, 1), cB + hstep, voffB); PG8_STAGE(PG8_SA(0, 0), cA, vA[0]); PG8_STAGE(PG8_SA(0, 1), cA, vA[1]);
    if (wr == 1) PG8_BAR;
    PG8_WAIT_V(2); PG8_BAR;
    PG8_STAGE(PG8_SB(1, 0), cB + kstep, voffB); PG8_STAGE(PG8_SA(1, 0), cA + kstep, vA[0]); PG8_STAGE(PG8_SB(1, 1), cB + hstep + kstep, voffB);
    PG8_WAIT_V(6); PG8_BAR;
    for (;;) {
        nxt.e = cur.e;
        const bool has_next = S.next(ui + 1, nxt);
        const char* nB = has_next ? (const char*)Btg + (size_t)nxt.pb * tstep : cB;
        int rawn[4] = {0, 0, 0, 0}; if (has_next) PG8_AOFF_ISSUE(rawn, nxt);
#pragma unroll 1
        for (int t = 0; t < nt; t += 2) {
            const bool last = (t == nt - 2);
            const char* a1 = cA + (size_t)(t + 1) * kstep;
            const char* a2 = last ? cA : cA + (size_t)(t + 2) * kstep; const char* b2 = last ? nB : cB + (size_t)(t + 2) * kstep;
            const char* a3 = a2 + kstep; const char* b3 = b2 + kstep;
            PG8_LDB(B0, 0, 0); PG8_LDB(B1, 0, 1); PG8_SCHED; PG8_LDA(At, 0, 0); PG8_STAGE(PG8_SA(1, 1), a1, vA[1]);
            if (last && has_next) { PG8_AOFF_FIN(vA, rawn, nxt); }
            PG8_WAIT_V(8); PG8_WAIT_L(0); PG8_BAR; PG8_MMA(0, 0, At, B0); PG8_MMA(0, 1, At, B1); PG8_BAR; PG8_SCHED;
            PG8_LDA(At, 0, 1); PG8_STAGE(PG8_SB(0, 0), b2, voffB); PG8_STAGE(PG8_SB(0, 1), b2 + hstep, voffB); PG8_STAGE(PG8_SA(0, 0), a2, vA[0]);
            PG8_WAIT_V(8); PG8_WAIT_L(0); PG8_BAR; PG8_MMA(1, 0, At, B0); PG8_MMA(1, 1, At, B1); PG8_BAR; PG8_SCHED;
            PG8_LDB(B0, 1, 0); PG8_LDB(B1, 1, 1); PG8_SCHED; PG8_LDA(At, 1, 0); PG8_STAGE(PG8_SA(0, 1), a2, vA[1]);
            PG8_WAIT_V(8); PG8_WAIT_L(0); PG8_BAR; PG8_MMA(0, 0, At, B0); PG8_MMA(0, 1, At, B1); PG8_BAR; PG8_SCHED;
            PG8_LDA(At, 1, 1); PG8_STAGE(PG8_SB(1, 0), b3, voffB); PG8_STAGE(PG8_SB(1, 1), b3 + hstep, voffB); PG8_STAGE(PG8_SA(1, 0), a3, vA[0]);
            PG8_WAIT_V(8); PG8_WAIT_L(0); PG8_BAR; PG8_MMA(1, 0, At, B0); PG8_MMA(1, 1, At, B1); PG8_BAR; PG8_SCHED;
        }
        if (wr == 0) PG8_BAR;
        { const int l_ = opaque_tid() & 63; E(acc, cur, wr, wc, l_ & 15, l_ >> 4); }
        if (!has_next) break;
#pragma unroll
        for (int a = 0; a < 2; ++a)
#pragma unroll
            for (int b = 0; b < 2; ++b)
#pragma unroll
                for (int m = 0; m < 4; ++m)
#pragma unroll
                    for (int n = 0; n < 2; ++n) acc[a][b][m][n] = (f32x4){z0_, z0_, z0_, z0_};
        cur = nxt; cB = nB; ++ui;
        if (wr == 1) PG8_BAR;
    }
    PG8_WAIT_V(0);
    PG8_BAR;
#undef PG8_SA
#undef PG8_SB
#undef PG8_STAGE
#undef PG8_LDA
#undef PG8_LDB
#undef PG8_MMA
#undef PG8_WAIT_V
#undef PG8_WAIT_L
#undef PG8_BAR
#undef PG8_SCHED
#undef PG8_AOFF
#undef PG8_AOFF_ISSUE
#undef PG8_AOFF_FIN
}
}
namespace pg8 {
#define ST16(base, boff, v) (*(u32x4*)((char*)(base) + (boff)) = (v))
#define PACK8(v0, v1) ({ u32x4 w_; w_.x = cvtpk((v0)[0], (v0)[1]); w_.y = cvtpk((v0)[2], (v0)[3]); w_.z = cvtpk((v1)[0], (v1)[1]); w_.w = cvtpk((v1)[2], (v1)[3]); w_; })
struct EpiBf16 {
    static constexpr bool PERM = true;
    bf16_t* O; int ldc; float sc;
    __device__ __forceinline__ void operator()(const f32x4 (&acc)[2][2][4][2], const Unit& u, int wr, int wc, int fr, int fq) const {
        const unsigned o0 = (unsigned)((u.pm * BM + wr * 64 + fr) * ldc + u.pn * BM + wc * 32 + 8 * fq) * 2u;
#pragma unroll
        for (int ai = 0; ai < 2; ++ai)
#pragma unroll
            for (int m = 0; m < 4; ++m) { const unsigned ro = o0 + (unsigned)((ai * HALF + m * 16) * ldc) * 2u;
#pragma unroll
                for (int bj = 0; bj < 2; ++bj) ST16(O, ro + bj * HALF * 2, PACK8(acc[ai][bj][m][0] * sc, acc[ai][bj][m][1] * sc)); }
    }
};
struct EpiQ {
    static constexpr bool PERM = true;
    bf16_t* QM; const float* rope;
    __device__ __forceinline__ void operator()(const f32x4 (&acc)[2][2][4][2], const Unit& u, int wr, int wc, int fr, int fq) const {
        const int row0 = u.pm * BM + wr * 64 + fr;
        if (u.pn < 2) {
            const unsigned o0 = (unsigned)(row0 * 768 + 2 * u.pn * 192 + wc * 32 + 8 * fq) * 2u;
#pragma unroll
            for (int ai = 0; ai < 2; ++ai)
#pragma unroll
                for (int m = 0; m < 4; ++m) { const unsigned ro = o0 + (unsigned)((ai * HALF + m * 16) * 768) * 2u;
#pragma unroll
                    for (int bj = 0; bj < 2; ++bj) ST16(QM, ro + bj * 192 * 2, PACK8(acc[ai][bj][m][0], acc[ai][bj][m][1])); }
        } else {
            const int g8 = 4 * (wc & 1) + fq;
            const unsigned o0 = (unsigned)(row0 * 768 + (wc >> 1) * 192 + 128 + 4 * g8) * 2u;
#pragma unroll
            for (int ai = 0; ai < 2; ++ai) {
                f32x4 csa[4], csb[4];
#pragma unroll
                for (int m = 0; m < 4; ++m) { const int t_ = (row0 + ai * HALF + m * 16) % NTOK; const unsigned co_ = (unsigned)(t_ * 32 + 4 * g8) * 8u;
                    csa[m] = *(const f32x4*)((const char*)rope + co_); csb[m] = *(const f32x4*)((const char*)rope + co_ + 16); }
                asm volatile("" ::: "memory");
#pragma unroll
                for (int m = 0; m < 4; ++m) {
                    const f32x4 cs0 = csa[m], cs1 = csb[m];
                    const float c[4] = {cs0[0], cs0[2], cs1[0], cs1[2]}, s[4] = {cs0[1], cs0[3], cs1[1], cs1[3]};
                    const unsigned ro = o0 + (unsigned)((ai * HALF + m * 16) * 768) * 2u;
#pragma unroll
                    for (int bj = 0; bj < 2; ++bj) { const f32x4 x1 = acc[ai][bj][m][0], x2 = acc[ai][bj][m][1];
                        float o1[4], o2[4];
#pragma unroll
                        for (int i = 0; i < 4; ++i) { o1[i] = x1[i] * c[i] - x2[i] * s[i]; o2[i] = x1[i] * s[i] + x2[i] * c[i]; }
                        u32x2 w1, w2; w1.x = cvtpk(o1[0], o1[1]); w1.y = cvtpk(o1[2], o1[3]); w2.x = cvtpk(o2[0], o2[1]); w2.y = cvtpk(o2[2], o2[3]);
                        *(u32x2*)((char*)QM + ro + bj * 2 * 192 * 2) = w1; *(u32x2*)((char*)QM + ro + bj * 2 * 192 * 2 + 64) = w2; }
                    asm volatile("" ::: "memory"); }
            }
        }
    }
};
struct EpiKV {
    static constexpr bool PERM = true;
    bf16_t* KN; bf16_t* VM;
    __device__ __forceinline__ void operator()(const f32x4 (&acc)[2][2][4][2], const Unit& u, int wr, int wc, int fr, int fq) const {
        const unsigned o0 = (unsigned)((u.pm * BM + wr * 64 + fr) * 512 + u.pn * 128 + wc * 32 + 8 * fq) * 2u;
#pragma unroll
        for (int ai = 0; ai < 2; ++ai)
#pragma unroll
            for (int m = 0; m < 4; ++m) { const unsigned ro = o0 + (unsigned)((ai * HALF + m * 16) * 512) * 2u;
                ST16(KN, ro, PACK8(acc[ai][0][m][0], acc[ai][0][m][1])); ST16(VM, ro, PACK8(acc[ai][1][m][0], acc[ai][1][m][1])); }
    }
};
struct EpiOut {
    static constexpr bool PERM = false;
    const bf16_t* HB; bf16_t* Y; float* STAT;
    __device__ __forceinline__ void operator()(const f32x4 (&acc)[2][2][4][2], const Unit& u, int wr, int wc, int fr, int fq) const {
        const int row0 = u.pm * BM + wr * 64 + fr, col0 = u.pn * BM + wc * 32 + 4 * fq;
#pragma unroll
        for (int ai = 0; ai < 2; ++ai) {
            u32x2 hres[4][2][2];
#pragma unroll
            for (int m = 0; m < 4; ++m) { const unsigned off = (unsigned)((row0 + ai * HALF + m * 16) * DM + col0) * 4u;
#pragma unroll
                for (int bj = 0; bj < 2; ++bj)
#pragma unroll
                    for (int n = 0; n < 2; ++n) hres[m][bj][n] = *(const u32x2*)((const char*)HB + ((off + (bj * HALF + n * 16) * 4) >> 1)); }
            asm volatile("" ::: "memory");
#pragma unroll
            for (int m = 0; m < 4; ++m) { const int row = row0 + ai * HALF + m * 16; float s = 0.f, q = 0.f;
                const unsigned yb = (unsigned)((((row >> 5) * 128 + (col0 >> 4)) * 32 + (row & 31)) * 16 + (col0 & 15)) * 2u;
#pragma unroll
                for (int bj = 0; bj < 2; ++bj)
#pragma unroll
                    for (int n = 0; n < 2; ++n) { const u32x2 hw = hres[m][bj][n]; const f32x4 hv = {bflo(hw.x), bfhi(hw.x), bflo(hw.y), bfhi(hw.y)}; const f32x4 y = acc[ai][bj][m][n] * (1.0f / (FP8_WSCALE * OM_SCALE)) + hv * DN_ALPHA;
                        { u32x2 yw; yw.x = cvtpk(y[0], y[1]); yw.y = cvtpk(y[2], y[3]); *(u32x2*)((char*)Y + yb + (unsigned)(((bj * HALF + n * 16) >> 4) * 32 * 16) * 2u) = yw; } s += (y[0] + y[1]) + (y[2] + y[3]); q += (y[0] * y[0] + y[1] * y[1]) + (y[2] * y[2] + y[3] * y[3]); }
                s += __shfl_xor(s, 16); s += __shfl_xor(s, 32); q += __shfl_xor(q, 16); q += __shfl_xor(q, 32);
                if (fq == 0) *(f32x2*)((char*)STAT + (unsigned)(row * 32 + u.pn * 4 + wc) * 8u) = (f32x2){s, q}; }
        }
    }
};
struct EpiSwiglu {
    static constexpr bool PERM = true;
    bf16_t* ACT; const float* b_in;
    __device__ __forceinline__ void operator()(const f32x4 (&acc)[2][2][4][2], const Unit& u, int wr, int wc, int fr, int fq) const {
        const int col = u.pn * 128 + wc * 32 + 8 * fq;
        const unsigned o0 = (unsigned)((u.pm * BM + wr * 64 + fr) * DFF + col);
        const float* bg = b_in + (size_t)u.e * 1024 + col; const float* bu = bg + 512;
        const f32x4 bg0 = *(const f32x4*)bg, bg1 = *(const f32x4*)(bg + 4), bu0 = *(const f32x4*)bu, bu1 = *(const f32x4*)(bu + 4);
#pragma unroll
        for (int ai = 0; ai < 2; ++ai)
#pragma unroll
            for (int m = 0; m < 4; ++m) { float a[8];
#pragma unroll
                for (int n = 0; n < 2; ++n) { const f32x4 g4 = acc[ai][0][m][n] * (1.0f / FP8_WSCALE) + (n ? bg1 : bg0), u4 = acc[ai][1][m][n] * (1.0f / FP8_WSCALE) + (n ? bu1 : bu0);
#pragma unroll
                    for (int i = 0; i < 4; ++i) { const float g = fminf(g4[i], 7.0f), up = fminf(fmaxf(u4[i], -7.0f), 7.0f);
                        const float sg = __builtin_amdgcn_rcpf(1.0f + __builtin_amdgcn_exp2f(-1.702f * 1.4426950408889634f * g));
                        a[4 * n + i] = g * sg * (up + 1.0f); } }
                u32x2 w; w.x = cvt4_fp8(a[0], a[1], a[2], a[3]); w.y = cvt4_fp8(a[4], a[5], a[6], a[7]);
                *(u32x2*)((char*)ACT + o0 + (unsigned)((ai * HALF + m * 16) * DFF)) = w;
                asm volatile("" ::: "memory"); }
    }
};
struct EpiDown {
    static constexpr int PERM = 2;
    unsigned char* YE; const float* b_out;
    __device__ __forceinline__ void operator()(const f32x4 (&acc)[2][2][4][2], const Unit& u, int wr, int wc, int fr, int fq) const {
        const int col0 = u.pn * BM + wc * 64 + 16 * fq;
        const unsigned o0 = (unsigned)((u.pm * BM + wr * 64 + fr) * DM + col0);
        const unsigned bo = (unsigned)(u.e * DM + col0) * 4u;
        f32x4 bb[2][2];
#pragma unroll
        for (int bj = 0; bj < 2; ++bj)
#pragma unroll
            for (int n = 0; n < 2; ++n) bb[bj][n] = *(const f32x4*)((const char*)b_out + bo + (bj * 8 + n * 4) * 4);
#pragma unroll
        for (int ai = 0; ai < 2; ++ai)
#pragma unroll
            for (int m = 0; m < 4; ++m) { u32x4 w;
                { const f32x4 v = acc[ai][0][m][0] * (1.0f / FP8_WSCALE) + bb[0][0]; w.x = cvt4_fp8(v[0], v[1], v[2], v[3]); }
                { const f32x4 v = acc[ai][0][m][1] * (1.0f / FP8_WSCALE) + bb[0][1]; w.y = cvt4_fp8(v[0], v[1], v[2], v[3]); }
                { const f32x4 v = acc[ai][1][m][0] * (1.0f / FP8_WSCALE) + bb[1][0]; w.z = cvt4_fp8(v[0], v[1], v[2], v[3]); }
                { const f32x4 v = acc[ai][1][m][1] * (1.0f / FP8_WSCALE) + bb[1][1]; w.w = cvt4_fp8(v[0], v[1], v[2], v[3]); }
                *(u32x4*)(YE + o0 + (unsigned)((ai * HALF + m * 16) * DM)) = w; }
    }
};
struct MoeOrder {
    const LAS int* tstart; const unsigned* cnt; const int* rowtok; int nN, G, c; bool gather; bool runs;
    __device__ __forceinline__ bool next(int i, Unit& u) const {
        const int total = tstart[NEXP];
        const int per = (total * nN + G - 1) / G;
        const long L = runs ? (long)c * per + i : (long)i * G + c; if (L >= (long)total * nN || (runs && i >= per)) return false;
        const int mt = (int)(L / nN), pn = (int)(L % nN);
        int e = (u.e > 0 && u.e < NEXP && tstart[u.e] <= mt) ? u.e : 0;
#pragma unroll 1
        while (e + 1 < NEXP && tstart[e + 1] <= mt) ++e;
        u.pm = mt; u.pn = pn; u.e = e; u.j = mt - tstart[e]; u.pb = e * nN + pn; u.half = 0; return true;
    }
    __device__ __forceinline__ int arow(const Unit& u, int r) const {
        if (!gather) return u.pm * BM + r;
        const int p = u.j * BM + r; const int n = tstart[64 + u.e];
        const int v = rowtok[(size_t)u.e * MROWS + (p < n ? p : 0)];
        return (p < n) ? v : 0;
    }
    __device__ __forceinline__ void arow4_issue(const Unit& u, const int (&r)[4], int (&raw)[4]) const {
        if (!gather) return;
        const int n = tstart[64 + u.e];
#pragma unroll
        for (int q = 0; q < 4; ++q) { const int p = u.j * BM + r[q]; raw[q] = rowtok[(size_t)u.e * MROWS + (p < n ? p : 0)]; }
    }
    __device__ __forceinline__ int arow4_fin(const Unit& u, int r, int raw) const {
        if (!gather) return u.pm * BM + r;
        const int p = u.j * BM + r; const int n = tstart[64 + u.e]; return (p < n) ? raw : 0;
    }
    __device__ __forceinline__ void arow4(const Unit& u, const int (&r)[4], int (&o)[4]) const {
        if (!gather) { for (int q = 0; q < 4; ++q) o[q] = u.pm * BM + r[q]; return; }
        const int n = tstart[64 + u.e]; int v[4];
#pragma unroll
        for (int q = 0; q < 4; ++q) { const int p = u.j * BM + r[q]; v[q] = rowtok[(size_t)u.e * MROWS + (p < n ? p : 0)]; }
        asm volatile("" ::: "memory");
#pragma unroll
        for (int q = 0; q < 4; ++q) { const int p = u.j * BM + r[q]; o[q] = (p < n) ? v[q] : 0; }
    }
};
}
struct KArgs { const float* in[19]; float* out; unsigned char* ws; };
struct PArgs { const KArgs& k; unsigned char* ws;
    __device__ __forceinline__ const float* in(int i) const { return k.in[i]; }
    __device__ __forceinline__ float* out() const { return k.out; } };
enum { I_X = 0, I_META, I_REL, I_EVWIN, I_QNORM, I_KVNORM, I_WUQ, I_WUKV, I_EVWOUT, I_ODWIN, I_ODWOUT, I_LNG, I_LNB, I_RW, I_RB, I_EWIN, I_EBIN, I_EWOUT, I_EBOUT };

__device__ __forceinline__ int rowmap(int kind, int n) {
    switch (kind) {
    case 0: {
        if (n < 768) return n; if (n < 832) return EC_KROPE + (n - 768); if (n < 2368) return n - 64; return n; }
    case 1: {
        const int head = n / 192, d = n % 192; if (d < 128) return head * 128 + d;
        const int i = d - 128; if (i < 32) return 512 + head * 64 + 8 * (i >> 2) + (i & 3); const int i2 = i - 32; return 512 + head * 64 + 8 * (i2 >> 2) + 4 + (i2 & 3); }
    case 2: {
        if (n < 512) return 256 * (n >> 7) + (n & 127); const int j = n - 512; return 256 * (j >> 7) + 128 + (j & 127); }
    default: return n;
    }
}
__device__ __forceinline__ void ti_load(f32x4 (&v)[8], const float* W, int Nsrc, int nblk, int item, int lane) {
    const int kb = item / nblk, nb = item % nblk, k0 = 64 * kb, n0 = 32 * nb; const int nq = n0 + 4 * (lane & 7);
#pragma unroll
    for (int i = 0; i < 8; ++i) { const int kk = 8 * i + (lane >> 3); v[i] = (nq < Nsrc) ? *(const f32x4*)(W + (size_t)(k0 + kk) * Nsrc + nq) : (f32x4){0.f, 0.f, 0.f, 0.f}; }
}
__device__ __forceinline__ void ti_finish(const f32x4 (&v)[8], int K, int nblk, bf16_t* WT, int kind, LAS float* scr, int item, int lane) {
    const int kb = item / nblk, nb = item % nblk, k0 = 64 * kb, n0 = 32 * nb;
#pragma unroll
    for (int i = 0; i < 8; ++i) { const int kk = 8 * i + (lane >> 3); LAS float* d = scr + kk * 33 + 4 * (lane & 7); d[0] = v[i][0]; d[1] = v[i][1]; d[2] = v[i][2]; d[3] = v[i][3]; }
    LDS_WAIT(); asm volatile("" ::: "memory");
    const int c = lane & 7;
#pragma unroll
    for (int j = 0; j < 4; ++j) { const int n = (lane >> 3) + 8 * j; const LAS float* s = scr + (8 * c) * 33 + n;
        u32x4 o; o.x = cvtpk(s[0 * 33], s[1 * 33]); o.y = cvtpk(s[2 * 33], s[3 * 33]); o.z = cvtpk(s[4 * 33], s[5 * 33]); o.w = cvtpk(s[6 * 33], s[7 * 33]);
        *(u32x4*)(WT + (size_t)rowmap(kind, n0 + n) * K + k0 + 8 * c) = o; }
    LDS_WAIT(); asm volatile("" ::: "memory");
}
__device__ __forceinline__ void ti_finish8(const f32x4 (&v)[8], int K, int nblk, unsigned char* WT8, int kind, LAS float* scr, int item, int lane) {
    const int kb = item / nblk, nb = item % nblk, k0 = 64 * kb, n0 = 32 * nb;
#pragma unroll
    for (int i = 0; i < 8; ++i) { const int kk = 8 * i + (lane >> 3); LAS float* d = scr + kk * 33 + 4 * (lane & 7); d[0] = v[i][0]; d[1] = v[i][1]; d[2] = v[i][2]; d[3] = v[i][3]; }
    LDS_WAIT(); asm volatile("" ::: "memory");
    const int c = lane & 7;
#pragma unroll
    for (int j = 0; j < 4; ++j) { const int n = (lane >> 3) + 8 * j; const LAS float* s = scr + (8 * c) * 33 + n;
        u32x2 o; o.x = cvt4_fp8(s[0 * 33] * FP8_WSCALE, s[1 * 33] * FP8_WSCALE, s[2 * 33] * FP8_WSCALE, s[3 * 33] * FP8_WSCALE);
        o.y = cvt4_fp8(s[4 * 33] * FP8_WSCALE, s[5 * 33] * FP8_WSCALE, s[6 * 33] * FP8_WSCALE, s[7 * 33] * FP8_WSCALE);
        *(u32x2*)(WT8 + (size_t)rowmap(kind, n0 + n) * K + k0 + 8 * c) = o; }
    LDS_WAIT(); asm volatile("" ::: "memory");
}
__device__ __forceinline__ void transpose_item8(const float* W, int K, int Nsrc, int nblk, unsigned char* WT8, int kind, LAS float* scr, int item, int lane) {
    f32x4 v[8]; ti_load(v, W, Nsrc, nblk, item, lane); ti_finish8(v, K, nblk, WT8, kind, scr, item, lane);
}
__device__ __forceinline__ void transpose_item(const float* W, int K, int Nsrc, int nblk, bf16_t* WT, int kind, LAS float* scr, int item, int lane) {
    f32x4 v[8]; ti_load(v, W, Nsrc, nblk, item, lane); ti_finish(v, K, nblk, WT, kind, scr, item, lane);
}
__device__ __forceinline__ void phase_prologue(const PArgs& a, LAS unsigned char* lds, int vcu, int G) {
    const int tid = opaque_tid(), lane = tid & 63, wave = __builtin_amdgcn_readfirstlane(tid >> 6);
    LAS float* scr = (LAS float*)(lds + wave * 16384);
    const int gw = vcu * 8 + wave, NGW = G * 8;
    unsigned char* ws = a.ws;
    constexpr int I_EVIN = (DM / 64) * (EVP / 32), I_UQ = (512 / 64) * (768 / 32), I_UKV = (256 / 64) * (1024 / 32), I_OUT = (1024 / 64) * (DM / 32), I_ODIN = (DM / 64) * (ODP / 32);
    constexpr int I_EI = (DM / 64) * (1024 / 32), I_EO = (DFF / 64) * (DM / 32);
    constexpr int N_SMALL = 2 * (I_EVIN + I_UQ + I_UKV + I_OUT + I_ODIN + I_OUT);
    constexpr long N_ALL = (long)N_SMALL;
    for (long it = gw; it < N_ALL; it += NGW) {
        long r = it;
        if (r < N_SMALL) {
            const int j = (int)(r & 1); r >>= 1;
            if (r < I_EVIN) { transpose_item8(a.in(I_EVWIN) + (size_t)j * DM * 2368, DM, 2368, EVP / 32, ws + WS_WINE + j * SZ_WINE, 0, scr, (int)r, lane); continue; } r -= I_EVIN;
            if (r < I_UQ) { transpose_item(a.in(I_WUQ) + (size_t)j * 512 * 768, 512, 768, 768 / 32, (bf16_t*)(ws + WS_WUQ + j * SZ_WUQ), 1, scr, (int)r, lane); continue; } r -= I_UQ;
            if (r < I_UKV) { transpose_item(a.in(I_WUKV) + (size_t)j * 256 * 1024, 256, 1024, 1024 / 32, (bf16_t*)(ws + WS_WUKV + j * SZ_WUKV), 3, scr, (int)r, lane); continue; } r -= I_UKV;
            if (r < I_OUT) { transpose_item8(a.in(I_EVWOUT) + (size_t)j * 1024 * DM, 1024, DM, DM / 32, ws + WS_WOUTE + j * SZ_WOUT, 3, scr, (int)r, lane); continue; } r -= I_OUT;
            if (r < I_ODIN) { transpose_item8(a.in(I_ODWIN) + (size_t)j * DM * 1864, DM, 1864, ODP / 32, ws + WS_WINO + j * SZ_WINO, 3, scr, (int)r, lane); continue; } r -= I_ODIN;
            transpose_item8(a.in(I_ODWOUT) + (size_t)j * 1024 * DM, 1024, DM, DM / 32, ws + WS_WOUTO + j * SZ_WOUT, 3, scr, (int)r, lane); continue;
        }
    }
    {   constexpr int PER = I_EI + I_EO; constexpr long NEXI = (long)DEPTH * NEXP * PER;
#define EXP_DESC(idx, Wp, Kd, Ns, nb, Tp, kd, qi) const int le_ = (int)((idx) / PER), q_ = (int)((idx) % PER); const bool ei_ = q_ < I_EI; \
        const float* Wp = ei_ ? a.in(I_EWIN) + (size_t)le_ * DM * 1024 : a.in(I_EWOUT) + (size_t)le_ * DFF * DM; const int Kd = ei_ ? DM : DFF, Ns = ei_ ? 1024 : DM, nb = ei_ ? 1024 / 32 : DM / 32; \
        unsigned char* Tp = ei_ ? (ws + WS_WEI + (size_t)le_ * SZ_WEI) : (ws + WS_WEO + (size_t)le_ * SZ_WEO); const int kd = ei_ ? 2 : 3, qi = ei_ ? q_ : q_ - I_EI
        f32x4 va[8], vb[8];
        long it = gw;
        if (it < NEXI) { EXP_DESC(it, W0, K0, N0, B0, T0, D0, Q0); (void)K0; (void)T0; (void)D0; ti_load(va, W0, N0, B0, Q0, lane); }
        for (; it < NEXI; it += 2 * NGW) {
            const long i1 = it + NGW, i2 = it + 2 * NGW;
            if (i1 < NEXI) { EXP_DESC(i1, W1, K1, N1, B1, T1, D1, Q1); (void)K1; (void)T1; (void)D1; ti_load(vb, W1, N1, B1, Q1, lane); }
            { EXP_DESC(it, W0, K0, N0, B0, T0, D0, Q0); (void)W0; (void)N0; ti_finish8(va, K0, B0, T0, D0, scr, Q0, lane); }
            if (i2 < NEXI) { EXP_DESC(i2, W2, K2, N2, B2, T2, D2, Q2); (void)K2; (void)T2; (void)D2; ti_load(va, W2, N2, B2, Q2, lane); }
            if (i1 < NEXI) { EXP_DESC(i1, W1, K1, N1, B1, T1, D1, Q1); (void)W1; (void)N1; ti_finish8(vb, K1, B1, T1, D1, scr, Q1, lane); }
        }
#undef EXP_DESC
    }
    for (int i = gw * 64 + lane; i < DEPTH * 32 * DM; i += NGW * 64) {
        const int l = i / (32 * DM), e = (i / DM) % 32, k = i % DM;
        const float w = a.in(I_RW)[((size_t)l * DM + k) * 32 + e];
        const unsigned hi = cvtpk(w, 0.f) & 0xffffu; const float lo = w - bflo(hi);
        ((bf16_t*)(ws + WS_WRH))[i] = (bf16_t)hi; ((bf16_t*)(ws + WS_WRL))[i] = (bf16_t)(cvtpk(lo, 0.f) & 0xffffu);
    }
    for (int i = gw * 64 + lane; i < NTOK * 32; i += NGW * 64) {
        const int t = i >> 5, k = i & 31;
        const float inv = powf(10000.0f, -(float)k / 32.0f); const float ang = (float)t * inv;
        float sn, cs; sincosf(ang, &sn, &cs);
        *(f32x2*)((float*)(ws + WS_ROPE) + (size_t)i * 2) = (f32x2){cs, sn};
    }
    bf16_t* HB = (bf16_t*)(ws + WS_HB);
    for (int m = gw; m < MROWS; m += NGW) {
        const int b = m / NTOK, t = m % NTOK;
        const float* src = (t < NMETA) ? a.in(I_META) + (size_t)t * DM : a.in(I_X) + ((size_t)b * SEQ + (t - NMETA)) * DM;
        const bool zero = t >= NMETA + SEQ;
        f32x4 v8[8];
#pragma unroll
        for (int j = 0; j < 8; ++j) v8[j] = zero ? (f32x4){0.f, 0.f, 0.f, 0.f} : *(const f32x4*)(src + 4 * lane + 256 * j);
        asm volatile("" ::: "memory");
#pragma unroll
        for (int j = 0; j < 8; ++j) { const int c = 4 * lane + 256 * j; const f32x4 v = v8[j];
            u32x2 w; w.x = cvtpk(v[0], v[1]); w.y = cvtpk(v[2], v[3]); *(u32x2*)(HB + (size_t)m * DM + c) = w;
            *(unsigned*)(ws + WS_HB8 + (size_t)m * DM + c) = cvt4_fp8(v[0], v[1], v[2], v[3]); }
    }
}

__device__ __forceinline__ void phase_latent_norm(const PArgs& a, int jl, int vcu, int G) {
    const int tid = opaque_tid(), lane = tid & 63, wave = __builtin_amdgcn_readfirstlane(tid >> 6);
    const int gw = vcu * 8 + wave, NGW = G * 8;
    unsigned char* ws = a.ws;
    const bf16_t* P = (const bf16_t*)(ws + WS_P); bf16_t* QN = (bf16_t*)(ws + WS_QN); bf16_t* KVN = (bf16_t*)(ws + WS_KVN); bf16_t* KR = (bf16_t*)(ws + WS_KR);
    const float* rope = (const float*)(ws + WS_ROPE);
    const float* gq = a.in(I_QNORM) + jl * 512; const float* gkv = a.in(I_KVNORM) + jl * 256;
    f32x4 g0 = *(const f32x4*)(gq + 8 * lane), g1 = *(const f32x4*)(gq + 8 * lane + 4), gk = *(const f32x4*)(gkv + 4 * lane);
    const int lr = lane & 31;
#define LAT_LOAD(m_, qv_, kv_, x1_, x2_, cs_) do { const bf16_t* pr_ = P + (size_t)(m_) * EVP; qv_ = *(const u32x4*)(pr_ + EC_QLAT + 8 * lane); kv_ = *(const u32x2*)(pr_ + EC_KVLAT + 4 * lane); \
        x1_ = pr_[EC_KROPE + lr]; x2_ = pr_[EC_KROPE + 32 + lr]; cs_ = *(const f32x2*)(rope + ((size_t)((m_) % NTOK) * 32 + lr) * 2); } while (0)
    u32x4 qv = {0u, 0u, 0u, 0u}, qvn = qv; u32x2 kv = {0u, 0u}, kvn = kv; bf16_t x1b = 0, x2b = 0, x1n = 0, x2n = 0; f32x2 cs = {0.f, 0.f}, csn = cs;
    if (gw < MROWS) LAT_LOAD(gw, qv, kv, x1b, x2b, cs);
    for (int m = gw; m < MROWS; m += NGW) {
        const int mn = (m + NGW < MROWS) ? m + NGW : m;
        LAT_LOAD(mn, qvn, kvn, x1n, x2n, csn);
        asm volatile("" ::: "memory");
        float q[8] = {bflo(qv.x), bfhi(qv.x), bflo(qv.y), bfhi(qv.y), bflo(qv.z), bfhi(qv.z), bflo(qv.w), bfhi(qv.w)};
        float k[4] = {bflo(kv.x), bfhi(kv.x), bflo(kv.y), bfhi(kv.y)};
        float sq = 0.f, sk = 0.f;
#pragma unroll
        for (int i = 0; i < 8; ++i) sq += q[i] * q[i];
#pragma unroll
        for (int i = 0; i < 4; ++i) sk += k[i] * k[i];
        sq = wave_sum(sq); sk = wave_sum(sk);
        const float rq = 1.0f / sqrtf(sq * (1.0f / 512.0f) + RMS_EPS), rk = 1.0f / sqrtf(sk * (1.0f / 256.0f) + RMS_EPS);
        u32x4 wq; wq.x = cvtpk(q[0] * rq * g0[0], q[1] * rq * g0[1]); wq.y = cvtpk(q[2] * rq * g0[2], q[3] * rq * g0[3]);
        wq.z = cvtpk(q[4] * rq * g1[0], q[5] * rq * g1[1]); wq.w = cvtpk(q[6] * rq * g1[2], q[7] * rq * g1[3]);
        *(u32x4*)(QN + (size_t)m * 512 + 8 * lane) = wq;
        u32x2 wk; wk.x = cvtpk(k[0] * rk * gk[0], k[1] * rk * gk[1]); wk.y = cvtpk(k[2] * rk * gk[2], k[3] * rk * gk[3]);
        *(u32x2*)(KVN + (size_t)m * 256 + 4 * lane) = wk;
        if (lane < 32) {
            const float x1 = bf2f(x1b), x2 = bf2f(x2b);
            KR[(size_t)m * 64 + lane] = (bf16_t)(cvtpk(x1 * cs[0] - x2 * cs[1], 0.f) & 0xffffu);
            KR[(size_t)m * 64 + 32 + lane] = (bf16_t)(cvtpk(x1 * cs[1] + x2 * cs[0], 0.f) & 0xffffu);
        }
        qv = qvn; kv = kvn; x1b = x1n; x2b = x2n; cs = csn;
    }
#undef LAT_LOAD
}

__device__ __forceinline__ void phase_ln_route(const PArgs& a, int layer, int cslot, LAS unsigned char* lds, int vcu, int G) {
    const int tid = opaque_tid(), lane = tid & 63, wave = __builtin_amdgcn_readfirstlane(tid >> 6);
    const int r32 = lane & 31, hh = lane >> 5;
    unsigned char* ws = a.ws;
    const bf16_t* Y = (const bf16_t*)(ws + WS_Y); const float* STAT = (const float*)(ws + WS_STAT);
    bf16_t* HB = (bf16_t*)(ws + WS_HB);
    const bf16_t* WRH = (const bf16_t*)(ws + WS_WRH) + (size_t)layer * 32 * DM; const bf16_t* WRL = (const bf16_t*)(ws + WS_WRL) + (size_t)layer * 32 * DM;
    const float* g = a.in(I_LNG) + (size_t)(layer * 2 + 0) * DM; const float* bta = a.in(I_LNB) + (size_t)(layer * 2 + 0) * DM;
    const float* rb = a.in(I_RB) + layer * 32;
    unsigned* cnt = (unsigned*)(ws + WS_CTL) + CW_CNT + 2048 * cslot;
    int* TOPE = (int*)(ws + WS_TOPE); int* TOPP = (int*)(ws + WS_TOPP); float* TOPG = (float*)(ws + WS_TOPG); int* ROWTOK = (int*)(ws + WS_ROWTOK);
    LAS float* part = (LAS float*)lds;
    LAS float* tot = part + 8 * 16 * 64;
    LAS float* gbl = tot + 16 * 64 + wave * 512;
    LAS unsigned* lcnt0 = (LAS unsigned*)(tot + 16 * 64 + 8 * 512);
    float* LOGIT = (float*)(ws + WS_QN);
    LAS unsigned char* stg = lds + 57344 + wave * 7168;
    const int cbase = 256 * wave, lcol = 16 * hh;
    bf16x8 whf[16], wlf[16];
#pragma unroll
    for (int s = 0; s < 16; ++s) { const int col = cbase + 32 * (s >> 1) + lcol + 8 * (s & 1);
        whf[s] = *(const bf16x8*)(WRH + (size_t)r32 * DM + col); wlf[s] = *(const bf16x8*)(WRL + (size_t)r32 * DM + col); }
    { const f32x4 gv = *(const f32x4*)(g + cbase + 4 * lane), bv = *(const f32x4*)(bta + cbase + 4 * lane);
      *(LAS f32x4*)(gbl + 4 * lane) = gv; *(LAS f32x4*)(gbl + 256 + 4 * lane) = bv; }
    LDS_WAIT(); asm volatile("" ::: "memory");
    for (int grp = vcu; grp < MROWS / 32; grp += G) {
        const int row = grp * 32 + r32;
        float s = 0.f, q = 0.f;
        { const f32x4* st = (const f32x4*)(STAT + (size_t)row * 64);
#pragma unroll
          for (int i = 0; i < 16; ++i) { const f32x4 v = st[i]; s += v[0] + v[2]; q += v[1] + v[3]; } }
        const float mean = s * (1.0f / DM); const float var = fmaxf(q * (1.0f / DM) - mean * mean, 0.f); const float rstd = 1.0f / sqrtf(var + LN_EPS);
        f32x16 acc;
#pragma unroll
        for (int i = 0; i < 16; ++i) acc[i] = 0.f;
        const size_t ro = (size_t)row * DM + cbase + lcol;
        u32x4 yAv[4], yBv[4];
#pragma unroll
        for (int p = 0; p < 8; ++p) {
            if ((p & 3) == 0) {
#pragma unroll
                for (int pp = 0; pp < 4; ++pp) { const bf16_t* yp = Y + ((size_t)(grp * 128 + 16 * wave + 2 * (p + pp) + hh) * 32 + r32) * 16;
                    yAv[pp] = *(const u32x4*)(yp); yBv[pp] = *(const u32x4*)(yp + 8); }
                asm volatile("" ::: "memory"); }
            const u32x4 yA = yAv[p & 3], yB = yBv[p & 3];
            const f32x4 y0 = {bflo(yA.x), bfhi(yA.x), bflo(yA.y), bfhi(yA.y)}, y1 = {bflo(yA.z), bfhi(yA.z), bflo(yA.w), bfhi(yA.w)}, y2 = {bflo(yB.x), bfhi(yB.x), bflo(yB.y), bfhi(yB.y)}, y3 = {bflo(yB.z), bfhi(yB.z), bflo(yB.w), bfhi(yB.w)};
            const LAS float* gp = gbl + 32 * p + lcol;
            const f32x4 g0 = *(const LAS f32x4*)(gp), g1 = *(const LAS f32x4*)(gp + 4), g2 = *(const LAS f32x4*)(gp + 8), g3 = *(const LAS f32x4*)(gp + 12);
            const f32x4 b0 = *(const LAS f32x4*)(gp + 256), b1 = *(const LAS f32x4*)(gp + 260), b2 = *(const LAS f32x4*)(gp + 264), b3 = *(const LAS f32x4*)(gp + 268);
            const f32x4 h0 = (y0 - mean) * rstd * g0 + b0, h1 = (y1 - mean) * rstd * g1 + b1, h2 = (y2 - mean) * rstd * g2 + b2, h3 = (y3 - mean) * rstd * g3 + b3;
            u32x4 hiA, hiB; hiA.x = cvtpk(h0[0], h0[1]); hiA.y = cvtpk(h0[2], h0[3]); hiA.z = cvtpk(h1[0], h1[1]); hiA.w = cvtpk(h1[2], h1[3]);
            hiB.x = cvtpk(h2[0], h2[1]); hiB.y = cvtpk(h2[2], h2[3]); hiB.z = cvtpk(h3[0], h3[1]); hiB.w = cvtpk(h3[2], h3[3]);
            { LAS unsigned char* sH = stg + r32 * 144 + (p & 1) * 64 + hh * 32; *(LAS u32x4*)(sH) = hiA; *(LAS u32x4*)(sH + 16) = hiB;
              u32x4 q8; q8.x = cvt4_fp8(h0[0], h0[1], h0[2], h0[3]); q8.y = cvt4_fp8(h1[0], h1[1], h1[2], h1[3]); q8.z = cvt4_fp8(h2[0], h2[1], h2[2], h2[3]); q8.w = cvt4_fp8(h3[0], h3[1], h3[2], h3[3]);
              *(LAS u32x4*)(stg + 4608 + r32 * 80 + (p & 1) * 32 + hh * 16) = q8; }
            if (p & 1) {
                LDS_WAIT(); asm volatile("" ::: "memory");
                int ln_ = lane; asm volatile("" : "+v"(ln_));
                const size_t cq = (size_t)cbase + 64 * (p >> 1);
#pragma unroll
                for (int i = 0; i < 4; ++i) { const int id = i * 64 + ln_, rw = id >> 3, c = id & 7; const u32x4 w = *(const LAS u32x4*)(stg + rw * 144 + c * 16);
                    *(u32x4*)((unsigned char*)HB + ((size_t)(grp * 32 + rw) * DM + cq) * 2 + c * 16) = w; }
#pragma unroll
                for (int i = 0; i < 2; ++i) { const int id = i * 64 + ln_, rw = id >> 2, c = id & 3; const u32x4 w = *(const LAS u32x4*)(stg + 4608 + rw * 80 + c * 16);
                    *(u32x4*)((unsigned char*)(ws + WS_HB8) + (size_t)(grp * 32 + rw) * DM + cq + c * 16) = w; }
                asm volatile("" ::: "memory");
            }
            u32x4 loA, loB; loA.x = cvtpk(h0[0] - bflo(hiA.x), h0[1] - bfhi(hiA.x)); loA.y = cvtpk(h0[2] - bflo(hiA.y), h0[3] - bfhi(hiA.y));
            loA.z = cvtpk(h1[0] - bflo(hiA.z), h1[1] - bfhi(hiA.z)); loA.w = cvtpk(h1[2] - bflo(hiA.w), h1[3] - bfhi(hiA.w));
            loB.x = cvtpk(h2[0] - bflo(hiB.x), h2[1] - bfhi(hiB.x)); loB.y = cvtpk(h2[2] - bflo(hiB.y), h2[3] - bfhi(hiB.y));
            loB.z = cvtpk(h3[0] - bflo(hiB.z), h3[1] - bfhi(hiB.z)); loB.w = cvtpk(h3[2] - bflo(hiB.w), h3[3] - bfhi(hiB.w));
            const bf16x8 hiAf = __builtin_bit_cast(bf16x8, hiA), hiBf = __builtin_bit_cast(bf16x8, hiB), loAf = __builtin_bit_cast(bf16x8, loA), loBf = __builtin_bit_cast(bf16x8, loB);
            acc = __builtin_amdgcn_mfma_f32_32x32x16_bf16(whf[2 * p], hiAf, acc, 0, 0, 0);
            acc = __builtin_amdgcn_mfma_f32_32x32x16_bf16(whf[2 * p], loAf, acc, 0, 0, 0);
            acc = __builtin_amdgcn_mfma_f32_32x32x16_bf16(wlf[2 * p], hiAf, acc, 0, 0, 0);
            acc = __builtin_amdgcn_mfma_f32_32x32x16_bf16(whf[2 * p + 1], hiBf, acc, 0, 0, 0);
            acc = __builtin_amdgcn_mfma_f32_32x32x16_bf16(whf[2 * p + 1], loBf, acc, 0, 0, 0);
            acc = __builtin_amdgcn_mfma_f32_32x32x16_bf16(wlf[2 * p + 1], hiBf, acc, 0, 0, 0);
        }
#pragma unroll
        for (int r = 0; r < 16; ++r) part[(wave * 16 + r) * 64 + lane] = acc[r];
        LDS_WAIT(); __syncthreads();
#pragma unroll
        for (int rr = 0; rr < 2; ++rr) { const int r = 2 * wave + rr; float t = 0.f;
#pragma unroll
            for (int w = 0; w < 8; ++w) t += part[(w * 16 + r) * 64 + lane];
            LOGIT[((size_t)grp * 16 + r) * 64 + lane] = t; }
        LDS_WAIT(); __syncthreads();
    }
    __syncthreads();
    LAS unsigned* lcnt = lcnt0 + wave * 64;
    for (int grp = vcu + wave * G; grp < MROWS / 32; grp += 8 * G) {
        const int row = grp * 32 + r32;
        {
            float v[16];
#pragma unroll
            for (int r = 0; r < 16; ++r) v[r] = LOGIT[((size_t)grp * 16 + r) * 64 + lane] + rb[(r & 3) + 8 * (r >> 2) + 4 * hh];
            float bv[4]; int bi[4];
#pragma unroll
            for (int k = 0; k < 4; ++k) { float best = -3.0e38f; int br = 0;
#pragma unroll
                for (int r = 0; r < 16; ++r) { const bool gt = v[r] > best; best = gt ? v[r] : best; br = gt ? r : br; }
#pragma unroll
                for (int r = 0; r < 16; ++r) v[r] = (r == br) ? -3.0e38f : v[r];
                bv[k] = best; bi[k] = (br & 3) + 8 * (br >> 2) + 4 * hh; }
            float ov[4]; int oi[4];
#pragma unroll
            for (int k = 0; k < 4; ++k) { ov[k] = __shfl_xor(bv[k], 32); oi[k] = __shfl_xor(bi[k], 32); }
            float tv[4]; int ti[4]; int pa = 0, pb = 0;
#pragma unroll
            for (int k = 0; k < 4; ++k) {
                float av = bv[0], ovv = ov[0]; int ai = bi[0], oii = oi[0];
#pragma unroll
                for (int z = 1; z < 4; ++z) { av = (pa == z) ? bv[z] : av; ai = (pa == z) ? bi[z] : ai; ovv = (pb == z) ? ov[z] : ovv; oii = (pb == z) ? oi[z] : oii; }
                const bool takeA = (av > ovv) || (av == ovv && ai < oii);
                tv[k] = takeA ? av : ovv; ti[k] = takeA ? ai : oii; pa += takeA ? 1 : 0; pb += takeA ? 0 : 1; }
            if (hh == 0) {
                const float e1 = __expf(tv[1] - tv[0]), e2 = __expf(tv[2] - tv[0]), e3 = __expf(tv[3] - tv[0]); const float inv = 1.0f / (1.0f + e1 + e2 + e3);
                const float gt[4] = {inv, e1 * inv, e2 * inv, e3 * inv};
                lcnt[lane] = 0u; LDS_WAIT(); asm volatile("" ::: "memory");
                unsigned lr[4];
#pragma unroll
                for (int k = 0; k < 4; ++k) lr[k] = __hip_atomic_fetch_add(lcnt + ti[k], 1u, __ATOMIC_RELAXED, __HIP_MEMORY_SCOPE_WORKGROUP);
                LDS_WAIT(); asm volatile("" ::: "memory");
                { const unsigned n = lcnt[lane]; unsigned bs = 0u; if (n) bs = __hip_atomic_fetch_add(cnt + 64 * lane, n, __ATOMIC_RELAXED, __HIP_MEMORY_SCOPE_AGENT); lcnt[32 + lane] = bs; }
                LDS_WAIT(); asm volatile("" ::: "memory");
                int ps[4];
#pragma unroll
                for (int k = 0; k < 4; ++k) { ps[k] = (int)(lcnt[32 + ti[k]] + lr[k]); ROWTOK[(size_t)ti[k] * MROWS + ps[k]] = row; }
                *(i32x4*)(TOPE + (size_t)row * 4) = (i32x4){ti[0], ti[1], ti[2], ti[3]};
                *(i32x4*)(TOPP + (size_t)row * 4) = (i32x4){ps[0], ps[1], ps[2], ps[3]};
                *(f32x4*)(TOPG + (size_t)row * 4) = (f32x4){gt[0], gt[1], gt[2], gt[3]};
            }
        }
    }
    __syncthreads();
}

__device__ __forceinline__ void build_tile_table(const unsigned* cnt, LAS int* tstart) {
    const int tid_ = opaque_tid();
    if (tid_ < 64) {
        const int lane = tid_; const int n = (lane < NEXP) ? (int)__hip_atomic_load(cnt + 64 * lane, __ATOMIC_RELAXED, __HIP_MEMORY_SCOPE_AGENT) : 0;
        const int tiles = (n + 255) >> 8; int incl = tiles;
#pragma unroll
        for (int o = 1; o < 64; o <<= 1) { const int v = __shfl_up(incl, o); if (lane >= o) incl += v; }
        if (lane <= NEXP) tstart[lane] = incl - tiles;
        if (lane < NEXP) tstart[64 + lane] = n;
    }
    LDS_WAIT(); __syncthreads();
}

struct CombRow { f32x4 z[8]; };
template <bool last>
__device__ __forceinline__ void phase_combine_ln(const PArgs& a, int layer, const LAS int* tstart, int vcu, int G, bool dummy) {
    const int tid = opaque_tid(), lane = tid & 63, wave = __builtin_amdgcn_readfirstlane(tid >> 6);
    LAS unsigned char* lds_b = (LAS unsigned char*)tstart - TBL_OFF;
    const int gw = vcu * 8 + wave, NGW = G * 8;
    unsigned char* ws = a.ws;
    const bf16_t* HBin = (const bf16_t*)(ws + WS_HB); const unsigned char* YE = (const unsigned char*)(ws + WS_YEXP);
    bf16_t* HB = dummy ? (bf16_t*)(ws + WS_P) : (bf16_t*)(ws + WS_HB);
    unsigned char* H8 = ws + WS_HB8;
    const int* TOPE = (const int*)(ws + WS_TOPE); const int* TOPP = (const int*)(ws + WS_TOPP); const float* TOPG = (const float*)(ws + WS_TOPG);
    const float* g = a.in(I_LNG) + (size_t)(layer * 2 + 1) * DM; const float* bta = a.in(I_LNB) + (size_t)(layer * 2 + 1) * DM;
    float* outp = dummy ? (float*)(ws + WS_Y) : a.out();
    LAS float* gl = (LAS float*)(lds_b);
    { const int tid_ = tid; *(LAS f32x4*)(gl + 4 * tid_) = *(const f32x4*)(g + 4 * tid_); *(LAS f32x4*)(gl + 2048 + 4 * tid_) = *(const f32x4*)(bta + 4 * tid_); }
    LDS_WAIT(); __syncthreads();
#define IDX_LOAD(te_, tp_, tg_, m) do { te_ = *(const i32x4*)(TOPE + (size_t)(m) * 4); tp_ = *(const i32x4*)(TOPP + (size_t)(m) * 4); tg_ = *(const f32x4*)(TOPG + (size_t)(m) * 4); } while (0)
#define RAW_ISSUE(m, te_, tp_) do { \
        const unsigned o0_ = (unsigned)((tstart[te_[0]] * 256 + tp_[0])) , o1_ = (unsigned)((tstart[te_[1]] * 256 + tp_[1])), o2_ = (unsigned)((tstart[te_[2]] * 256 + tp_[2])), o3_ = (unsigned)((tstart[te_[3]] * 256 + tp_[3])); \
        _Pragma("unroll") for (int j = 0; j < 8; ++j) { const int c = 4 * lane + 256 * j; hwv[j] = *(const u32x2*)(HBin + (size_t)(m) * DM + c); \
            wv[j][0] = *(const unsigned*)(YE + (size_t)o0_ * DM + c); wv[j][1] = *(const unsigned*)(YE + (size_t)o1_ * DM + c); wv[j][2] = *(const unsigned*)(YE + (size_t)o2_ * DM + c); wv[j][3] = *(const unsigned*)(YE + (size_t)o3_ * DM + c); } } while (0)
#define COMB_CONVERT(R, tg_) do { _Pragma("unroll") for (int j = 0; j < 8; ++j) { const u32x2 hw_ = hwv[j]; f32x4 v_ = (f32x4){bflo(hw_.x), bfhi(hw_.x), bflo(hw_.y), bfhi(hw_.y)} * DN_ALPHA; \
            const unsigned w0_ = wv[j][0], w1_ = wv[j][1], w2_ = wv[j][2], w3_ = wv[j][3]; \
            const f32x2 a0_ = __builtin_amdgcn_cvt_pk_f32_fp8((int)w0_, false), c0_ = __builtin_amdgcn_cvt_pk_f32_fp8((int)w0_, true), a1_ = __builtin_amdgcn_cvt_pk_f32_fp8((int)w1_, false), c1_ = __builtin_amdgcn_cvt_pk_f32_fp8((int)w1_, true); \
            const f32x2 a2_ = __builtin_amdgcn_cvt_pk_f32_fp8((int)w2_, false), c2_ = __builtin_amdgcn_cvt_pk_f32_fp8((int)w2_, true), a3_ = __builtin_amdgcn_cvt_pk_f32_fp8((int)w3_, false), c3_ = __builtin_amdgcn_cvt_pk_f32_fp8((int)w3_, true); \
            v_[0] += tg_[0] * a0_[0] + tg_[1] * a1_[0] + tg_[2] * a2_[0] + tg_[3] * a3_[0]; \
            v_[1] += tg_[0] * a0_[1] + tg_[1] * a1_[1] + tg_[2] * a2_[1] + tg_[3] * a3_[1]; \
            v_[2] += tg_[0] * c0_[0] + tg_[1] * c1_[0] + tg_[2] * c2_[0] + tg_[3] * c3_[0]; \
            v_[3] += tg_[0] * c0_[1] + tg_[1] * c1_[1] + tg_[2] * c2_[1] + tg_[3] * c3_[1]; \
            (R).z[j] = v_; } } while (0)
#define COMB_FINISH(R, m) do { float s_ = 0.f; _Pragma("unroll") for (int j = 0; j < 8; ++j) s_ += ((R).z[j][0] + (R).z[j][1]) + ((R).z[j][2] + (R).z[j][3]); \
        const float mean_ = wave_sum(s_) * (1.0f / DM); float s2_ = 0.f; \
        _Pragma("unroll") for (int j = 0; j < 8; ++j) { (R).z[j] = (R).z[j] - mean_; s2_ += ((R).z[j][0] * (R).z[j][0] + (R).z[j][1] * (R).z[j][1]) + ((R).z[j][2] * (R).z[j][2] + (R).z[j][3] * (R).z[j][3]); } \
        const float rstd_ = 1.0f / sqrtf(wave_sum(s2_) * (1.0f / DM) + LN_EPS); const int b_ = (m) / NTOK, t_ = (m) % NTOK; \
        _Pragma("unroll") for (int j = 0; j < 8; ++j) { const int c = 4 * lane + 256 * j; \
            const f32x4 o_ = (R).z[j] * rstd_ * *(const LAS f32x4*)(gl + c) + *(const LAS f32x4*)(gl + 2048 + c); \
            if (!last) { u32x2 w_; w_.x = cvtpk(o_[0], o_[1]); w_.y = cvtpk(o_[2], o_[3]); *(u32x2*)(HB + (size_t)(m) * DM + c) = w_; \
                *(unsigned*)(H8 + (size_t)(m) * DM + c) = cvt4_fp8(o_[0], o_[1], o_[2], o_[3]); } \
            else if (t_ >= NMETA && t_ < NMETA + SEQ) *(f32x4*)(outp + ((size_t)b_ * SEQ + (t_ - NMETA)) * DM + c) = o_; } } while (0)
    if (gw < MROWS) {
        i32x4 teA, tpA, teB, tpB; f32x4 tgA, tgB, tgC; u32x2 hwv[8]; unsigned wv[8][4]; CombRow r;
        IDX_LOAD(teA, tpA, tgA, gw);
        RAW_ISSUE(gw, teA, tpA); tgC = tgA;
        { const int m1 = (gw + NGW < MROWS) ? gw + NGW : gw; IDX_LOAD(teB, tpB, tgB, m1); }
        int m = gw;
#define COMB_STEP(teX, tpX, tgX, teY, tpY, tgY) do { const int m1 = (m + NGW < MROWS) ? m + NGW : m, m2 = (m + 2 * NGW < MROWS) ? m + 2 * NGW : m; \
            COMB_CONVERT(r, tgC);                              \
            RAW_ISSUE(m1, teX, tpX); tgC = tgX;                \
            IDX_LOAD(teY, tpY, tgY, m2);                       \
            asm volatile("" ::: "memory"); } while (0)
        COMB_STEP(teB, tpB, tgB, teA, tpA, tgA);
        for (;;) {
            COMB_FINISH(r, m);
            m += NGW; if (m >= MROWS) break;
            COMB_STEP(teA, tpA, tgA, teB, tpB, tgB);
            COMB_FINISH(r, m);
            m += NGW; if (m >= MROWS) break;
            COMB_STEP(teB, tpB, tgB, teA, tpA, tgA);
        }
#undef COMB_STEP
    }
#undef IDX_LOAD
#undef RAW_ISSUE
#undef COMB_CONVERT
#undef COMB_FINISH
}
namespace att {
constexpr int KVBLK = 64;
constexpr int BUF_BYTES = 40960, OFF_KN = 0, OFF_KR = 16384, OFF_V = 24576, OFF_WS = 2 * BUF_BYTES, OFF_FLAG = OFF_WS + 8 * 256;
#define KSWZ(row, colB) ((row) * 256 + ((colB) ^ (((row) & 7) << 4)))
#define KRSWZ(row, colB) ((row) * 128 + ((colB) ^ (((row) & 7) << 4)))
__device__ __forceinline__ int crow(int r, int hi) { return (r & 3) + 8 * (r >> 2) + 4 * hi; }
__device__ __forceinline__ int v_st(int k, int c) { const int kk = (k & ~0xC) | ((k & 4) << 1) | ((k & 8) >> 1); return ((kk >> 3) * 4 + (c >> 5)) * 512 + ((kk & 7) * 32 + (c & 31)) * 2; }
__device__ __forceinline__ int v_rd_base(int lane) { return ((lane & 3) << 3) | (((lane >> 2) & 3) << 6) | (((lane >> 4) & 1) << 5) | (((lane >> 5) & 1) << 8); }
constexpr int v_rd_off(int d0, int ks, int half) { return d0 * 512 + ks * 4096 + half * 2048; }
template <int OFF> __device__ __forceinline__ s16x4 tr_read(int vb) { s16x4 r; asm volatile("ds_read_b64_tr_b16 %0, %1 offset:%2" : "=&v"(r) : "v"(vb), "i"(OFF) : "memory"); return r; }
template <int D0> __device__ __forceinline__ void pv_one(f32x16& od, int vb, bf16x8 pa0, bf16x8 pa1, bf16x8 pa2, bf16x8 pa3) {
    const s16x4 l0 = tr_read<v_rd_off(D0, 0, 0)>(vb), h0 = tr_read<v_rd_off(D0, 0, 1)>(vb), l1 = tr_read<v_rd_off(D0, 1, 0)>(vb), h1 = tr_read<v_rd_off(D0, 1, 1)>(vb);
    const s16x4 l2 = tr_read<v_rd_off(D0, 2, 0)>(vb), h2 = tr_read<v_rd_off(D0, 2, 1)>(vb), l3 = tr_read<v_rd_off(D0, 3, 0)>(vb), h3 = tr_read<v_rd_off(D0, 3, 1)>(vb);
    asm volatile("s_waitcnt lgkmcnt(0)" ::: "memory"); SBAR();
#define PK(L, H) (bf16x8){L[0], L[1], L[2], L[3], H[0], H[1], H[2], H[3]}
    od = __builtin_amdgcn_mfma_f32_32x32x16_bf16(pa0, PK(l0, h0), od, 0, 0, 0);
    od = __builtin_amdgcn_mfma_f32_32x32x16_bf16(pa1, PK(l1, h1), od, 0, 0, 0);
    od = __builtin_amdgcn_mfma_f32_32x32x16_bf16(pa2, PK(l2, h2), od, 0, 0, 0);
    od = __builtin_amdgcn_mfma_f32_32x32x16_bf16(pa3, PK(l3, h3), od, 0, 0, 0);
#undef PK
}
__device__ __forceinline__ void pv_d0(f32x16* o, int vb, bf16x8 pa0, bf16x8 pa1, bf16x8 pa2, bf16x8 pa3) {
    pv_one<0>(o[0], vb, pa0, pa1, pa2, pa3); pv_one<1>(o[1], vb, pa0, pa1, pa2, pa3); pv_one<2>(o[2], vb, pa0, pa1, pa2, pa3); pv_one<3>(o[3], vb, pa0, pa1, pa2, pa3);
}
__device__ __forceinline__ void pack_p(const f32x16& p0, const f32x16& p1, bf16x8& pa0, bf16x8& pa1, bf16x8& pa2, bf16x8& pa3) {
#define PK4(P, BASE, OUT) do { unsigned a0 = cvtpk(P[BASE + 0], P[BASE + 1]), a1 = cvtpk(P[BASE + 2], P[BASE + 3]);   \
    unsigned b0 = cvtpk(P[BASE + 4], P[BASE + 5]), b1 = cvtpk(P[BASE + 6], P[BASE + 7]);                              \
    auto r0 = __builtin_amdgcn_permlane32_swap(a0, b0, false, false); auto r1 = __builtin_amdgcn_permlane32_swap(a1, b1, false, false); \
    u32x4 w = {r0[0], r1[0], r0[1], r1[1]}; OUT = __builtin_bit_cast(bf16x8, w); } while (0)
    PK4(p0, 0, pa0); PK4(p0, 8, pa1); PK4(p1, 0, pa2); PK4(p1, 8, pa3);
#undef PK4
}
__device__ __forceinline__ float xhalf_max(float v) { auto rr = __builtin_amdgcn_permlane32_swap(__float_as_uint(v), __float_as_uint(v), false, false); return fmaxf(__uint_as_float(rr[0]), __uint_as_float(rr[1])); }
__device__ __forceinline__ float xhalf_sum(float v) { auto rr = __builtin_amdgcn_permlane32_swap(__float_as_uint(v), __float_as_uint(v), false, false); return __uint_as_float(rr[0]) + __uint_as_float(rr[1]); }

template <bool MLA>
__device__ __forceinline__ void attn_unit(LAS unsigned char* lds, const bf16_t* __restrict__ Qp, int ldq, const bf16_t* __restrict__ Kn, int ldk, const bf16_t* __restrict__ Kr,
                                          const bf16_t* __restrict__ Vp, int ldv, unsigned char* __restrict__ Op, int ldo, int q0) {
    constexpr int NQ = MLA ? 12 : 8, NQR = 8;
    const int tid = opaque_tid(), wid = __builtin_amdgcn_readfirstlane(tid >> 6), lane = tid & 63, r32 = lane & 31, hi = lane >> 5;
    LAS float* wsl = (LAS float*)(lds + OFF_WS) + wid * 64; LAS float* li_l = wsl; LAS float* al_l = wsl + 32;
    volatile LAS unsigned* flags = (volatile LAS unsigned*)(lds + OFF_FLAG);
    const int t = q0 + wid * 32 + r32;
    const int tq = t < NTOK ? t : NTOK - 1;
    float m_reg = -1e30f, l_reg = 0.f, R = 0.f; f32x16 o[4];
#pragma unroll
    for (int d = 0; d < 4; ++d)
#pragma unroll
        for (int r = 0; r < 16; ++r) o[d][r] = 0.f;
    bf16x8 qr[NQR];
    const bf16_t* Qw = Qp + (size_t)tq * ldq + hi * 8;
#pragma unroll
    for (int d0 = 0; d0 < NQR; ++d0) qr[d0] = *(const bf16x8*)(Qw + d0 * 16);
    const int sr = tid >> 4, sc = (tid & 15) * 8, vst0 = v_st(sr, sc), vst1 = v_st(32 + sr, sc);
    const int krr = tid >> 3, krc = (tid & 7) * 8;
    const int vb0 = (int)(uintptr_t)(lds + OFF_V) + v_rd_base(lane);
    bf16x8 vs0, vs1, ks0, ks1, kr0;
    const unsigned offV0 = (unsigned)(sr * ldv + sc) * 2u, offV1 = (unsigned)((32 + sr) * ldv + sc) * 2u, offK0 = (unsigned)(sr * ldk + sc) * 2u, offK1 = (unsigned)((32 + sr) * ldk + sc) * 2u, offR = (unsigned)(krr * 64 + krc) * 2u;
#define SLOAD(k0) do { const char* vb_ = (const char*)(Vp + (size_t)(k0) * ldv); const char* kb_ = (const char*)(Kn + (size_t)(k0) * ldk); \
    vs0 = *(const bf16x8*)(vb_ + offV0); vs1 = *(const bf16x8*)(vb_ + offV1); ks0 = *(const bf16x8*)(kb_ + offK0); ks1 = *(const bf16x8*)(kb_ + offK1); \
    if (MLA) kr0 = *(const bf16x8*)((const char*)(Kr + (size_t)(k0) * 64) + offR); } while (0)
#define SWRITE(b) do { LAS unsigned char* bb = lds + (b) * BUF_BYTES; *(LAS bf16x8*)(bb + OFF_V + vst0) = vs0; *(LAS bf16x8*)(bb + OFF_V + vst1) = vs1; \
    *(LAS bf16x8*)(bb + OFF_KN + KSWZ(sr, sc * 2)) = ks0; *(LAS bf16x8*)(bb + OFF_KN + KSWZ(32 + sr, sc * 2)) = ks1; \
    if (MLA) *(LAS bf16x8*)(bb + OFF_KR + KRSWZ(krr, krc * 2)) = kr0; } while (0)
    int NT, jfirst, jstep;
    if (MLA) { const int emax = chunk_end(q0 + 255 < NTOK ? q0 + 255 : NTOK - 1); NT = (emax + 63) / 64; if (NT > NTOK / 64) NT = NTOK / 64; jfirst = 0; jstep = 1; }
    else { int jh = (q0 + 255) / 64; if (jh > NTOK / 64 - 1) jh = NTOK / 64 - 1; NT = jh + 1; jfirst = jh; jstep = -1; }
    const int emin = MLA ? chunk_end(q0) : 0;
    const int e_t = chunk_end(tq);
    constexpr float SC = MLA ? 0.072168783648703220f : 0.088388347648318440f;
    constexpr float C = SC * 1.4426950408889634f;
    SLOAD(jfirst * KVBLK); VM_WAIT(); SWRITE(0); LDS_WAIT(); __syncthreads();
    for (int it = 0; it < NT; ++it) {
        const int j = jfirst + it * jstep; const int cb = it & 1;
        const bool more = (it + 1 < NT);
        if (more) SLOAD((j + jstep) * KVBLK);
        SBAR();
        f32x16 p0, p1;
#pragma unroll
        for (int r = 0; r < 16; ++r) { p0[r] = 0.f; p1[r] = 0.f; }
        { const LAS unsigned char* Ks = lds + cb * BUF_BYTES + OFF_KN; const LAS unsigned char* Krs = lds + cb * BUF_BYTES + OFF_KR;
#pragma unroll
          for (int d0 = 0; d0 < NQ; ++d0) {
              bf16x8 b0, b1;
              if (d0 < 8) { const int cbb = (d0 * 16 + hi * 8) * 2; b0 = *(const LAS bf16x8*)(Ks + KSWZ(r32, cbb)); b1 = *(const LAS bf16x8*)(Ks + KSWZ(32 + r32, cbb)); }
              else { const int cbb = ((d0 - 8) * 16 + hi * 8) * 2; b0 = *(const LAS bf16x8*)(Krs + KRSWZ(r32, cbb)); b1 = *(const LAS bf16x8*)(Krs + KRSWZ(32 + r32, cbb)); }
              const bf16x8 qf = (d0 < NQR) ? qr[d0 < NQR ? d0 : 0] : *(const bf16x8*)(Qw + d0 * 16);
              p0 = __builtin_amdgcn_mfma_f32_32x32x16_bf16(b0, qf, p0, 0, 0, 0);
              p1 = __builtin_amdgcn_mfma_f32_32x32x16_bf16(b1, qf, p1, 0, 0, 0); } }
        const int kbase = j * KVBLK;
        if (MLA) {
            if (kbase + KVBLK > emin) {
#pragma unroll
                for (int r = 0; r < 16; ++r) { const int k0 = kbase + crow(r, hi); p0[r] = (k0 < e_t) ? p0[r] : -1e30f; p1[r] = (k0 + 32 < e_t) ? p1[r] : -1e30f; } }
            float pmax = p0[0];
#pragma unroll
            for (int r = 1; r < 16; ++r) pmax = fmaxf(pmax, p0[r]);
#pragma unroll
            for (int r = 0; r < 16; ++r) pmax = fmaxf(pmax, p1[r]);
            pmax = xhalf_max(pmax);
            const float mn = fmaxf(m_reg, pmax); const float alpha = __builtin_amdgcn_exp2f((m_reg - mn) * C); m_reg = mn;
            const float mnC = -mn * C; float ps = 0.f;
#pragma unroll
            for (int r = 0; r < 16; ++r) { p0[r] = __builtin_amdgcn_exp2f(fmaf(p0[r], C, mnC)); p1[r] = __builtin_amdgcn_exp2f(fmaf(p1[r], C, mnC)); ps += p0[r] + p1[r]; }
            ps = xhalf_sum(ps); l_reg = l_reg * alpha + ps;
            if (__any(alpha < 1.f)) { if (hi == 0) al_l[r32] = alpha; LDS_WAIT();
#pragma unroll
                for (int d = 0; d < 4; ++d)
#pragma unroll
                    for (int r = 0; r < 16; ++r) o[d][r] *= al_l[crow(r, hi)]; }
        } else {
#define SB_LK(zz, kk) (((kk) < t) ? -(fmaxf((zz), 0.f) + 0.6931471805599453f * __builtin_amdgcn_logf(1.0f + __builtin_amdgcn_exp2f(-fabsf(zz) * 1.4426950408889634f))) : 0.f)
#pragma unroll
            for (int r = 0; r < 16; ++r) { p0[r] *= SC; p1[r] *= SC; }
            float abv[2][4]; float run = 0.f;
#pragma unroll
            for (int tt = 1; tt >= 0; --tt)
#pragma unroll
                for (int c = 3; c >= 0; --c) {
                    float mine = 0.f;
#pragma unroll
                    for (int i = 0; i < 4; ++i) { const int r = 4 * c + i; const int kk = kbase + 32 * tt + crow(r, hi); mine += SB_LK(tt ? p1[r] : p0[r], kk); }
                    const float other = __shfl_xor(mine, 32);
                    const float g_hi1 = hi ? mine : other, g_hi0 = hi ? other : mine;
                    abv[tt][c] = hi ? run : run + g_hi1;
                    run += g_hi1 + g_hi0; }
#pragma unroll
            for (int tt = 0; tt < 2; ++tt)
#pragma unroll
                for (int c = 0; c < 4; ++c) {
                    float cum = R + abv[tt][c];
#pragma unroll
                    for (int i = 3; i >= 0; --i) { const int r = 4 * c + i; const int kk = kbase + 32 * tt + crow(r, hi);
                        const float z = tt ? p1[r] : p0[r]; cum += SB_LK(z, kk);
                        const float av = (kk < t) ? __builtin_amdgcn_exp2f((z + cum) * 1.4426950408889634f) : 0.f;
                        if (tt) p1[r] = av; else p0[r] = av; } }
#undef SB_LK
            R += run;
        }
        bf16x8 pa0, pa1, pa2, pa3; pack_p(p0, p1, pa0, pa1, pa2, pa3);
        SBAR();
        pv_d0(o, vb0 + cb * BUF_BYTES, pa0, pa1, pa2, pa3);
        if (!MLA) { const bool done = __all((R < -60.f) || (t >= NTOK)); if (lane == 0) flags[(it & 1) * 8 + wid] = done ? 1u : 0u; }
        if (more) { VM_WAIT(); SWRITE(cb ^ 1); }
        LDS_WAIT(); __syncthreads();
        if (!MLA) { unsigned alld = 1u;
#pragma unroll
            for (int w = 0; w < 8; ++w) alld &= flags[(it & 1) * 8 + w];
            if (alld) break; }
    }
    float rli[16];
    if (MLA) { if (hi == 0) li_l[r32] = l_reg; LDS_WAIT();
#pragma unroll
        for (int r = 0; r < 16; ++r) rli[r] = __builtin_amdgcn_rcpf(li_l[crow(r, hi)]); }
    else {
#pragma unroll
        for (int r = 0; r < 16; ++r) rli[r] = 1.f; }
#pragma unroll
    for (int r = 0; r < 16; ++r) { const int orow = q0 + wid * 32 + crow(r, hi);
        if (orow < NTOK) {
#pragma unroll
            for (int d0 = 0; d0 < 4; ++d0) Op[(size_t)orow * ldo + d0 * 32 + r32] = om_fp8(o[d0][r] * rli[r]); } }
    __syncthreads();
#undef SLOAD
#undef SWRITE
}
#undef KSWZ
#undef KRSWZ

__device__ __forceinline__ void phase_attention(const PArgs& a, LAS unsigned char* lds, int layer) {
    unsigned char* ws = a.ws;
    unsigned* qctr = (unsigned*)(ws + WS_CTL) + CW_Q + 64 * layer;
    const bf16_t* P = (const bf16_t*)(ws + WS_P); const bf16_t* QM = (const bf16_t*)(ws + WS_QM); const bf16_t* KN = (const bf16_t*)(ws + WS_KN);
    const bf16_t* KR = (const bf16_t*)(ws + WS_KR); const bf16_t* VM = (const bf16_t*)(ws + WS_VM); unsigned char* OM = ws + WS_OM;
    volatile LAS unsigned* slot = (volatile LAS unsigned*)(lds + OFF_FLAG + 128);
    constexpr int NQB = 33, NU = 16 * NQB;
    for (;;) {
        if (opaque_tid() == 0) slot[0] = __hip_atomic_fetch_add(qctr, 1u, __ATOMIC_RELAXED, __HIP_MEMORY_SCOPE_AGENT);
        LDS_WAIT(); __syncthreads();
        const unsigned u = slot[0];
        __syncthreads();
        if (u >= 2u * NU) break;
        if (u < (unsigned)NU) {
            const int qb = NQB - 1 - (int)(u / 16), bh = (int)(u % 16), b = bh >> 2, h = bh & 3; const size_t r0 = (size_t)b * NTOK;
            attn_unit<true>(lds, QM + r0 * 768 + h * 192, 768, KN + r0 * 512 + h * 128, 512, KR + r0 * 64, VM + r0 * 512 + h * 128, 512, OM + r0 * 1024 + h * 128, 1024, qb * 256);
        } else {
            const int v = (int)u - NU; const int qb = NQB - 1 - v / 16, bh = v % 16, b = bh >> 2, h = bh & 3; const size_t r0 = (size_t)b * NTOK;
            attn_unit<false>(lds, P + r0 * EVP + EC_SBQ + h * 128, EVP, P + r0 * EVP + EC_SBK + h * 128, EVP, nullptr, P + r0 * EVP + EC_SBV + h * 128, EVP, OM + r0 * 1024 + 512 + h * 128, 1024, qb * 256);
        }
    }
}
}
namespace idx {
__device__ __forceinline__ int crow(int r, int hi) { return (r & 3) + 8 * (r >> 2) + 4 * hi; }
constexpr int KCH = 256;
constexpr int NCH = (NTOK + KCH - 1) / KCH;
constexpr int NITEMS = 17680;
constexpr int NQG = MROWS / 32;

constexpr int SPITCH = 136;
__device__ __forceinline__ unsigned short score_key(float f) { unsigned h; asm volatile("v_cvt_f16_f32 %0, %1" : "=v"(h) : "v"(f)); const int m = ((int)(h << 16)) >> 31; return (unsigned short)(h ^ ((unsigned)m | 0x8000u)); }
__device__ __forceinline__ void phase_indexer(const PArgs& a, LAS unsigned char* lds, int vcu, int G) {
    const int tid = opaque_tid(), lane = tid & 63, wave = __builtin_amdgcn_readfirstlane(tid >> 6), r32 = lane & 31, hh = lane >> 5;
    const int gw = vcu * 8 + wave, NGW = G * 8;
    unsigned char* ws = a.ws;
    const bf16_t* P = (const bf16_t*)(ws + WS_P); unsigned short* SCO = (unsigned short*)(ws + WS_BIG);
    LAS float* wtab = (LAS float*)(lds + wave * 16384);
    LAS unsigned char* stg = lds + wave * 16384 + 1024;
    const int lo = (int)((long)gw * NITEMS / NGW), hi = (int)((long)(gw + 1) * NITEMS / NGW);
    int b = lo / 4420, g = 0, ck = lo % 4420;
#pragma unroll 1
    for (;;) { const int ng_ = (g + 2) / 8 + 1; if (ck < ng_) break; ck -= ng_; ++g; }
    for (int item = lo; item < hi; ) {
        const int nchunk = (g + 2) / 8 + 1; const int take = (hi - item < nchunk - ck) ? hi - item : nchunk - ck;
        const int t0 = g * 32;
        const int lmax = chunk_end(t0 + 31) < NTOK ? chunk_end(t0 + 31) : NTOK;
        const int k0 = ck * KCH;
        const int kend = (k0 + take * KCH < lmax) ? k0 + take * KCH : lmax; const int ntile = (kend - k0 + 31) / 32;
        item += take; ck += take;
        const int b_cur = b, g_done = (ck == nchunk);
        if (g_done) { ck = 0; ++g; if (g == NQG / BATCH) { g = 0; ++b; } }
        const size_t qrow = (size_t)b_cur * NTOK + t0 + r32;
        bf16x8 qa[8][4];
#pragma unroll
        for (int h = 0; h < 8; ++h)
#pragma unroll
            for (int s = 0; s < 4; ++s) qa[h][s] = *(const bf16x8*)(P + qrow * ODP + OC_IQ + h * 64 + s * 16 + hh * 8);
        if (hh == 0) { const u32x4 wv = *(const u32x4*)(P + qrow * ODP + OC_IW);
            const float w8[8] = {bflo(wv.x), bfhi(wv.x), bflo(wv.y), bfhi(wv.y), bflo(wv.z), bfhi(wv.z), bflo(wv.w), bfhi(wv.w)};
#pragma unroll
            for (int h = 0; h < 8; ++h) wtab[h * 32 + r32] = w8[h] * 0.044194173824159216f; }
        LDS_WAIT(); asm volatile("" ::: "memory");
        bf16x8 kb[4], kn[4];
        { const size_t krow = (size_t)b_cur * NTOK + k0 + r32;
#pragma unroll
          for (int s = 0; s < 4; ++s) kb[s] = *(const bf16x8*)(P + krow * ODP + OC_IK + s * 16 + hh * 8); }
        for (int tl = 0; tl < ntile; ++tl) {
            asm volatile("" ::: "memory");
            const int key0 = k0 + 32 * tl;
            { const int kx = (tl + 1 < ntile) ? key0 + 32 : key0; const size_t krow = (size_t)b_cur * NTOK + kx + r32;
#pragma unroll
              for (int s = 0; s < 4; ++s) kn[s] = *(const bf16x8*)(P + krow * ODP + OC_IK + s * 16 + hh * 8); }
            float sc[16];
#pragma unroll
            for (int r = 0; r < 16; ++r) sc[r] = 0.f;
#pragma unroll
            for (int h = 0; h < 8; h += 2) {
                f32x16 xa, xb;
#pragma unroll
                for (int r = 0; r < 16; ++r) { xa[r] = 0.f; xb[r] = 0.f; }
#pragma unroll
                for (int s = 0; s < 4; ++s) { xa = __builtin_amdgcn_mfma_f32_32x32x16_bf16(qa[h][s], kb[s], xa, 0, 0, 0);
                    xb = __builtin_amdgcn_mfma_f32_32x32x16_bf16(qa[h + 1][s], kb[s], xb, 0, 0, 0); SBAR(); }
#pragma unroll
                for (int c = 0; c < 4; ++c) { const f32x4 wa4 = *(const LAS f32x4*)(wtab + h * 32 + 8 * c + 4 * hh), wb4 = *(const LAS f32x4*)(wtab + (h + 1) * 32 + 8 * c + 4 * hh);
#pragma unroll
                    for (int i = 0; i < 4; i += 2) {
                        const int a0 = __float_as_int(xa[4 * c + i]), a1 = __float_as_int(xa[4 * c + i + 1]), b0 = __float_as_int(xb[4 * c + i]), b1 = __float_as_int(xb[4 * c + i + 1]);
                        const f32x2 ra = {__int_as_float(a0 > 0 ? a0 : 0), __int_as_float(a1 > 0 ? a1 : 0)}, rb = {__int_as_float(b0 > 0 ? b0 : 0), __int_as_float(b1 > 0 ? b1 : 0)};
                        const f32x2 wa = {wa4[i], wa4[i + 1]}, wb = {wb4[i], wb4[i + 1]}; f32x2 s2 = {sc[4 * c + i], sc[4 * c + i + 1]};
                        s2 = __builtin_elementwise_fma(wa, ra, s2); s2 = __builtin_elementwise_fma(wb, rb, s2); sc[4 * c + i] = s2[0]; sc[4 * c + i + 1] = s2[1]; } }
            }
            { int cb2 = ((tl & 3) * 32 + r32 + 4 * hh * SPITCH) * 2; asm volatile("" : "+v"(cb2));
#pragma unroll
              for (int r = 0; r < 16; ++r) *(LAS unsigned short*)(stg + cb2 + ((r & 3) + 8 * (r >> 2)) * SPITCH * 2) = score_key(sc[r]); }
            if ((tl & 3) == 3 || tl == ntile - 1) {
                const int ncol = 32 * ((tl & 3) + 1);
                char* gbase = (char*)(SCO + ((size_t)b_cur * NTOK + t0) * NTOK + k0 + 128 * (tl >> 2));
                LDS_WAIT(); asm volatile("" ::: "memory");
                int ln = lane; asm volatile("" : "+v"(ln));
                const int c8 = 8 * (ln & 15); const unsigned goff = (unsigned)((ln >> 4) * NTOK + c8) * 2u; const int soff = ((ln >> 4) * SPITCH + c8) * 2;
                if (c8 < ncol) {
#pragma unroll 1
                    for (int i = 0; i < 8; ++i) { const u32x4 pv = *(const LAS u32x4*)(stg + soff + i * 4 * SPITCH * 2); *(u32x4*)(gbase + goff + (size_t)i * 4 * NTOK * 2) = pv; }
                }
                asm volatile("" ::: "memory");
            }
#pragma unroll
            for (int s = 0; s < 4; ++s) kb[s] = kn[s];
        }
        LDS_WAIT(); asm volatile("" ::: "memory");
    }
}

__device__ __forceinline__ int t5_bucket(int rel) {
    const int base = rel > 0 ? 16 : 0; const int n = rel < 0 ? -rel : rel;
    if (n < 8) return base + n;
    int large = 8 + (31 - __builtin_clz((unsigned)(n * n))) - 6; large = large < 15 ? large : 15;
    return base + large;
}
__device__ __forceinline__ unsigned ord_key(float f) { const unsigned u = __float_as_uint(f); return (u & 0x80000000u) ? ~u : (u | 0x80000000u); }

constexpr int VPITCH = 272;
template <int OFF> __device__ __forceinline__ s16x4 tr_read_i(int vb) { s16x4 r; asm volatile("ds_read_b64_tr_b16 %0, %1 offset:%2" : "=&v"(r) : "v"(vb), "i"(OFF) : "memory"); return r; }
__device__ __forceinline__ void pv_chunk(f32x4 (&oc)[8], int vb, bf16x8 pa) {
    s16x4 lo[8], hi[8];
#define PV_RD(d) lo[d] = tr_read_i<(d) * 32>(vb); hi[d] = tr_read_i<(d) * 32 + 16 * VPITCH>(vb)
    PV_RD(0); PV_RD(1); PV_RD(2); PV_RD(3); PV_RD(4); PV_RD(5); PV_RD(6); PV_RD(7);
#undef PV_RD
    asm volatile("s_waitcnt lgkmcnt(0)" ::: "memory"); SBAR();
#pragma unroll
    for (int d = 0; d < 8; ++d) { const bf16x8 vf = {lo[d][0], lo[d][1], lo[d][2], lo[d][3], hi[d][0], hi[d][1], hi[d][2], hi[d][3]};
        oc[d] = __builtin_amdgcn_mfma_f32_16x16x32_bf16(pa, vf, oc[d], 0, 0, 0); }
}
__device__ __forceinline__ void phase_select_attend(const PArgs& a, LAS unsigned char* lds, int vcu, int G) {
    const int tid = opaque_tid(), lane = tid & 63, wave = __builtin_amdgcn_readfirstlane(tid >> 6);
    const int gw = vcu * 8 + wave, NGW = G * 8;
    unsigned char* ws = a.ws;
    const bf16_t* P = (const bf16_t*)(ws + WS_P); const unsigned short* SCO = (const unsigned short*)(ws + WS_BIG); unsigned char* OM = ws + WS_OM;
    LAS unsigned char* wl = lds + wave * 16384;
    LAS unsigned* hist = (LAS unsigned*)wl;
    LAS unsigned long long* cand = (LAS unsigned long long*)wl;
    LAS unsigned* hist2 = (LAS unsigned*)(wl + 8704);
    LAS unsigned long long* cand2 = (LAS unsigned long long*)(wl + 9728);
    LAS int* bkt = (LAS int*)(wl + 13312);
    LAS float* btab = (LAS float*)(wl + 14336);
    LAS int* sel = (LAS int*)(wl + 15360);
    constexpr int CAP = 1024, CAP2 = 448;
    const unsigned long long lt_mask = (1ull << lane) - 1ull;
    const int hn = lane & 15, g4 = lane >> 4;
    const int vwr = (int)(uintptr_t)wl + (g4 * VPITCH + hn * 16);
    const int vrd = (int)(uintptr_t)wl + ((4 * g4 + (hn >> 2)) * VPITCH + (hn & 3) * 8);
    { const f32x4 tv = *(const f32x4*)(a.in(I_REL) + 4 * lane); *(LAS f32x4*)(btab + 4 * lane) = tv; }
    LDS_WAIT(); asm volatile("" ::: "memory");
#define APPEND(flag, list, count, value) do { const unsigned long long b_ = __ballot(flag); if (flag) (list)[(count) + (int)__builtin_popcountll(b_ & lt_mask)] = (value); (count) += (int)__builtin_popcountll(b_); } while (0)
#define RANK_TAKE(lst, n, nd) do { _Pragma("unroll 1") for (int j0_ = 0; j0_ < (n); j0_ += 64) { const int j_ = j0_ + lane; const bool act_ = j_ < (n); \
        const unsigned long long kj_ = act_ ? (lst)[j_] : 0ull; int rank_ = 0; \
        _Pragma("unroll 4") for (int k_ = 0; k_ < (n); ++k_) rank_ += ((lst)[k_] > kj_) ? 1 : 0; \
        const bool take_ = act_ && rank_ < (nd); APPEND(take_, sel, base, (int)(0xFFFFFFFFu - (unsigned)kj_)); } } while (0)
    const bool paired = (G % 8 == 0); const int cpx = paired ? G / 8 : 1;
    const int nwl = paired ? 16 * cpx : NGW; const int wl0 = paired ? ((vcu / cpx) & 1) * 8 * cpx + (vcu % cpx) * 8 + wave : gw;
    const int qend = paired ? NTOK : MROWS;
    for (int qq = wl0; qq < qend; qq += nwl) {
        const int qi = paired ? (vcu / (2 * cpx)) * NTOK + qq : qq;
        const int b = qi / NTOK, t = qi % NTOK; const size_t row = (size_t)b * NTOK + t;
        const int L = chunk_end(t) < NTOK ? chunk_end(t) : NTOK;
        const bf16_t* Pb = P + (size_t)b * NTOK * ODP;
        int nsel;
        if (L <= 256) {
            nsel = L;
#pragma unroll
            for (int i = 0; i < 4; ++i) sel[64 * i + lane] = 64 * i + lane;
        } else {
            nsel = 256;
            const unsigned short* srow = SCO + row * NTOK;
            unsigned zz = 0u; asm volatile("" : "+v"(zz));
            int sh = 16; unsigned pfx = 0u; int need = 256; unsigned cbin = 0u;
#define CHUNK_LOAD(dst, c0_) do { int l8_ = 8 * lane; asm volatile("" : "+v"(l8_)); _Pragma("unroll") for (int k = 0; k < 8; ++k) { const int idx_ = (c0_) + 512 * k + l8_; dst[k] = __builtin_nontemporal_load((const u32x4*)(srow + (idx_ < L ? idx_ : 0))); } } while (0)
#define KEY16(w, c) (((c) & 1) ? ((w)[(c) >> 1] >> 16) : ((w)[(c) >> 1] & 0xffffu))
#pragma unroll 1
            for (;;) {
                const int nb = sh >= 11 ? 11 : sh; const int nsh = sh - nb; const unsigned dmask = (1u << nb) - 1u; const bool first = (sh == 16); const unsigned pv0 = first ? 0u : (pfx >> sh);
#pragma unroll 1
                for (int i = 0; i < 8; ++i) *(LAS u32x4*)(wl + i * 1024 + lane * 16) = (u32x4){zz, zz, zz, zz};
                u32x4 v[8];
                LDS_WAIT(); asm volatile("" ::: "memory");
#pragma unroll 1
                for (int c0 = 0; c0 < L; c0 += 4096) {
                    CHUNK_LOAD(v, c0); asm volatile("" ::: "memory"); SBAR();
                    int l8 = 8 * lane; asm volatile("" : "+v"(l8));
#pragma unroll
                    for (int k = 0; k < 8; ++k) { const bool ok = (c0 + 512 * k + l8) < L;
#pragma unroll
                        for (int c = 0; c < 8; ++c) { const unsigned u = KEY16(v[k], c); const bool match = ok && (first || ((u >> sh) == pv0));
                            if (match) __hip_atomic_fetch_add(hist + ((u >> nsh) & dmask), 1u, __ATOMIC_RELAXED, __HIP_MEMORY_SCOPE_WORKGROUP); } }
                }
                LDS_WAIT(); asm volatile("" ::: "memory");
                unsigned loc = 0u;
#pragma unroll
                for (int i = 0; i < 8; ++i) { const u32x4 h4 = *(const LAS u32x4*)(hist + 32 * lane + 4 * i); loc += (h4.x + h4.y) + (h4.z + h4.w); }
                unsigned above = loc;
#pragma unroll
                for (int o = 1; o < 64; o <<= 1) { const unsigned vv = __shfl_down(above, o); if (lane + o < 64) above += vv; }
                const unsigned excl = above - loc;
                const bool mine = (excl < (unsigned)need) && ((unsigned)need <= above);
                const unsigned long long bal = __ballot(mine);
                const int owner = (int)__builtin_ctzll(bal ? bal : 1ull);
                unsigned run = excl; int bsel = 0; unsigned abv = excl, cb = 0u; bool found = false;
#pragma unroll 1
                for (int i = 7; i >= 0; --i) { const u32x4 h4 = *(const LAS u32x4*)(hist + 32 * lane + 4 * i); const unsigned hv[4] = {h4.x, h4.y, h4.z, h4.w};
#pragma unroll
                    for (int k = 3; k >= 0; --k) { const unsigned nr = run + hv[k]; const bool hit = !found && (nr >= (unsigned)need); bsel = hit ? 4 * i + k : bsel; abv = hit ? run : abv; cb = hit ? hv[k] : cb; found = found || hit; run = nr; } }
                const unsigned bin = (unsigned)__shfl(32 * lane + bsel, owner); const unsigned abv_b = (unsigned)__shfl((int)abv, owner); cbin = (unsigned)__shfl((int)cb, owner);
                pfx |= bin << nsh; need -= (int)abv_b; sh = nsh;
                if (cbin <= (unsigned)CAP || sh == 0) break;
            }
            const bool alleq = (sh == 0) && (cbin > (unsigned)CAP);
            const unsigned pv = pfx >> sh;
            int base = 0, ccount = 0;
            if (!alleq) {
                { u32x4 v[8];
#pragma unroll 1
                for (int c0 = 0; c0 < L; c0 += 4096) {
                    CHUNK_LOAD(v, c0); asm volatile("" ::: "memory"); SBAR();
                    int l8 = 8 * lane; asm volatile("" : "+v"(l8));
#pragma unroll
                    for (int k = 0; k < 8; ++k) { const int idx = c0 + 512 * k + l8; const bool ok = idx < L;
#pragma unroll
                        for (int c = 0; c < 8; ++c) { const unsigned u = KEY16(v[k], c); const unsigned hi = u >> sh;
                            const bool sure = ok && hi > pv, isc = ok && hi == pv;
                            const unsigned long long bt = __ballot(sure), bc = __ballot(isc);
                            if (bt | bc) {
                                if (sure) sel[base + (int)__builtin_popcountll(bt & lt_mask)] = idx + c;
                                if (isc) cand[ccount + (int)__builtin_popcountll(bc & lt_mask)] = ((unsigned long long)u << 32) | (unsigned long long)(0xFFFFFFFFu - (unsigned)(idx + c));
                                base += (int)__builtin_popcountll(bt); ccount += (int)__builtin_popcountll(bc); } } }
                } }
                LDS_WAIT(); asm volatile("" ::: "memory");
                bool done = false;
                if (sh >= 8 && ccount > 64) {
                    *(LAS u32x4*)(hist2 + 4 * lane) = (u32x4){zz, zz, zz, zz};
                    LDS_WAIT(); asm volatile("" ::: "memory");
                    const int s2 = 32 + sh - 8;
#pragma unroll 1
                    for (int j0 = 0; j0 < ccount; j0 += 64) { const int j = j0 + lane; if (j < ccount) __hip_atomic_fetch_add(hist2 + (unsigned)((cand[j] >> s2) & 255ull), 1u, __ATOMIC_RELAXED, __HIP_MEMORY_SCOPE_WORKGROUP); }
                    LDS_WAIT(); asm volatile("" ::: "memory");
                    const u32x4 h4 = *(const LAS u32x4*)(hist2 + 4 * lane); const unsigned loc2 = (h4.x + h4.y) + (h4.z + h4.w);
                    unsigned ab2 = loc2;
#pragma unroll
                    for (int o = 1; o < 64; o <<= 1) { const unsigned vv = __shfl_down(ab2, o); if (lane + o < 64) ab2 += vv; }
                    const unsigned ex2 = ab2 - loc2; const bool mine2 = (ex2 < (unsigned)need) && ((unsigned)need <= ab2);
                    const unsigned long long bal2 = __ballot(mine2); const int own2 = (int)__builtin_ctzll(bal2 ? bal2 : 1ull);
                    unsigned run2 = ex2; int bs2 = 0; unsigned av2 = ex2, cb2 = 0u; bool f2 = false; const unsigned hv2[4] = {h4.x, h4.y, h4.z, h4.w};
#pragma unroll
                    for (int k = 3; k >= 0; --k) { const unsigned nr = run2 + hv2[k]; const bool hit = !f2 && (nr >= (unsigned)need); bs2 = hit ? k : bs2; av2 = hit ? run2 : av2; cb2 = hit ? hv2[k] : cb2; f2 = f2 || hit; run2 = nr; }
                    const unsigned bin2 = (unsigned)__shfl(4 * lane + bs2, own2); const unsigned abv2 = (unsigned)__shfl((int)av2, own2); const unsigned cnt2 = (unsigned)__shfl((int)cb2, own2);
                    if (cnt2 <= (unsigned)CAP2) {
                        int c2 = 0;
#pragma unroll 1
                        for (int j0 = 0; j0 < ccount; j0 += 64) { const int j = j0 + lane; const bool act = j < ccount; const unsigned long long kj = act ? cand[j] : 0ull;
                            const unsigned sub = (unsigned)((kj >> s2) & 255ull); const bool sure2 = act && sub > bin2, isc2 = act && sub == bin2;
                            APPEND(sure2, sel, base, (int)(0xFFFFFFFFu - (unsigned)kj));
                            APPEND(isc2, cand2, c2, kj); }
                        LDS_WAIT(); asm volatile("" ::: "memory");
                        const int need2 = need - (int)abv2;
                        RANK_TAKE(cand2, c2, need2);
                        done = true;
                    }
                }
                if (!done) RANK_TAKE(cand, ccount, need);
            } else {
#pragma unroll 2
                for (int i0 = 0; i0 < L; i0 += 64) { const int s = i0 + lane; const bool valid = s < L;
                    const unsigned u = valid ? (unsigned)srow[s < L ? s : L - 1] : 0u;
                    const bool sure = valid && u > pv, isc = valid && u == pv;
                    const unsigned long long bc = __ballot(isc); const int crank = ccount + (int)__builtin_popcountll(bc & lt_mask);
                    const bool take = sure || (isc && crank < need);
                    ccount += (int)__builtin_popcountll(bc);
                    APPEND(take, sel, base, s); }
            }
#undef CHUNK_LOAD
#undef KEY16
        }
        LDS_WAIT(); asm volatile("" ::: "memory");
#pragma unroll
        for (int i = 0; i < 4; ++i) { const int jj = 64 * i + lane; bkt[jj] = t5_bucket(((jj < nsel) ? sel[jj] : t) - t) * 8; }
        bf16x8 qb[4];
#pragma unroll
        for (int kk = 0; kk < 4; ++kk) { bf16x8 z = {0, 0, 0, 0, 0, 0, 0, 0}; qb[kk] = (hn < 8) ? *(const bf16x8*)(P + row * ODP + OC_Q + hn * 128 + kk * 32 + g4 * 8) : z; }
        f32x4 sa[16];
#pragma unroll
        for (int tb = 0; tb < 4; ++tb) {
            bf16x8 ka[4][4]; int hno = hn; asm volatile("" : "+v"(hno));
#pragma unroll
            for (int u = 0; u < 4; ++u) { const int jj = 16 * (4 * tb + u) + hno; const int key = (jj < nsel) ? sel[jj] : 0; const unsigned koff = (unsigned)(key * ODP + OC_K + g4 * 8) * 2u;
#pragma unroll
                for (int kk = 0; kk < 4; ++kk) ka[u][kk] = *(const bf16x8*)((const char*)Pb + koff + kk * 64); }
            asm volatile("" ::: "memory"); SBAR();
#pragma unroll
            for (int u = 0; u < 4; ++u) { f32x4 acc = {0.f, 0.f, 0.f, 0.f};
#pragma unroll
                for (int kk = 0; kk < 4; ++kk) acc = __builtin_amdgcn_mfma_f32_16x16x32_bf16(ka[u][kk], qb[kk], acc, 0, 0, 0);
                sa[4 * tb + u] = acc; }
            asm volatile("" ::: "memory");
        }
        bf16x8 vr0[8], vr1[8];
#define V_LOAD(dst, c) do { int g4o_ = g4; asm volatile("" : "+v"(g4o_)); _Pragma("unroll") for (int i_ = 0; i_ < 8; ++i_) { const int jj_ = 32 * (c) + g4o_ + 4 * i_; const int key_ = (jj_ < nsel) ? sel[jj_] : 0; \
            dst[i_] = *(const bf16x8*)((const char*)Pb + (unsigned)(key_ * ODP + OC_V + hn * 8) * 2u); } } while (0)
#define V_WRITE(src) do { _Pragma("unroll") for (int i_ = 0; i_ < 8; ++i_) *(LAS bf16x8*)(uintptr_t)(vwr + 4 * i_ * VPITCH) = src[i_]; } while (0)
        V_LOAD(vr0, 0); V_LOAD(vr1, 1);
        float mx = -1e30f; int g4b = 4 * g4; asm volatile("" : "+v"(g4b));
#pragma unroll
        for (int tl = 0; tl < 16; ++tl) { const i32x4 b4 = *(const LAS i32x4*)(bkt + 16 * tl + 4 * g4); const int bb[4] = {b4.x, b4.y, b4.z, b4.w};
#pragma unroll
            for (int i = 0; i < 4; ++i) { const int jj = 16 * tl + g4b + i; const bool ok = jj < nsel;
                const float bias = btab[bb[i] + (hn & 7)];
                const float s = ok ? sa[tl][i] * 0.088388347648318440f + bias : -1e30f; sa[tl][i] = s; mx = fmaxf(mx, s); } }
        mx = fmaxf(mx, __shfl_xor(mx, 16)); mx = fmaxf(mx, __shfl_xor(mx, 32));
        float sum = 0.f;
#pragma unroll
        for (int tl = 0; tl < 16; ++tl)
#pragma unroll
            for (int i = 0; i < 4; ++i) { const float p = __builtin_amdgcn_exp2f((sa[tl][i] - mx) * 1.4426950408889634f); sa[tl][i] = p; sum += p; }
        sum += __shfl_xor(sum, 16); sum += __shfl_xor(sum, 32);
        const float rs = 1.0f / sum;
        f32x4 oc[8];
#pragma unroll
        for (int d = 0; d < 8; ++d) oc[d] = (f32x4){0.f, 0.f, 0.f, 0.f};
#define PV_CHUNK(c, cur) do { \
            if ((c) + 1 < 8) asm volatile("s_waitcnt vmcnt(8)" ::: "memory"); else asm volatile("s_waitcnt vmcnt(0)" ::: "memory"); \
            V_WRITE(cur); if ((c) + 2 < 8) V_LOAD(cur, (c) + 2); \
            const f32x4 pa_ = sa[2 * (c)] * rs, pb_ = sa[2 * (c) + 1] * rs; \
            u32x4 pw; pw.x = cvtpk(pa_[0], pa_[1]); pw.y = cvtpk(pa_[2], pa_[3]); pw.z = cvtpk(pb_[0], pb_[1]); pw.w = cvtpk(pb_[2], pb_[3]); \
            const bf16x8 pf = __builtin_bit_cast(bf16x8, pw); \
            LDS_WAIT(); asm volatile("" ::: "memory"); \
            pv_chunk(oc, vrd, pf); } while (0)
        PV_CHUNK(0, vr0); PV_CHUNK(1, vr1); PV_CHUNK(2, vr0); PV_CHUNK(3, vr1); PV_CHUNK(4, vr0); PV_CHUNK(5, vr1); PV_CHUNK(6, vr0); PV_CHUNK(7, vr1);
#undef PV_CHUNK
#undef V_LOAD
#undef V_WRITE
        if (g4 < 2) {
#pragma unroll
            for (int dt = 0; dt < 8; ++dt)
#pragma unroll
                for (int i = 0; i < 4; ++i) OM[row * 1024 + (4 * g4 + i) * 128 + 16 * dt + hn] = om_fp8(oc[dt][i]);
        }
        LDS_WAIT(); asm volatile("" ::: "memory");
    }
#undef APPEND
#undef RANK_TAKE
}
}
typedef __attribute__((address_space(1))) unsigned char gu8_t;
#define PH_ARGS const KArgs& ka, unsigned lds_off
#define PH_SETUP PArgs a{ka, opaque_ws(ka.ws)}; LAS unsigned char* lds = (LAS unsigned char*)(uintptr_t)lds_off; unsigned char* ws = a.ws; (void)ws; (void)lds; \
    int G_ = gridDim.x, bx_ = blockIdx.x; asm volatile("" : "+s"(G_), "+s"(bx_)); const int G = G_, bx = bx_; const int vcu = (G % 8 == 0) ? (bx % 8) * (G / 8) + bx / 8 : bx; (void)vcu

__device__ __forceinline__ void ph_prologue(PH_ARGS) { PH_SETUP; phase_prologue(a, lds, vcu, G); }
__device__ __forceinline__ void ph_inproj(PH_ARGS, int layer) { PH_SETUP;
    const int jl = layer >> 1; const bool even = (layer & 1) == 0; const int N = even ? EVP : ODP;
    const bf16_t* Bt = even ? (const bf16_t*)(ws + WS_WINE + jl * SZ_WINE) : (const bf16_t*)(ws + WS_WINO + jl * SZ_WINO);
    pg8::DenseOrder S; S.init(MROWS, N, G, bx);
    pg8::EpiBf16 E{(bf16_t*)(ws + WS_P), N, 1.0f / FP8_WSCALE};
    pg8::gemm_phase<pg8::EpiBf16, pg8::DenseOrder, true>(lds, (const bf16_t*)(ws + WS_HB8), DM / 2, Bt, DM / 2, S, E);
}
__device__ __forceinline__ void ph_latent(PH_ARGS, int jl) { PH_SETUP; phase_latent_norm(a, jl, vcu, G); }
__device__ __forceinline__ void ph_upq(PH_ARGS, int jl) { PH_SETUP;
    pg8::DenseOrder S; S.init(MROWS, 768, G, bx);
    pg8::EpiQ E{(bf16_t*)(ws + WS_QM), (const float*)(ws + WS_ROPE)};
    pg8::gemm_phase<pg8::EpiQ, pg8::DenseOrder>(lds, (const bf16_t*)(ws + WS_QN), 512, (const bf16_t*)(ws + WS_WUQ + jl * SZ_WUQ), 512, S, E);
}
__device__ __forceinline__ void ph_upkv(PH_ARGS, int jl) { PH_SETUP;
    pg8::DenseOrder S; S.init(MROWS, 1024, G, bx);
    pg8::EpiKV E{(bf16_t*)(ws + WS_KN), (bf16_t*)(ws + WS_VM)};
    pg8::gemm_phase<pg8::EpiKV, pg8::DenseOrder>(lds, (const bf16_t*)(ws + WS_KVN), 256, (const bf16_t*)(ws + WS_WUKV + jl * SZ_WUKV), 256, S, E);
}
__device__ __forceinline__ void ph_attn(PH_ARGS, int layer) { PH_SETUP; att::phase_attention(a, lds, layer); }
__device__ __forceinline__ void ph_indexer(PH_ARGS) { PH_SETUP; idx::phase_indexer(a, lds, vcu, G); }
__device__ __forceinline__ void ph_select(PH_ARGS) { PH_SETUP; idx::phase_select_attend(a, lds, vcu, G); }
__device__ __forceinline__ void ph_outproj(PH_ARGS, int layer) { PH_SETUP;
    const int jl = layer >> 1; const bool even = (layer & 1) == 0;
    const bf16_t* Bt = even ? (const bf16_t*)(ws + WS_WOUTE + jl * SZ_WOUT) : (const bf16_t*)(ws + WS_WOUTO + jl * SZ_WOUT);
    pg8::DenseOrder S; S.init(MROWS, DM, G, bx);
    pg8::EpiOut E{(const bf16_t*)(ws + WS_HB), (bf16_t*)(ws + WS_Y), (float*)(ws + WS_STAT)};
    pg8::gemm_phase<pg8::EpiOut, pg8::DenseOrder, true>(lds, (const bf16_t*)(ws + WS_OM), 1024 / 2, Bt, 1024 / 2, S, E);
}
__device__ __forceinline__ void ph_lnroute(PH_ARGS, int layer, int cslot) { PH_SETUP; phase_ln_route(a, layer, cslot, lds, vcu, G); }
__device__ __forceinline__ void ph_expert_up(PH_ARGS, int layer) { PH_SETUP;
    const unsigned* cnt = (const unsigned*)(ws + WS_CTL) + CW_CNT + 2048 * layer; LAS int* tstart = (LAS int*)(lds + TBL_OFF);
    build_tile_table(cnt, tstart);
    pg8::MoeOrder S{tstart, cnt, (const int*)(ws + WS_ROWTOK), 4, G, vcu, true, false};
    pg8::EpiSwiglu E{(bf16_t*)(ws + WS_ACT), a.in(I_EBIN) + (size_t)layer * NEXP * 1024};
    pg8::gemm_phase<pg8::EpiSwiglu, pg8::MoeOrder, true>(lds, (const bf16_t*)(ws + WS_HB8), DM / 2, (const bf16_t*)(ws + WS_WEI + (size_t)layer * NEXP * SZ_WEI), DM / 2, S, E);
}
__device__ __forceinline__ void ph_expert_down(PH_ARGS, int layer) { PH_SETUP;
    const unsigned* cnt = (const unsigned*)(ws + WS_CTL) + CW_CNT + 2048 * layer; LAS int* tstart = (LAS int*)(lds + TBL_OFF);
    pg8::MoeOrder S{tstart, cnt, (const int*)(ws + WS_ROWTOK), 8, G, vcu, false, false};
    pg8::EpiDown E{(unsigned char*)(ws + WS_YEXP), a.in(I_EBOUT) + (size_t)layer * NEXP * DM};
    pg8::gemm_phase<pg8::EpiDown, pg8::MoeOrder, true>(lds, (const bf16_t*)(ws + WS_ACT), DFF / 2, (const bf16_t*)(ws + WS_WEO + (size_t)layer * NEXP * SZ_WEO), DFF / 2, S, E);
}
__device__ __forceinline__ void ph_combine(PH_ARGS, int layer, bool dummy) { PH_SETUP;
    if (layer == DEPTH - 1) phase_combine_ln<true>(a, layer, (const LAS int*)(lds + TBL_OFF), vcu, G, dummy); else phase_combine_ln<false>(a, layer, (const LAS int*)(lds + TBL_OFF), vcu, G, dummy); }

__global__ void __launch_bounds__(512, 2) mk_fwd(KArgs a) {
    extern __shared__ __attribute__((aligned(16))) unsigned char lds_raw[];
    LAS unsigned char* lds = (LAS unsigned char*)lds_raw;
    const int tid = threadIdx.x;
    for (int u = tid; u < (LDS_BYTES - LDS_CTL) / 4; u += 512) ((LAS unsigned*)(lds + LDS_CTL))[u] = 0u;
    __syncthreads();
    const unsigned lo = (unsigned)(uintptr_t)lds;
    gu32_t* barw = (gu32_t*)(a.ws + WS_CTL) + CW_BAR; const unsigned st_off = lo + MISC_OFF + 32;
    const unsigned xcc = xcd_barrier_post((unsigned*)barw, (volatile LAS unsigned*)(uintptr_t)st_off).x;
#define GRID_BAR() xcd_barrier(barw, xcc, st_off)

    ph_prologue(a, lo);
    GRID_BAR();
#pragma unroll 1
    for (int layer = 0; layer < DEPTH; ++layer) {
        const int jl = layer >> 1; const bool even = (layer & 1) == 0;
        ph_inproj(a, lo, layer);
        GRID_BAR();
        if (even) {
            ph_latent(a, lo, jl);
            GRID_BAR();
            ph_upq(a, lo, jl);
            ph_upkv(a, lo, jl);
            GRID_BAR();
            ph_attn(a, lo, layer);
            GRID_BAR();
        } else {
            ph_indexer(a, lo);
            GRID_BAR();
            ph_select(a, lo);
            GRID_BAR();
        }
        ph_outproj(a, lo, layer);
        GRID_BAR();
        ph_lnroute(a, lo, layer, layer);
        GRID_BAR();
        ph_expert_up(a, lo, layer);
        GRID_BAR();
        ph_expert_down(a, lo, layer);
        GRID_BAR();
        ph_combine(a, lo, layer, false);
        if (layer + 1 < DEPTH) GRID_BAR();
    }
}

extern "C" void kernel_launch(void* const* d_in, const int* in_sizes, int n_in, void* d_out, int out_size, void* d_ws, size_t ws_size, hipStream_t stream) {
    static int grid = 0;
    if (grid == 0) {
        if (n_in != 19 || ws_size < WS_END) { fprintf(stderr, "kernel_launch: n_in %d (want 19), ws %zu (need %zu)\n", n_in, ws_size, (size_t)WS_END); grid = -1; return; }
        int dev = 0, cus = 0, per_cu = 0;
        if (hipGetDevice(&dev) != hipSuccess || hipDeviceGetAttribute(&cus, hipDeviceAttributeMultiprocessorCount, dev) != hipSuccess) { grid = -1; return; }
        if (hipFuncSetAttribute((const void*)mk_fwd, hipFuncAttributeMaxDynamicSharedMemorySize, LDS_BYTES) != hipSuccess) { fprintf(stderr, "kernel_launch: hipFuncSetAttribute failed\n"); grid = -1; return; }
        if (hipOccupancyMaxActiveBlocksPerMultiprocessor(&per_cu, (const void*)mk_fwd, 512, LDS_BYTES) != hipSuccess || per_cu < 1)
            fprintf(stderr, "kernel_launch: occupancy query reports %d workgroups per CU\n", per_cu);
        (void)hipGetLastError();
        grid = cus > 0 ? cus : 256;
    }
    if (grid < 0) return;
    if (hipMemsetAsync((char*)d_ws + WS_CTL, 0, CTL_BYTES, stream) != hipSuccess) return;
    KArgs a{};
    for (int i = 0; i < 19; ++i) a.in[i] = (const float*)d_in[i];
    a.out = (float*)d_out; a.ws = (unsigned char*)d_ws;
    hipLaunchKernelGGL(mk_fwd, dim3(grid), dim3(512), LDS_BYTES, stream, a);
    (void)hipPeekAtLastError();
}
```

```cpp
#include <hip/hip_runtime.h>
#include <cstdio>
#include <cstdint>

#define LAS __attribute__((address_space(3)))
typedef unsigned short bf16_t;
typedef short bf16x8 __attribute__((ext_vector_type(8)));
typedef short s16x4 __attribute__((ext_vector_type(4)));
typedef float f32x2 __attribute__((ext_vector_type(2)));
typedef float f32x4 __attribute__((ext_vector_type(4)));
typedef float f32x16 __attribute__((ext_vector_type(16)));
typedef unsigned u32x2 __attribute__((ext_vector_type(2)));
typedef unsigned u32x4 __attribute__((ext_vector_type(4)));
typedef int i32x4 __attribute__((ext_vector_type(4)));

constexpr int BATCH = 4, NTOK = 8320, MROWS = BATCH * NTOK, DM = 2048, SEQ = 8192, NMETA = 16, DEPTH = 4;
constexpr int NEXP = 32, DFF = 512;
constexpr float DN_ALPHA = 1.6817928305074290f;
constexpr float LN_EPS = 1e-5f, RMS_EPS = 1e-6f;
constexpr int EVP = 2560;
constexpr int ODP = 2048;
constexpr int MAXSLOT = MROWS * 4 + NEXP * 256;
constexpr int EC_QLAT = 0, EC_KVLAT = 512, EC_SBQ = 768, EC_SBK = 1280, EC_SBV = 1792, EC_KROPE = 2304;
constexpr int OC_Q = 0, OC_K = 1024, OC_V = 1152, OC_IQ = 1280, OC_IK = 1792, OC_IW = 1856;

constexpr size_t MiB = 1u << 20;
constexpr size_t alignup(size_t x) { return (x + 4095) & ~(size_t)4095; }
constexpr size_t WS_CTL = 0, CTL_BYTES = 1 * MiB;
constexpr size_t SZ_WINE = (size_t)EVP * DM * 2, SZ_WUQ = 768 * 512 * 2, SZ_WUKV = 1024 * 256 * 2, SZ_WOUT = (size_t)DM * 1024 * 2, SZ_WINO = (size_t)ODP * DM * 2;
constexpr size_t SZ_WEI = (size_t)1024 * DM, SZ_WEO = (size_t)DM * DFF  , SZ_WR = (size_t)32 * DM * 2;
constexpr size_t WS_WINE = WS_CTL + CTL_BYTES;
constexpr size_t WS_WUQ = WS_WINE + 2 * SZ_WINE;
constexpr size_t WS_WUKV = WS_WUQ + 2 * SZ_WUQ;
constexpr size_t WS_WOUTE = WS_WUKV + 2 * SZ_WUKV;
constexpr size_t WS_WINO = WS_WOUTE + 2 * SZ_WOUT;
constexpr size_t WS_WOUTO = WS_WINO + 2 * SZ_WINO;
constexpr size_t WS_WEI = WS_WOUTO + 2 * SZ_WOUT;
constexpr size_t WS_WEO = WS_WEI + (size_t)DEPTH * NEXP * SZ_WEI;
constexpr size_t WS_WRH = WS_WEO + (size_t)DEPTH * NEXP * SZ_WEO;
constexpr size_t WS_WRL = WS_WRH + DEPTH * SZ_WR;
constexpr size_t WS_ROPE = WS_WRL + DEPTH * SZ_WR;
constexpr size_t WS_H = alignup(WS_ROPE + (size_t)NTOK * 64 * 4);
constexpr size_t WS_HB8 = WS_H;
constexpr size_t WS_HB = WS_H + (size_t)MROWS * DM * 4;
constexpr size_t WS_Y = WS_HB + (size_t)MROWS * DM * 2;
constexpr size_t WS_STAT = WS_Y + (size_t)MROWS * DM * 4;
constexpr size_t WS_P = WS_STAT + (size_t)MROWS * 64 * 4;
constexpr size_t WS_QN = WS_P + (size_t)MROWS * EVP * 2;
constexpr size_t WS_KVN = WS_QN + (size_t)MROWS * 512 * 2;
constexpr size_t WS_QM = WS_KVN + (size_t)MROWS * 256 * 2;
constexpr size_t WS_KN = WS_QM + (size_t)MROWS * 768 * 2;
constexpr size_t WS_VM = WS_KN + (size_t)MROWS * 512 * 2;
constexpr size_t WS_KR = WS_VM + (size_t)MROWS * 512 * 2;
constexpr size_t WS_OM = WS_KR + (size_t)MROWS * 64 * 2;
constexpr size_t WS_TOPE = WS_OM + (size_t)MROWS * 1024 * 2;
constexpr size_t WS_TOPP = WS_TOPE + (size_t)MROWS * 16;
constexpr size_t WS_TOPG = WS_TOPP + (size_t)MROWS * 16;
constexpr size_t WS_ROWTOK = WS_TOPG + (size_t)MROWS * 16;
constexpr size_t WS_BIG = alignup(WS_ROWTOK + (size_t)NEXP * MROWS * 4);
constexpr size_t SZ_SCORES = (size_t)BATCH * NTOK * NTOK * 4;
constexpr size_t WS_ACT = WS_BIG, WS_YEXP = WS_BIG + alignup((size_t)MAXSLOT * DFF * 2);
constexpr size_t WS_END = WS_BIG + SZ_SCORES;
static_assert(WS_YEXP + (size_t)MAXSLOT * DM * 2 <= WS_END, "alias region");
constexpr size_t WS_ARGTAB = 512 * 1024;
constexpr int CW_BAR = 4096, CW_CNT = 16384  , CW_Q = 32768  , CW_ERR = 65536;

constexpr int LDS_BYTES = 147456, LDS_CTL = 131072, MISC_OFF = LDS_CTL + 320, TBL_OFF = LDS_CTL + 1024;

#define LDS_WAIT() asm volatile("s_waitcnt lgkmcnt(0)" ::: "memory")
#define VM_WAIT() asm volatile("s_waitcnt vmcnt(0)" ::: "memory")
#define SBAR() __builtin_amdgcn_sched_barrier(0)

__device__ __forceinline__ unsigned cvtpk(float lo, float hi) { unsigned r; asm volatile("v_cvt_pk_bf16_f32 %0, %1, %2" : "=v"(r) : "v"(lo), "v"(hi)); return r; }
typedef int i32x8 __attribute__((ext_vector_type(8)));
__device__ __forceinline__ unsigned cvt4_fp8(float a, float b, float c, float d) { int w = __builtin_amdgcn_cvt_pk_fp8_f32(a, b, 0, false); w = __builtin_amdgcn_cvt_pk_fp8_f32(c, d, w, true); return (unsigned)w; }
constexpr float OM_SCALE = 64.0f;
__device__ __forceinline__ unsigned char om_fp8(float v) { v = fminf(fmaxf(v * OM_SCALE, -448.0f), 448.0f); return (unsigned char)(__builtin_amdgcn_cvt_pk_fp8_f32(v, v, 0, false) & 0xff); }
constexpr float FP8_WSCALE = 32.0f;
__device__ __forceinline__ float bf2f(unsigned short b) { return __uint_as_float(((unsigned)b) << 16); }
__device__ __forceinline__ float bflo(unsigned w) { return __uint_as_float(w << 16); }
__device__ __forceinline__ float bfhi(unsigned w) { return __uint_as_float(w & 0xffff0000u); }
__device__ __forceinline__ float wave_sum(float v) {
#pragma unroll
    for (int o = 1; o < 64; o <<= 1) v += __shfl_xor(v, o);
    return v;
}
typedef __attribute__((address_space(1))) unsigned char gu8_t;
__device__ __forceinline__ int opaque_tid() { int t = (int)threadIdx.x; asm volatile("" : "+v"(t)); return t; }
__device__ __forceinline__ unsigned char* opaque_ws(unsigned char* p) { size_t z = 0; asm volatile("" : "+s"(z)); return p + z; }
__device__ __forceinline__ int chunk_end(int t) { return t < NMETA ? NMETA : NMETA + 64 * ((t - NMETA) / 64 + 1); }

#define XB_TMO      128
#define XB_XCNT(j)  (256  + 64 * (j))
#define XB_XSUB(j)  (1280 + 64 * (j))
#define XB_XGEN(j)  (2304 + 64 * (j))
#define XB_TOP      3328
#define XB_TOPGEN   3392
#define XCD_BAR_WORDS 3456
#define XB_SPIN_CAP (1u << 18)
__device__ __forceinline__ unsigned xb_ld(unsigned* p)              { return __hip_atomic_load(p, __ATOMIC_RELAXED, __HIP_MEMORY_SCOPE_AGENT); }
__device__ __forceinline__ unsigned xb_add(unsigned* p, unsigned v) { return __hip_atomic_fetch_add(p, v, __ATOMIC_RELAXED, __HIP_MEMORY_SCOPE_AGENT); }
__device__ __forceinline__ unsigned xb_xcc_id() { return (unsigned)__builtin_amdgcn_s_getreg((3 << 11) | 20) & 0xFu; }
#define XB_SPIN(cond, bar) do { unsigned _sp = 0; while (cond) { __builtin_amdgcn_s_sleep(1); \
    if ((++_sp & 255u) == 0u) { if (xb_ld(&(bar)[XB_TMO])) break; if (_sp > XB_SPIN_CAP) { atomicAdd(&(bar)[XB_TMO], 1u); break; } } } } while (0)
struct XcdBarrier { unsigned* bar; unsigned x; volatile LAS unsigned* st; };
__device__ __forceinline__ XcdBarrier xcd_barrier_post(unsigned* bar, volatile LAS unsigned* st) {
    XcdBarrier b; b.bar = bar; b.x = xb_xcc_id(); b.st = st;
    if (threadIdx.x == 0) (void)xb_add(&bar[XB_XCNT(b.x)], 1u);
    return b;
}
__device__ __forceinline__ void xcd_barrier_complete(unsigned* bar, unsigned x, unsigned& nloc, unsigned& nx) {
    const unsigned G = gridDim.x * gridDim.y * gridDim.z;
    unsigned sum, cnt, mine, sp = 0u;
    for (;;) {
        sum = 0u; cnt = 0u; mine = 0u;
#pragma unroll
        for (unsigned j = 0; j < 16; ++j) { const unsigned c = xb_ld(&bar[XB_XCNT(j)]); sum += c; cnt += (c > 0u) ? 1u : 0u; mine = (j == x) ? c : mine; }
        if (sum == G) break;
        __builtin_amdgcn_s_sleep(1);
        if ((++sp & 255u) == 0u) { if (xb_ld(&bar[XB_TMO])) break; if (sp > XB_SPIN_CAP) { atomicAdd(&bar[XB_TMO], 1u); break; } }
    }
    nloc = mine > 0u ? mine : 1u; nx = cnt > 0u ? cnt : 1u;
}
typedef __attribute__((address_space(1))) unsigned gu32_t;
__device__ __forceinline__ void xcd_barrier_body(const XcdBarrier& b) {
    asm volatile("s_waitcnt vmcnt(0)" ::: "memory");
    __syncthreads();
    if (opaque_tid() == 0) {
        size_t z_ = 0; asm volatile("" : "+s"(z_));
        unsigned* bar = b.bar + z_; unsigned bxx = b.x; asm volatile("" : "+s"(bxx));
        __builtin_amdgcn_s_waitcnt(0);
        unsigned nloc = b.st[0], nx = b.st[1];
        if (nloc == 0u) { xcd_barrier_complete(bar, bxx, nloc, nx); b.st[0] = nloc; b.st[1] = nx; }
        const unsigned old = xb_add(&bar[XB_XSUB(bxx)], 1u);
        const unsigned gen = old / nloc;
        if (old + 1u == (gen + 1u) * nloc) {
            __builtin_amdgcn_fence(__ATOMIC_RELEASE, "agent");
            asm volatile("s_waitcnt vmcnt(0)" ::: "memory");
            const unsigned og = xb_add(&bar[XB_TOP], 1u);
            const unsigned tg = og / nx;
            if (og + 1u == (tg + 1u) * nx) xb_add(&bar[XB_TOPGEN], 1u);
            else XB_SPIN(xb_ld(&bar[XB_TOPGEN]) == tg, bar);
            __builtin_amdgcn_fence(__ATOMIC_ACQUIRE, "agent");
            xb_add(&bar[XB_XGEN(bxx)], 1u);
            asm volatile("s_waitcnt vmcnt(0)" ::: "memory");
        } else {
            XB_SPIN(xb_ld(&bar[XB_XGEN(bxx)]) == gen, bar);
            __builtin_amdgcn_fence(__ATOMIC_ACQUIRE, "agent");
            asm volatile("s_waitcnt vmcnt(0)" ::: "memory");
        }
    }
    __syncthreads();
}

__device__ __forceinline__ void xcd_barrier(gu32_t* barg, unsigned x, unsigned st_off) {
    XcdBarrier b; b.bar = (unsigned*)barg; b.x = x; b.st = (volatile LAS unsigned*)(uintptr_t)st_off;
    xcd_barrier_body(b);
}

namespace pg8 {
constexpr int BM = 256, BK = 64, HALF = 128, HTB = HALF * BK * 2, STAGE_BYTES = 8 * HTB, NXCD = 8, WGM = 8;
__device__ __forceinline__ int lds_byte(int r, int c) { const int st = (r >> 4) * 2 + (c >> 5), rr = r & 15, cc = c & 31, ob = rr * 64 + cc * 2; return st * 1024 + (ob ^ (((ob >> 9) & 1) << 5)); }
__device__ __forceinline__ void stage_rc(int b, int& R, int& C) { const int st = b / 1024, sb = b % 1024, swz = sb ^ (((sb >> 9) & 1) << 5); R = (st >> 1) * 16 + swz / 64; C = (st & 1) * 32 + (swz % 64) / 2; }
__device__ __forceinline__ int perm16(int R) { return (R >> 5) * 64 + ((R >> 2) & 3) * 16 + ((R >> 4) & 1) * 4 + (R & 3); }
__device__ __forceinline__ int perm32(int rho) { const int n = rho >> 4, i = rho & 15; return 8 * (i >> 2) + 4 * n + (i & 3); }
struct Unit { int pm, pn, pb, e, j, half; };

struct DenseOrder {
    int nM, nN, nwg, G, c;
    __device__ __forceinline__ void init(int M, int N, int G_, int c_) { nM = M / BM; nN = N / BM; nwg = nM * nN; G = G_; c = c_; }
    __device__ __forceinline__ bool next(int i, Unit& u) const {
        const long L = (long)i * G + c; if (L >= nwg) return false;
        int wgid = (int)L; { const int q = nwg / NXCD, r = nwg % NXCD, xcd = wgid % NXCD, off = wgid / NXCD; wgid = (xcd < r ? xcd * (q + 1) : r * (q + 1) + (xcd - r) * q) + off; }
        const int nig = WGM * nN, gid = wgid / nig, fm = gid * WGM, gsz = (nM - fm) < WGM ? (nM - fm) : WGM;
        u.pm = fm + ((wgid % nig) % gsz); u.pn = (wgid % nig) / gsz; u.pb = u.pn; u.e = 0; u.j = 0; u.half = 0; return true;
    }
    __device__ __forceinline__ int arow(const Unit& u, int r) const { return u.pm * BM + r; }
    __device__ __forceinline__ void arow4(const Unit& u, const int (&r)[4], int (&o)[4]) const { for (int q = 0; q < 4; ++q) o[q] = u.pm * BM + r[q]; }
    __device__ __forceinline__ void arow4_issue(const Unit&, const int (&)[4], int (&)[4]) const {}
    __device__ __forceinline__ int arow4_fin(const Unit& u, int r, int) const { return u.pm * BM + r; }
};

template <class Epi, class Sched, bool FP8 = false>
__device__ __forceinline__ void gemm_phase(LAS unsigned char* lds, const bf16_t* Ag, int lda, const bf16_t* Btg, int K, const Sched& S, const Epi& E) {
    const int tid = opaque_tid(), wid = __builtin_amdgcn_readfirstlane(tid >> 6), lane = tid & 63, wr = wid >> 2, wc = wid & 3, fr = lane & 15, fq = lane >> 4;
    const int nt = K / BK;
    unsigned voffB[2];
#pragma unroll
    for (int i = 0; i < 2; ++i) { int R, C; stage_rc(tid * 16 + i * 8192, R, C); const int Rb = (int)Epi::PERM == 2 ? perm16(R) : Epi::PERM ? ((R & ~31) + perm32(R & 31)) : R; voffB[i] = (unsigned)(Rb * K + C) * 2u; }
    const size_t kstep = (size_t)(BK * 2);
    const size_t tstep = (size_t)2 * HALF * K * 2;
    const size_t hstep = (size_t)((int)Epi::PERM == 2 ? 8 : HALF) * K * 2;
    const unsigned ldsw = (unsigned)wid * 1024u;
    const int aoff = lds_byte(wr * 64 + fr, fq * 8), boff = lds_byte(wc * 32 + fr, fq * 8);
#define PG8_SA(b, h) (((b) * 2 + (h)) * HTB)
#define PG8_SB(b, h) ((4 + (b) * 2 + (h)) * HTB)
#define PG8_STAGE(bufoff, gbase, voff) do { _Pragma("unroll") for (int _i = 0; _i < 2; ++_i) \
        __builtin_amdgcn_global_load_lds((const unsigned*)((const char*)(gbase) + (voff)[_i]), (LAS unsigned*)(lds + (bufoff) + ldsw + _i * 8192), 16, 0, 0); } while (0)
#define PG8_LDA(dst, b, h) do { _Pragma("unroll") for (int m = 0; m < 4; ++m) _Pragma("unroll") for (int k = 0; k < 2; ++k) dst[m][k] = *(const LAS bf16x8*)(lds + PG8_SA(b, h) + aoff + m * 2048 + k * 1024); } while (0)
#define PG8_LDB(dst, b, h) do { _Pragma("unroll") for (int n = 0; n < 2; ++n) _Pragma("unroll") for (int k = 0; k < 2; ++k) dst[n][k] = *(const LAS bf16x8*)(lds + PG8_SB(b, h) + boff + n * 2048 + k * 1024); } while (0)
#define PG8_MMA(ai, bj, At, Bt) do { __builtin_amdgcn_s_setprio(1); _Pragma("unroll") for (int m = 0; m < 4; ++m) _Pragma("unroll") for (int n = 0; n < 2; ++n) { \
        if constexpr (FP8) { const i32x4 a0_ = __builtin_bit_cast(i32x4, At[m][0]), a1_ = __builtin_bit_cast(i32x4, At[m][1]), b0_ = __builtin_bit_cast(i32x4, Bt[n][0]), b1_ = __builtin_bit_cast(i32x4, Bt[n][1]); \
            const i32x8 a8_ = __builtin_shufflevector(a0_, a1_, 0, 1, 2, 3, 4, 5, 6, 7), b8_ = __builtin_shufflevector(b0_, b1_, 0, 1, 2, 3, 4, 5, 6, 7); \
            acc[ai][bj][m][n] = __builtin_amdgcn_mfma_scale_f32_16x16x128_f8f6f4(b8_, a8_, acc[ai][bj][m][n], 0, 0, 0, sc1_, 0, sc1_); } \
        else { _Pragma("unroll") for (int k = 0; k < 2; ++k) acc[ai][bj][m][n] = __builtin_amdgcn_mfma_f32_16x16x32_bf16(Bt[n][k], At[m][k], acc[ai][bj][m][n], 0, 0, 0); } } \
        __builtin_amdgcn_s_setprio(0); } while (0)
#define PG8_WAIT_V(n) asm volatile("s_waitcnt vmcnt(" #n ")" ::: "memory")
#define PG8_WAIT_L(n) asm volatile("s_waitcnt lgkmcnt(" #n ")" ::: "memory")
#define PG8_BAR __builtin_amdgcn_s_barrier()
#define PG8_SCHED __builtin_amdgcn_sched_barrier(0)
#define PG8_AOFF(dst, u) do { int _t = tid; asm volatile("" : "+v"(_t)); int _rw[4], _cc[4]; _Pragma("unroll") for (int _h = 0; _h < 2; ++_h) _Pragma("unroll") for (int _i = 0; _i < 2; ++_i) { int _R, _C; stage_rc(_t * 16 + _i * 8192, _R, _C); \
        _rw[_h * 2 + _i] = _h * HALF + _R; _cc[_h * 2 + _i] = _C; } \
        int _ar[4]; S.arow4(u, _rw, _ar);                                        \
        _Pragma("unroll") for (int _q = 0; _q < 4; ++_q) dst[_q >> 1][_q & 1] = (unsigned)(_ar[_q] * lda + _cc[_q]) * 2u; } while (0)
#define PG8_AOFF_ISSUE(raw, u) do { int _t = tid; asm volatile("" : "+v"(_t)); int _rw[4]; _Pragma("unroll") for (int _h = 0; _h < 2; ++_h) _Pragma("unroll") for (int _i = 0; _i < 2; ++_i) { int _R, _C; stage_rc(_t * 16 + _i * 8192, _R, _C); _rw[_h * 2 + _i] = _h * HALF + _R; } \
        S.arow4_issue(u, _rw, raw); } while (0)
#define PG8_AOFF_FIN(dst, raw, u) do { int _t = tid; asm volatile("" : "+v"(_t)); _Pragma("unroll") for (int _h = 0; _h < 2; ++_h) _Pragma("unroll") for (int _i = 0; _i < 2; ++_i) { int _R, _C; stage_rc(_t * 16 + _i * 8192, _R, _C); \
        dst[_h][_i] = (unsigned)(S.arow4_fin(u, _h * HALF + _R, raw[_h * 2 + _i]) * lda + _C) * 2u; } } while (0)
    Unit cur, nxt; int ui = 0; cur.e = 0;
    if (!S.next(0, cur)) return;
    f32x4 acc[2][2][4][2];
    int sc1_ = 0x7f7f7f7f; float z0_ = 0.f; asm volatile("" : "+v"(sc1_), "+v"(z0_));
    (void)sc1_;
#pragma unroll
    for (int a = 0; a < 2; ++a)
#pragma unroll
        for (int b = 0; b < 2; ++b)
#pragma unroll
            for (int m = 0; m < 4; ++m)
#pragma unroll
                for (int n = 0; n < 2; ++n) acc[a][b][m][n] = (f32x4){z0_, z0_, z0_, z0_};
    bf16x8 At[4][2], B0[2][2], B1[2][2];
    unsigned vA[2][2];
    PG8_AOFF(vA, cur);
    const char* cA = (const char*)Ag;
    const char* cB = (const char*)Btg + (size_t)cur.pb * tstep;
    PG8_STAGE(PG8_SB(0, 0), cB, voffB); PG8_STAGE(PG8_SB(0, 1), cB + hstep, voffB); PG8_STAGE(PG8_SA(0, 0), cA, vA[0]); PG8_STAGE(PG8_SA(0, 1), cA, vA[1]);
    if (wr == 1) PG8_BAR;
    PG8_WAIT_V(2); PG8_BAR;
    PG8_STAGE(PG8_SB(1, 0), cB + kstep, voffB); PG8_STAGE(PG8_SA(1, 0), cA + kstep, vA[0]); PG8_STAGE(PG8_SB(1, 1), cB + hstep + kstep, voffB);
    PG8_WAIT_V(6); PG8_BAR;
    for (;;) {
        nxt.e = cur.e;
        const bool has_next = S.next(ui + 1, nxt);
        const char* nB = has_next ? (const char*)Btg + (size_t)nxt.pb * tstep : cB;
        int rawn[4] = {0, 0, 0, 0}; if (has_next) PG8_AOFF_ISSUE(rawn, nxt);
#pragma unroll 1
        for (int t = 0; t < nt; t += 2) {
            const bool last = (t == nt - 2);
            const char* a1 = cA + (size_t)(t + 1) * kstep;
            const char* a2 = last ? cA : cA + (size_t)(t + 2) * kstep; const char* b2 = last ? nB : cB + (size_t)(t + 2) * kstep;
            const char* a3 = a2 + kstep; const char* b3 = b2 + kstep;
            PG8_LDB(B0, 0, 0); PG8_LDB(B1, 0, 1); PG8_SCHED; PG8_LDA(At, 0, 0); PG8_STAGE(PG8_SA(1, 1), a1, vA[1]);
            if (last && has_next) { PG8_AOFF_FIN(vA, rawn, nxt); }
            PG8_WAIT_V(8); PG8_WAIT_L(0); PG8_BAR; PG8_MMA(0, 0, At, B0); PG8_MMA(0, 1, At, B1); PG8_BAR; PG8_SCHED;
            PG8_LDA(At, 0, 1); PG8_STAGE(PG8_SB(0, 0), b2, voffB); PG8_STAGE(PG8_SB(0, 1), b2 + hstep, voffB); PG8_STAGE(PG8_SA(0, 0), a2, vA[0]);
            PG8_WAIT_V(8); PG8_WAIT_L(0); PG8_BAR; PG8_MMA(1, 0, At, B0); PG8_MMA(1, 1, At, B1); PG8_BAR; PG8_SCHED;
            PG8_LDB(B0, 1, 0); PG8_LDB(B1, 1, 1); PG8_SCHED; PG8_LDA(At, 1, 0); PG8_STAGE(PG8_SA(0, 1), a2, vA[1]);
            PG8_WAIT_V(8); PG8_WAIT_L(0); PG8_BAR; PG8_MMA(0, 0, At, B0); PG8_MMA(0, 1, At, B1); PG8_BAR; PG8_SCHED;
            PG8_LDA(At, 1, 1); PG8_STAGE(PG8_SB(1, 0), b3, voffB); PG8_STAGE(PG8_SB(1, 1), b3 + hstep, voffB); PG8_STAGE(PG8_SA(1, 0), a3, vA[0]);
            PG8_WAIT_V(8); PG8_WAIT_L(0); PG8_BAR; PG8_MMA(1, 0, At, B0); PG8_MMA(1, 1, At, B1); PG8_BAR; PG8_SCHED;
        }
        if (wr == 0) PG8_BAR;
        { const int l_ = opaque_tid() & 63; E(acc, cur, wr, wc, l_ & 15, l_ >> 4); }
        if (!has_next) break;
#pragma unroll
        for (int a = 0; a < 2; ++a)
#pragma unroll
            for (int b = 0; b < 2; ++b)
#pragma unroll
                for (int m = 0; m < 4; ++m)
#pragma unroll
                    for (int n = 0; n < 2; ++n) acc[a][b][m][n] = (f32x4){z0_, z0_, z0_, z0_};
        cur = nxt; cB = nB; ++ui;
        if (wr == 1) PG8_BAR;
    }
    PG8_WAIT_V(0);
    PG8_BAR;
#undef PG8_SA
#undef PG8_SB
#undef PG8_STAGE
#undef PG8_LDA
#undef PG8_LDB
#undef PG8_MMA
#undef PG8_WAIT_V
#undef PG8_WAIT_L
#undef PG8_BAR
#undef PG8_SCHED
#undef PG8_AOFF
#undef PG8_AOFF_ISSUE
#undef PG8_AOFF_FIN
}
}
namespace pg8 {
#define ST16(base, boff, v) (*(u32x4*)((char*)(base) + (boff)) = (v))
#define PACK8(v0, v1) ({ u32x4 w_; w_.x = cvtpk((v0)[0], (v0)[1]); w_.y = cvtpk((v0)[2], (v0)[3]); w_.z = cvtpk((v1)[0], (v1)[1]); w_.w = cvtpk((v1)[2], (v1)[3]); w_; })
struct EpiBf16 {
    static constexpr bool PERM = true;
    bf16_t* O; int ldc; float sc;
    __device__ __forceinline__ void operator()(const f32x4 (&acc)[2][2][4][2], const Unit& u, int wr, int wc, int fr, int fq) const {
        const unsigned o0 = (unsigned)((u.pm * BM + wr * 64 + fr) * ldc + u.pn * BM + wc * 32 + 8 * fq) * 2u;
#pragma unroll
        for (int ai = 0; ai < 2; ++ai)
#pragma unroll
            for (int m = 0; m < 4; ++m) { const unsigned ro = o0 + (unsigned)((ai * HALF + m * 16) * ldc) * 2u;
#pragma unroll
                for (int bj = 0; bj < 2; ++bj) ST16(O, ro + bj * HALF * 2, PACK8(acc[ai][bj][m][0] * sc, acc[ai][bj][m][1] * sc)); }
    }
};
struct EpiQ {
    static constexpr bool PERM = true;
    bf16_t* QM; const float* rope;
    __device__ __forceinline__ void operator()(const f32x4 (&acc)[2][2][4][2], const Unit& u, int wr, int wc, int fr, int fq) const {
        const int row0 = u.pm * BM + wr * 64 + fr;
        if (u.pn < 2) {
            const unsigned o0 = (unsigned)(row0 * 768 + 2 * u.pn * 192 + wc * 32 + 8 * fq) * 2u;
#pragma unroll
            for (int ai = 0; ai < 2; ++ai)
#pragma unroll
                for (int m = 0; m < 4; ++m) { const unsigned ro = o0 + (unsigned)((ai * HALF + m * 16) * 768) * 2u;
#pragma unroll
                    for (int bj = 0; bj < 2; ++bj) ST16(QM, ro + bj * 192 * 2, PACK8(acc[ai][bj][m][0], acc[ai][bj][m][1])); }
        } else {
            const int g8 = 4 * (wc & 1) + fq;
            const unsigned o0 = (unsigned)(row0 * 768 + (wc >> 1) * 192 + 128 + 4 * g8) * 2u;
#pragma unroll
            for (int ai = 0; ai < 2; ++ai) {
                f32x4 csa[4], csb[4];
#pragma unroll
                for (int m = 0; m < 4; ++m) { const int t_ = (row0 + ai * HALF + m * 16) % NTOK; const unsigned co_ = (unsigned)(t_ * 32 + 4 * g8) * 8u;
                    csa[m] = *(const f32x4*)((const char*)rope + co_); csb[m] = *(const f32x4*)((const char*)rope + co_ + 16); }
                asm volatile("" ::: "memory");
#pragma unroll
                for (int m = 0; m < 4; ++m) {
                    const f32x4 cs0 = csa[m], cs1 = csb[m];
                    const float c[4] = {cs0[0], cs0[2], cs1[0], cs1[2]}, s[4] = {cs0[1], cs0[3], cs1[1], cs1[3]};
                    const unsigned ro = o0 + (unsigned)((ai * HALF + m * 16) * 768) * 2u;
#pragma unroll
                    for (int bj = 0; bj < 2; ++bj) { const f32x4 x1 = acc[ai][bj][m][0], x2 = acc[ai][bj][m][1];
                        float o1[4], o2[4];
#pragma unroll
                        for (int i = 0; i < 4; ++i) { o1[i] = x1[i] * c[i] - x2[i] * s[i]; o2[i] = x1[i] * s[i] + x2[i] * c[i]; }
                        u32x2 w1, w2; w1.x = cvtpk(o1[0], o1[1]); w1.y = cvtpk(o1[2], o1[3]); w2.x = cvtpk(o2[0], o2[1]); w2.y = cvtpk(o2[2], o2[3]);
                        *(u32x2*)((char*)QM + ro + bj * 2 * 192 * 2) = w1; *(u32x2*)((char*)QM + ro + bj * 2 * 192 * 2 + 64) = w2; }
                    asm volatile("" ::: "memory"); }
            }
        }
    }
};
struct EpiKV {
    static constexpr bool PERM = true;
    bf16_t* KN; bf16_t* VM;
    __device__ __forceinline__ void operator()(const f32x4 (&acc)[2][2][4][2], const Unit& u, int wr, int wc, int fr, int fq) const {
        const unsigned o0 = (unsigned)((u.pm * BM + wr * 64 + fr) * 512 + u.pn * 128 + wc * 32 + 8 * fq) * 2u;
#pragma unroll
        for (int ai = 0; ai < 2; ++ai)
#pragma unroll
            for (int m = 0; m < 4; ++m) { const unsigned ro = o0 + (unsigned)((ai * HALF + m * 16) * 512) * 2u;
                ST16(KN, ro, PACK8(acc[ai][0][m][0], acc[ai][0][m][1])); ST16(VM, ro, PACK8(acc[ai][1][m][0], acc[ai][1][m][1])); }
    }
};
struct EpiOut {
    static constexpr bool PERM = false;
    const bf16_t* HB; bf16_t* Y; float* STAT;
    __device__ __forceinline__ void operator()(const f32x4 (&acc)[2][2][4][2], const Unit& u, int wr, int wc, int fr, int fq) const {
        const int row0 = u.pm * BM + wr * 64 + fr, col0 = u.pn * BM + wc * 32 + 4 * fq;
#pragma unroll
        for (int ai = 0; ai < 2; ++ai) {
            u32x2 hres[4][2][2];
#pragma unroll
            for (int m = 0; m < 4; ++m) { const unsigned off = (unsigned)((row0 + ai * HALF + m * 16) * DM + col0) * 4u;
#pragma unroll
                for (int bj = 0; bj < 2; ++bj)
#pragma unroll
                    for (int n = 0; n < 2; ++n) hres[m][bj][n] = *(const u32x2*)((const char*)HB + ((off + (bj * HALF + n * 16) * 4) >> 1)); }
            asm volatile("" ::: "memory");
#pragma unroll
            for (int m = 0; m < 4; ++m) { const int row = row0 + ai * HALF + m * 16; float s = 0.f, q = 0.f;
                const unsigned yb = (unsigned)((((row >> 5) * 128 + (col0 >> 4)) * 32 + (row & 31)) * 16 + (col0 & 15)) * 2u;
#pragma unroll
                for (int bj = 0; bj < 2; ++bj)
#pragma unroll
                    for (int n = 0; n < 2; ++n) { const u32x2 hw = hres[m][bj][n]; const f32x4 hv = {bflo(hw.x), bfhi(hw.x), bflo(hw.y), bfhi(hw.y)}; const f32x4 y = acc[ai][bj][m][n] * (1.0f / (FP8_WSCALE * OM_SCALE)) + hv * DN_ALPHA;
                        { u32x2 yw; yw.x = cvtpk(y[0], y[1]); yw.y = cvtpk(y[2], y[3]); *(u32x2*)((char*)Y + yb + (unsigned)(((bj * HALF + n * 16) >> 4) * 32 * 16) * 2u) = yw; } s += (y[0] + y[1]) + (y[2] + y[3]); q += (y[0] * y[0] + y[1] * y[1]) + (y[2] * y[2] + y[3] * y[3]); }
                s += __shfl_xor(s, 16); s += __shfl_xor(s, 32); q += __shfl_xor(q, 16); q += __shfl_xor(q, 32);
                if (fq == 0) *(f32x2*)((char*)STAT + (unsigned)(row * 32 + u.pn * 4 + wc) * 8u) = (f32x2){s, q}; }
        }
    }
};
struct EpiSwiglu {
    static constexpr bool PERM = true;
    bf16_t* ACT; const float* b_in;
    __device__ __forceinline__ void operator()(const f32x4 (&acc)[2][2][4][2], const Unit& u, int wr, int wc, int fr, int fq) const {
        const int col = u.pn * 128 + wc * 32 + 8 * fq;
        const unsigned o0 = (unsigned)((u.pm * BM + wr * 64 + fr) * DFF + col);
        const float* bg = b_in + (size_t)u.e * 1024 + col; const float* bu = bg + 512;
        const f32x4 bg0 = *(const f32x4*)bg, bg1 = *(const f32x4*)(bg + 4), bu0 = *(const f32x4*)bu, bu1 = *(const f32x4*)(bu + 4);
#pragma unroll
        for (int ai = 0; ai < 2; ++ai)
#pragma unroll
            for (int m = 0; m < 4; ++m) { float a[8];
#pragma unroll
                for (int n = 0; n < 2; ++n) { const f32x4 g4 = acc[ai][0][m][n] * (1.0f / FP8_WSCALE) + (n ? bg1 : bg0), u4 = acc[ai][1][m][n] * (1.0f / FP8_WSCALE) + (n ? bu1 : bu0);
#pragma unroll
                    for (int i = 0; i < 4; ++i) { const float g = fminf(g4[i], 7.0f), up = fminf(fmaxf(u4[i], -7.0f), 7.0f);
                        const float sg = __builtin_amdgcn_rcpf(1.0f + __builtin_amdgcn_exp2f(-1.702f * 1.4426950408889634f * g));
                        a[4 * n + i] = g * sg * (up + 1.0f); } }
                u32x2 w; w.x = cvt4_fp8(a[0], a[1], a[2], a[3]); w.y = cvt4_fp8(a[4], a[5], a[6], a[7]);
                *(u32x2*)((char*)ACT + o0 + (unsigned)((ai * HALF + m * 16) * DFF)) = w;
                asm volatile("" ::: "memory"); }
    }
};
struct EpiDown {
    static constexpr int PERM = 2;
    unsigned char* YE; const float* b_out;
    __device__ __forceinline__ void operator()(const f32x4 (&acc)[2][2][4][2], const Unit& u, int wr, int wc, int fr, int fq) const {
        const int col0 = u.pn * BM + wc * 64 + 16 * fq;
        const unsigned o0 = (unsigned)((u.pm * BM + wr * 64 + fr) * DM + col0);
        const unsigned bo = (unsigned)(u.e * DM + col0) * 4u;
        f32x4 bb[2][2];
#pragma unroll
        for (int bj = 0; bj < 2; ++bj)
#pragma unroll
            for (int n = 0; n < 2; ++n) bb[bj][n] = *(const f32x4*)((const char*)b_out + bo + (bj * 8 + n * 4) * 4);
#pragma unroll
        for (int ai = 0; ai < 2; ++ai)
#pragma unroll
            for (int m = 0; m < 4; ++m) { u32x4 w;
                { const f32x4 v = acc[ai][0][m][0] * (1.0f / FP8_WSCALE) + bb[0][0]; w.x = cvt4_fp8(v[0], v[1], v[2], v[3]); }
                { const f32x4 v = acc[ai][0][m][1] * (1.0f / FP8_WSCALE) + bb[0][1]; w.y = cvt4_fp8(v[0], v[1], v[2], v[3]); }
                { const f32x4 v = acc[ai][1][m][0] * (1.0f / FP8_WSCALE) + bb[1][0]; w.z = cvt4_fp8(v[0], v[1], v[2], v[3]); }
                { const f32x4 v = acc[ai][1][m][1] * (1.0f / FP8_WSCALE) + bb[1][1]; w.w = cvt4_fp8(v[0], v[1], v[2], v[3]); }
                *(u32x4*)(YE + o0 + (unsigned)((ai * HALF + m * 16) * DM)) = w; }
    }
};
struct MoeOrder {
    const LAS int* tstart; const unsigned* cnt; const int* rowtok; int nN, G, c; bool gather; bool runs;
    __device__ __forceinline__ bool next(int i, Unit& u) const {
        const int total = tstart[NEXP];
        const int per = (total * nN + G - 1) / G;
        const long L = runs ? (long)c * per + i : (long)i * G + c; if (L >= (long)total * nN || (runs && i >= per)) return false;
        const int mt = (int)(L / nN), pn = (int)(L % nN);
        int e = (u.e > 0 && u.e < NEXP && tstart[u.e] <= mt) ? u.e : 0;
#pragma unroll 1
        while (e + 1 < NEXP && tstart[e + 1] <= mt) ++e;
        u.pm = mt; u.pn = pn; u.e = e; u.j = mt - tstart[e]; u.pb = e * nN + pn; u.half = 0; return true;
    }
    __device__ __forceinline__ int arow(const Unit& u, int r) const {
        if (!gather) return u.pm * BM + r;
        const int p = u.j * BM + r; const int n = tstart[64 + u.e];
        const int v = rowtok[(size_t)u.e * MROWS + (p < n ? p : 0)];
        return (p < n) ? v : 0;
    }
    __device__ __forceinline__ void arow4_issue(const Unit& u, const int (&r)[4], int (&raw)[4]) const {
        if (!gather) return;
        const int n = tstart[64 + u.e];
#pragma unroll
        for (int q = 0; q < 4; ++q) { const int p = u.j * BM + r[q]; raw[q] = rowtok[(size_t)u.e * MROWS + (p < n ? p : 0)]; }
    }
    __device__ __forceinline__ int arow4_fin(const Unit& u, int r, int raw) const {
        if (!gather) return u.pm * BM + r;
        const int p = u.j * BM + r; const int n = tstart[64 + u.e]; return (p < n) ? raw : 0;
    }
    __device__ __forceinline__ void arow4(const Unit& u, const int (&r)[4], int (&o)[4]) const {
        if (!gather) { for (int q = 0; q < 4; ++q) o[q] = u.pm * BM + r[q]; return; }
        const int n = tstart[64 + u.e]; int v[4];
#pragma unroll
        for (int q = 0; q < 4; ++q) { const int p = u.j * BM + r[q]; v[q] = rowtok[(size_t)u.e * MROWS + (p < n ? p : 0)]; }
        asm volatile("" ::: "memory");
#pragma unroll
        for (int q = 0; q < 4; ++q) { const int p = u.j * BM + r[q]; o[q] = (p < n) ? v[q] : 0; }
    }
};
}
struct KArgs { const float* in[19]; float* out; unsigned char* ws; };
struct PArgs { const KArgs& k; unsigned char* ws;
    __device__ __forceinline__ const float* in(int i) const { return k.in[i]; }
    __device__ __forceinline__ float* out() const { return k.out; } };
enum { I_X = 0, I_META, I_REL, I_EVWIN, I_QNORM, I_KVNORM, I_WUQ, I_WUKV, I_EVWOUT, I_ODWIN, I_ODWOUT, I_LNG, I_LNB, I_RW, I_RB, I_EWIN, I_EBIN, I_EWOUT, I_EBOUT };

__device__ __forceinline__ int rowmap(int kind, int n) {
    switch (kind) {
    case 0: {
        if (n < 768) return n; if (n < 832) return EC_KROPE + (n - 768); if (n < 2368) return n - 64; return n; }
    case 1: {
        const int head = n / 192, d = n % 192; if (d < 128) return head * 128 + d;
        const int i = d - 128; if (i < 32) return 512 + head * 64 + 8 * (i >> 2) + (i & 3); const int i2 = i - 32; return 512 + head * 64 + 8 * (i2 >> 2) + 4 + (i2 & 3); }
    case 2: {
        if (n < 512) return 256 * (n >> 7) + (n & 127); const int j = n - 512; return 256 * (j >> 7) + 128 + (j & 127); }
    default: return n;
    }
}
__device__ __forceinline__ void ti_load(f32x4 (&v)[8], const float* W, int Nsrc, int nblk, int item, int lane) {
    const int kb = item / nblk, nb = item % nblk, k0 = 64 * kb, n0 = 32 * nb; const int nq = n0 + 4 * (lane & 7);
#pragma unroll
    for (int i = 0; i < 8; ++i) { const int kk = 8 * i + (lane >> 3); v[i] = (nq < Nsrc) ? *(const f32x4*)(W + (size_t)(k0 + kk) * Nsrc + nq) : (f32x4){0.f, 0.f, 0.f, 0.f}; }
}
__device__ __forceinline__ void ti_finish(const f32x4 (&v)[8], int K, int nblk, bf16_t* WT, int kind, LAS float* scr, int item, int lane) {
    const int kb = item / nblk, nb = item % nblk, k0 = 64 * kb, n0 = 32 * nb;
#pragma unroll
    for (int i = 0; i < 8; ++i) { const int kk = 8 * i + (lane >> 3); LAS float* d = scr + kk * 33 + 4 * (lane & 7); d[0] = v[i][0]; d[1] = v[i][1]; d[2] = v[i][2]; d[3] = v[i][3]; }
    LDS_WAIT(); asm volatile("" ::: "memory");
    const int c = lane & 7;
#pragma unroll
    for (int j = 0; j < 4; ++j) { const int n = (lane >> 3) + 8 * j; const LAS float* s = scr + (8 * c) * 33 + n;
        u32x4 o; o.x = cvtpk(s[0 * 33], s[1 * 33]); o.y = cvtpk(s[2 * 33], s[3 * 33]); o.z = cvtpk(s[4 * 33], s[5 * 33]); o.w = cvtpk(s[6 * 33], s[7 * 33]);
        *(u32x4*)(WT + (size_t)rowmap(kind, n0 + n) * K + k0 + 8 * c) = o; }
    LDS_WAIT(); asm volatile("" ::: "memory");
}
__device__ __forceinline__ void ti_finish8(const f32x4 (&v)[8], int K, int nblk, unsigned char* WT8, int kind, LAS float* scr, int item, int lane) {
    const int kb = item / nblk, nb = item % nblk, k0 = 64 * kb, n0 = 32 * nb;
#pragma unroll
    for (int i = 0; i < 8; ++i) { const int kk = 8 * i + (lane >> 3); LAS float* d = scr + kk * 33 + 4 * (lane & 7); d[0] = v[i][0]; d[1] = v[i][1]; d[2] = v[i][2]; d[3] = v[i][3]; }
    LDS_WAIT(); asm volatile("" ::: "memory");
    const int c = lane & 7;
#pragma unroll
    for (int j = 0; j < 4; ++j) { const int n = (lane >> 3) + 8 * j; const LAS float* s = scr + (8 * c) * 33 + n;
        u32x2 o; o.x = cvt4_fp8(s[0 * 33] * FP8_WSCALE, s[1 * 33] * FP8_WSCALE, s[2 * 33] * FP8_WSCALE, s[3 * 33] * FP8_WSCALE);
        o.y = cvt4_fp8(s[4 * 33] * FP8_WSCALE, s[5 * 33] * FP8_WSCALE, s[6 * 33] * FP8_WSCALE, s[7 * 33] * FP8_WSCALE);
        *(u32x2*)(WT8 + (size_t)rowmap(kind, n0 + n) * K + k0 + 8 * c) = o; }
    LDS_WAIT(); asm volatile("" ::: "memory");
}
__device__ __forceinline__ void transpose_item8(const float* W, int K, int Nsrc, int nblk, unsigned char* WT8, int kind, LAS float* scr, int item, int lane) {
    f32x4 v[8]; ti_load(v, W, Nsrc, nblk, item, lane); ti_finish8(v, K, nblk, WT8, kind, scr, item, lane);
}
__device__ __forceinline__ void transpose_item(const float* W, int K, int Nsrc, int nblk, bf16_t* WT, int kind, LAS float* scr, int item, int lane) {
    f32x4 v[8]; ti_load(v, W, Nsrc, nblk, item, lane); ti_finish(v, K, nblk, WT, kind, scr, item, lane);
}
__device__ __forceinline__ void phase_prologue(const PArgs& a, LAS unsigned char* lds, int vcu, int G) {
    const int tid = opaque_tid(), lane = tid & 63, wave = __builtin_amdgcn_readfirstlane(tid >> 6);
    LAS float* scr = (LAS float*)(lds + wave * 16384);
    const int gw = vcu * 8 + wave, NGW = G * 8;
    unsigned char* ws = a.ws;
    constexpr int I_EVIN = (DM / 64) * (EVP / 32), I_UQ = (512 / 64) * (768 / 32), I_UKV = (256 / 64) * (1024 / 32), I_OUT = (1024 / 64) * (DM / 32), I_ODIN = (DM / 64) * (ODP / 32);
    constexpr int I_EI = (DM / 64) * (1024 / 32), I_EO = (DFF / 64) * (DM / 32);
    constexpr int N_SMALL = 2 * (I_EVIN + I_UQ + I_UKV + I_OUT + I_ODIN + I_OUT);
    constexpr long N_ALL = (long)N_SMALL;
    for (long it = gw; it < N_ALL; it += NGW) {
        long r = it;
        if (r < N_SMALL) {
            const int j = (int)(r & 1); r >>= 1;
            if (r < I_EVIN) { transpose_item8(a.in(I_EVWIN) + (size_t)j * DM * 2368, DM, 2368, EVP / 32, ws + WS_WINE + j * SZ_WINE, 0, scr, (int)r, lane); continue; } r -= I_EVIN;
            if (r < I_UQ) { transpose_item(a.in(I_WUQ) + (size_t)j * 512 * 768, 512, 768, 768 / 32, (bf16_t*)(ws + WS_WUQ + j * SZ_WUQ), 1, scr, (int)r, lane); continue; } r -= I_UQ;
            if (r < I_UKV) { transpose_item(a.in(I_WUKV) + (size_t)j * 256 * 1024, 256, 1024, 1024 / 32, (bf16_t*)(ws + WS_WUKV + j * SZ_WUKV), 3, scr, (int)r, lane); continue; } r -= I_UKV;
            if (r < I_OUT) { transpose_item8(a.in(I_EVWOUT) + (size_t)j * 1024 * DM, 1024, DM, DM / 32, ws + WS_WOUTE + j * SZ_WOUT, 3, scr, (int)r, lane); continue; } r -= I_OUT;
            if (r < I_ODIN) { transpose_item8(a.in(I_ODWIN) + (size_t)j * DM * 1864, DM, 1864, ODP / 32, ws + WS_WINO + j * SZ_WINO, 3, scr, (int)r, lane); continue; } r -= I_ODIN;
            transpose_item8(a.in(I_ODWOUT) + (size_t)j * 1024 * DM, 1024, DM, DM / 32, ws + WS_WOUTO + j * SZ_WOUT, 3, scr, (int)r, lane); continue;
        }
    }
    {   constexpr int PER = I_EI + I_EO; constexpr long NEXI = (long)DEPTH * NEXP * PER;
#define EXP_DESC(idx, Wp, Kd, Ns, nb, Tp, kd, qi) const int le_ = (int)((idx) / PER), q_ = (int)((idx) % PER); const bool ei_ = q_ < I_EI; \
        const float* Wp = ei_ ? a.in(I_EWIN) + (size_t)le_ * DM * 1024 : a.in(I_EWOUT) + (size_t)le_ * DFF * DM; const int Kd = ei_ ? DM : DFF, Ns = ei_ ? 1024 : DM, nb = ei_ ? 1024 / 32 : DM / 32; \
        unsigned char* Tp = ei_ ? (ws + WS_WEI + (size_t)le_ * SZ_WEI) : (ws + WS_WEO + (size_t)le_ * SZ_WEO); const int kd = ei_ ? 2 : 3, qi = ei_ ? q_ : q_ - I_EI
        f32x4 va[8], vb[8];
        long it = gw;
        if (it < NEXI) { EXP_DESC(it, W0, K0, N0, B0, T0, D0, Q0); (void)K0; (void)T0; (void)D0; ti_load(va, W0, N0, B0, Q0, lane); }
        for (; it < NEXI; it += 2 * NGW) {
            const long i1 = it + NGW, i2 = it + 2 * NGW;
            if (i1 < NEXI) { EXP_DESC(i1, W1, K1, N1, B1, T1, D1, Q1); (void)K1; (void)T1; (void)D1; ti_load(vb, W1, N1, B1, Q1, lane); }
            { EXP_DESC(it, W0, K0, N0, B0, T0, D0, Q0); (void)W0; (void)N0; ti_finish8(va, K0, B0, T0, D0, scr, Q0, lane); }
            if (i2 < NEXI) { EXP_DESC(i2, W2, K2, N2, B2, T2, D2, Q2); (void)K2; (void)T2; (void)D2; ti_load(va, W2, N2, B2, Q2, lane); }
            if (i1 < NEXI) { EXP_DESC(i1, W1, K1, N1, B1, T1, D1, Q1); (void)W1; (void)N1; ti_finish8(vb, K1, B1, T1, D1, scr, Q1, lane); }
        }
#undef EXP_DESC
    }
    for (int i = gw * 64 + lane; i < DEPTH * 32 * DM; i += NGW * 64) {
        const int l = i / (32 * DM), e = (i / DM) % 32, k = i % DM;
        const float w = a.in(I_RW)[((size_t)l * DM + k) * 32 + e];
        const unsigned hi = cvtpk(w, 0.f) & 0xffffu; const float lo = w - bflo(hi);
        ((bf16_t*)(ws + WS_WRH))[i] = (bf16_t)hi; ((bf16_t*)(ws + WS_WRL))[i] = (bf16_t)(cvtpk(lo, 0.f) & 0xffffu);
    }
    for (int i = gw * 64 + lane; i < NTOK * 32; i += NGW * 64) {
        const int t = i >> 5, k = i & 31;
        const float inv = powf(10000.0f, -(float)k / 32.0f); const float ang = (float)t * inv;
        float sn, cs; sincosf(ang, &sn, &cs);
        *(f32x2*)((float*)(ws + WS_ROPE) + (size_t)i * 2) = (f32x2){cs, sn};
    }
    bf16_t* HB = (bf16_t*)(ws + WS_HB);
    for (int m = gw; m < MROWS; m += NGW) {
        const int b = m / NTOK, t = m % NTOK;
        const float* src = (t < NMETA) ? a.in(I_META) + (size_t)t * DM : a.in(I_X) + ((size_t)b * SEQ + (t - NMETA)) * DM;
        const bool zero = t >= NMETA + SEQ;
        f32x4 v8[8];
#pragma unroll
        for (int j = 0; j < 8; ++j) v8[j] = zero ? (f32x4){0.f, 0.f, 0.f, 0.f} : *(const f32x4*)(src + 4 * lane + 256 * j);
        asm volatile("" ::: "memory");
#pragma unroll
        for (int j = 0; j < 8; ++j) { const int c = 4 * lane + 256 * j; const f32x4 v = v8[j];
            u32x2 w; w.x = cvtpk(v[0], v[1]); w.y = cvtpk(v[2], v[3]); *(u32x2*)(HB + (size_t)m * DM + c) = w;
            *(unsigned*)(ws + WS_HB8 + (size_t)m * DM + c) = cvt4_fp8(v[0], v[1], v[2], v[3]); }
    }
}

__device__ __forceinline__ void phase_latent_norm(const PArgs& a, int jl, int vcu, int G) {
    const int tid = opaque_tid(), lane = tid & 63, wave = __builtin_amdgcn_readfirstlane(tid >> 6);
    const int gw = vcu * 8 + wave, NGW = G * 8;
    unsigned char* ws = a.ws;
    const bf16_t* P = (const bf16_t*)(ws + WS_P); bf16_t* QN = (bf16_t*)(ws + WS_QN); bf16_t* KVN = (bf16_t*)(ws + WS_KVN); bf16_t* KR = (bf16_t*)(ws + WS_KR);
    const float* rope = (const float*)(ws + WS_ROPE);
    const float* gq = a.in(I_QNORM) + jl * 512; const float* gkv = a.in(I_KVNORM) + jl * 256;
    f32x4 g0 = *(const f32x4*)(gq + 8 * lane), g1 = *(const f32x4*)(gq + 8 * lane + 4), gk = *(const f32x4*)(gkv + 4 * lane);
    const int lr = lane & 31;
#define LAT_LOAD(m_, qv_, kv_, x1_, x2_, cs_) do { const bf16_t* pr_ = P + (size_t)(m_) * EVP; qv_ = *(const u32x4*)(pr_ + EC_QLAT + 8 * lane); kv_ = *(const u32x2*)(pr_ + EC_KVLAT + 4 * lane); \
        x1_ = pr_[EC_KROPE + lr]; x2_ = pr_[EC_KROPE + 32 + lr]; cs_ = *(const f32x2*)(rope + ((size_t)((m_) % NTOK) * 32 + lr) * 2); } while (0)
    u32x4 qv = {0u, 0u, 0u, 0u}, qvn = qv; u32x2 kv = {0u, 0u}, kvn = kv; bf16_t x1b = 0, x2b = 0, x1n = 0, x2n = 0; f32x2 cs = {0.f, 0.f}, csn = cs;
    if (gw < MROWS) LAT_LOAD(gw, qv, kv, x1b, x2b, cs);
    for (int m = gw; m < MROWS; m += NGW) {
        const int mn = (m + NGW < MROWS) ? m + NGW : m;
        LAT_LOAD(mn, qvn, kvn, x1n, x2n, csn);
        asm volatile("" ::: "memory");
        float q[8] = {bflo(qv.x), bfhi(qv.x), bflo(qv.y), bfhi(qv.y), bflo(qv.z), bfhi(qv.z), bflo(qv.w), bfhi(qv.w)};
        float k[4] = {bflo(kv.x), bfhi(kv.x), bflo(kv.y), bfhi(kv.y)};
        float sq = 0.f, sk = 0.f;
#pragma unroll
        for (int i = 0; i < 8; ++i) sq += q[i] * q[i];
#pragma unroll
        for (int i = 0; i < 4; ++i) sk += k[i] * k[i];
        sq = wave_sum(sq); sk = wave_sum(sk);
        const float rq = 1.0f / sqrtf(sq * (1.0f / 512.0f) + RMS_EPS), rk = 1.0f / sqrtf(sk * (1.0f / 256.0f) + RMS_EPS);
        u32x4 wq; wq.x = cvtpk(q[0] * rq * g0[0], q[1] * rq * g0[1]); wq.y = cvtpk(q[2] * rq * g0[2], q[3] * rq * g0[3]);
        wq.z = cvtpk(q[4] * rq * g1[0], q[5] * rq * g1[1]); wq.w = cvtpk(q[6] * rq * g1[2], q[7] * rq * g1[3]);
        *(u32x4*)(QN + (size_t)m * 512 + 8 * lane) = wq;
        u32x2 wk; wk.x = cvtpk(k[0] * rk * gk[0], k[1] * rk * gk[1]); wk.y = cvtpk(k[2] * rk * gk[2], k[3] * rk * gk[3]);
        *(u32x2*)(KVN + (size_t)m * 256 + 4 * lane) = wk;
        if (lane < 32) {
            const float x1 = bf2f(x1b), x2 = bf2f(x2b);
            KR[(size_t)m * 64 + lane] = (bf16_t)(cvtpk(x1 * cs[0] - x2 * cs[1], 0.f) & 0xffffu);
            KR[(size_t)m * 64 + 32 + lane] = (bf16_t)(cvtpk(x1 * cs[1] + x2 * cs[0], 0.f) & 0xffffu);
        }
        qv = qvn; kv = kvn; x1b = x1n; x2b = x2n; cs = csn;
    }
#undef LAT_LOAD
}

__device__ __forceinline__ void phase_ln_route(const PArgs& a, int layer, int cslot, LAS unsigned char* lds, int vcu, int G) {
    const int tid = opaque_tid(), lane = tid & 63, wave = __builtin_amdgcn_readfirstlane(tid >> 6);
    const int r32 = lane & 31, hh = lane >> 5;
    unsigned char* ws = a.ws;
    const bf16_t* Y = (const bf16_t*)(ws + WS_Y); const float* STAT = (const float*)(ws + WS_STAT);
    bf16_t* HB = (bf16_t*)(ws + WS_HB);
    const bf16_t* WRH = (const bf16_t*)(ws + WS_WRH) + (size_t)layer * 32 * DM; const bf16_t* WRL = (const bf16_t*)(ws + WS_WRL) + (size_t)layer * 32 * DM;
    const float* g = a.in(I_LNG) + (size_t)(layer * 2 + 0) * DM; const float* bta = a.in(I_LNB) + (size_t)(layer * 2 + 0) * DM;
    const float* rb = a.in(I_RB) + layer * 32;
    unsigned* cnt = (unsigned*)(ws + WS_CTL) + CW_CNT + 2048 * cslot;
    int* TOPE = (int*)(ws + WS_TOPE); int* TOPP = (int*)(ws + WS_TOPP); float* TOPG = (float*)(ws + WS_TOPG); int* ROWTOK = (int*)(ws + WS_ROWTOK);
    LAS float* part = (LAS float*)lds;
    LAS float* tot = part + 8 * 16 * 64;
    LAS float* gbl = tot + 16 * 64 + wave * 512;
    LAS unsigned* lcnt0 = (LAS unsigned*)(tot + 16 * 64 + 8 * 512);
    float* LOGIT = (float*)(ws + WS_QN);
    LAS unsigned char* stg = lds + 57344 + wave * 7168;
    const int cbase = 256 * wave, lcol = 16 * hh;
    bf16x8 whf[16], wlf[16];
#pragma unroll
    for (int s = 0; s < 16; ++s) { const int col = cbase + 32 * (s >> 1) + lcol + 8 * (s & 1);
        whf[s] = *(const bf16x8*)(WRH + (size_t)r32 * DM + col); wlf[s] = *(const bf16x8*)(WRL + (size_t)r32 * DM + col); }
    { const f32x4 gv = *(const f32x4*)(g + cbase + 4 * lane), bv = *(const f32x4*)(bta + cbase + 4 * lane);
      *(LAS f32x4*)(gbl + 4 * lane) = gv; *(LAS f32x4*)(gbl + 256 + 4 * lane) = bv; }
    LDS_WAIT(); asm volatile("" ::: "memory");
    const int cdeal = (int)blockIdx.x;
    for (int grp = cdeal; grp < MROWS / 32; grp += G) {
        const int row = grp * 32 + r32;
        float s = 0.f, q = 0.f;
        { const f32x4* st = (const f32x4*)(STAT + (size_t)row * 64);
#pragma unroll
          for (int i = 0; i < 16; ++i) { const f32x4 v = st[i]; s += v[0] + v[2]; q += v[1] + v[3]; } }
        const float mean = s * (1.0f / DM); const float var = fmaxf(q * (1.0f / DM) - mean * mean, 0.f); const float rstd = 1.0f / sqrtf(var + LN_EPS);
        f32x16 acc;
#pragma unroll
        for (int i = 0; i < 16; ++i) acc[i] = 0.f;
        const size_t ro = (size_t)row * DM + cbase + lcol;
        u32x4 yAv[4], yBv[4];
#pragma unroll
        for (int p = 0; p < 8; ++p) {
            if ((p & 3) == 0) {
#pragma unroll
                for (int pp = 0; pp < 4; ++pp) { const bf16_t* yp = Y + ((size_t)(grp * 128 + 16 * wave + 2 * (p + pp) + hh) * 32 + r32) * 16;
                    yAv[pp] = *(const u32x4*)(yp); yBv[pp] = *(const u32x4*)(yp + 8); }
                asm volatile("" ::: "memory"); }
            const u32x4 yA = yAv[p & 3], yB = yBv[p & 3];
            const f32x4 y0 = {bflo(yA.x), bfhi(yA.x), bflo(yA.y), bfhi(yA.y)}, y1 = {bflo(yA.z), bfhi(yA.z), bflo(yA.w), bfhi(yA.w)}, y2 = {bflo(yB.x), bfhi(yB.x), bflo(yB.y), bfhi(yB.y)}, y3 = {bflo(yB.z), bfhi(yB.z), bflo(yB.w), bfhi(yB.w)};
            const LAS float* gp = gbl + 32 * p + lcol;
            const f32x4 g0 = *(const LAS f32x4*)(gp), g1 = *(const LAS f32x4*)(gp + 4), g2 = *(const LAS f32x4*)(gp + 8), g3 = *(const LAS f32x4*)(gp + 12);
            const f32x4 b0 = *(const LAS f32x4*)(gp + 256), b1 = *(const LAS f32x4*)(gp + 260), b2 = *(const LAS f32x4*)(gp + 264), b3 = *(const LAS f32x4*)(gp + 268);
            const f32x4 h0 = (y0 - mean) * rstd * g0 + b0, h1 = (y1 - mean) * rstd * g1 + b1, h2 = (y2 - mean) * rstd * g2 + b2, h3 = (y3 - mean) * rstd * g3 + b3;
            u32x4 hiA, hiB; hiA.x = cvtpk(h0[0], h0[1]); hiA.y = cvtpk(h0[2], h0[3]); hiA.z = cvtpk(h1[0], h1[1]); hiA.w = cvtpk(h1[2], h1[3]);
            hiB.x = cvtpk(h2[0], h2[1]); hiB.y = cvtpk(h2[2], h2[3]); hiB.z = cvtpk(h3[0], h3[1]); hiB.w = cvtpk(h3[2], h3[3]);
            { LAS unsigned char* sH = stg + r32 * 144 + (p & 1) * 64 + hh * 32; *(LAS u32x4*)(sH) = hiA; *(LAS u32x4*)(sH + 16) = hiB;
              u32x4 q8; q8.x = cvt4_fp8(h0[0], h0[1], h0[2], h0[3]); q8.y = cvt4_fp8(h1[0], h1[1], h1[2], h1[3]); q8.z = cvt4_fp8(h2[0], h2[1], h2[2], h2[3]); q8.w = cvt4_fp8(h3[0], h3[1], h3[2], h3[3]);
              *(LAS u32x4*)(stg + 4608 + r32 * 80 + (p & 1) * 32 + hh * 16) = q8; }
            if (p & 1) {
                LDS_WAIT(); asm volatile("" ::: "memory");
                int ln_ = lane; asm volatile("" : "+v"(ln_));
                const size_t cq = (size_t)cbase + 64 * (p >> 1);
#pragma unroll
                for (int i = 0; i < 4; ++i) { const int id = i * 64 + ln_, rw = id >> 3, c = id & 7; const u32x4 w = *(const LAS u32x4*)(stg + rw * 144 + c * 16);
                    *(u32x4*)((unsigned char*)HB + ((size_t)(grp * 32 + rw) * DM + cq) * 2 + c * 16) = w; }
#pragma unroll
                for (int i = 0; i < 2; ++i) { const int id = i * 64 + ln_, rw = id >> 2, c = id & 3; const u32x4 w = *(const LAS u32x4*)(stg + 4608 + rw * 80 + c * 16);
                    *(u32x4*)((unsigned char*)(ws + WS_HB8) + (size_t)(grp * 32 + rw) * DM + cq + c * 16) = w; }
                asm volatile("" ::: "memory");
            }
            u32x4 loA, loB; loA.x = cvtpk(h0[0] - bflo(hiA.x), h0[1] - bfhi(hiA.x)); loA.y = cvtpk(h0[2] - bflo(hiA.y), h0[3] - bfhi(hiA.y));
            loA.z = cvtpk(h1[0] - bflo(hiA.z), h1[1] - bfhi(hiA.z)); loA.w = cvtpk(h1[2] - bflo(hiA.w), h1[3] - bfhi(hiA.w));
            loB.x = cvtpk(h2[0] - bflo(hiB.x), h2[1] - bfhi(hiB.x)); loB.y = cvtpk(h2[2] - bflo(hiB.y), h2[3] - bfhi(hiB.y));
            loB.z = cvtpk(h3[0] - bflo(hiB.z), h3[1] - bfhi(hiB.z)); loB.w = cvtpk(h3[2] - bflo(hiB.w), h3[3] - bfhi(hiB.w));
            const bf16x8 hiAf = __builtin_bit_cast(bf16x8, hiA), hiBf = __builtin_bit_cast(bf16x8, hiB), loAf = __builtin_bit_cast(bf16x8, loA), loBf = __builtin_bit_cast(bf16x8, loB);
            acc = __builtin_amdgcn_mfma_f32_32x32x16_bf16(whf[2 * p], hiAf, acc, 0, 0, 0);
            acc = __builtin_amdgcn_mfma_f32_32x32x16_bf16(whf[2 * p], loAf, acc, 0, 0, 0);
            acc = __builtin_amdgcn_mfma_f32_32x32x16_bf16(wlf[2 * p], hiAf, acc, 0, 0, 0);
            acc = __builtin_amdgcn_mfma_f32_32x32x16_bf16(whf[2 * p + 1], hiBf, acc, 0, 0, 0);
            acc = __builtin_amdgcn_mfma_f32_32x32x16_bf16(whf[2 * p + 1], loBf, acc, 0, 0, 0);
            acc = __builtin_amdgcn_mfma_f32_32x32x16_bf16(wlf[2 * p + 1], hiBf, acc, 0, 0, 0);
        }
#pragma unroll
        for (int r = 0; r < 16; ++r) part[(wave * 16 + r) * 64 + lane] = acc[r];
        LDS_WAIT(); __syncthreads();
#pragma unroll
        for (int rr = 0; rr < 2; ++rr) { const int r = 2 * wave + rr; float t = 0.f;
#pragma unroll
            for (int w = 0; w < 8; ++w) t += part[(w * 16 + r) * 64 + lane];
            LOGIT[((size_t)grp * 16 + r) * 64 + lane] = t; }
        LDS_WAIT(); __syncthreads();
    }
    __syncthreads();
    LAS unsigned* lcnt = lcnt0 + wave * 64;
    for (int grp = cdeal + wave * G; grp < MROWS / 32; grp += 8 * G) {
        const int row = grp * 32 + r32;
        {
            float v[16];
#pragma unroll
            for (int r = 0; r < 16; ++r) v[r] = LOGIT[((size_t)grp * 16 + r) * 64 + lane];
            float rbv[16];
#pragma unroll
            for (int r = 0; r < 16; ++r) rbv[r] = rb[(r & 3) + 8 * (r >> 2) + 4 * hh];
            asm volatile("" ::: "memory"); SBAR();
#pragma unroll
            for (int r = 0; r < 16; ++r) v[r] += rbv[r];
            float bv[4]; int bi[4];
#pragma unroll
            for (int k = 0; k < 4; ++k) { float best = -3.0e38f; int br = 0;
#pragma unroll
                for (int r = 0; r < 16; ++r) { const bool gt = v[r] > best; best = gt ? v[r] : best; br = gt ? r : br; }
#pragma unroll
                for (int r = 0; r < 16; ++r) v[r] = (r == br) ? -3.0e38f : v[r];
                bv[k] = best; bi[k] = (br & 3) + 8 * (br >> 2) + 4 * hh; }
            float ov[4]; int oi[4];
#pragma unroll
            for (int k = 0; k < 4; ++k) { ov[k] = __shfl_xor(bv[k], 32); oi[k] = __shfl_xor(bi[k], 32); }
            float tv[4]; int ti[4]; int pa = 0, pb = 0;
#pragma unroll
            for (int k = 0; k < 4; ++k) {
                float av = bv[0], ovv = ov[0]; int ai = bi[0], oii = oi[0];
#pragma unroll
                for (int z = 1; z < 4; ++z) { av = (pa == z) ? bv[z] : av; ai = (pa == z) ? bi[z] : ai; ovv = (pb == z) ? ov[z] : ovv; oii = (pb == z) ? oi[z] : oii; }
                const bool takeA = (av > ovv) || (av == ovv && ai < oii);
                tv[k] = takeA ? av : ovv; ti[k] = takeA ? ai : oii; pa += takeA ? 1 : 0; pb += takeA ? 0 : 1; }
            if (hh == 0) {
                const float e1 = __expf(tv[1] - tv[0]), e2 = __expf(tv[2] - tv[0]), e3 = __expf(tv[3] - tv[0]); const float inv = 1.0f / (1.0f + e1 + e2 + e3);
                const float gt[4] = {inv, e1 * inv, e2 * inv, e3 * inv};
                lcnt[lane] = 0u; LDS_WAIT(); asm volatile("" ::: "memory");
                unsigned lr[4];
#pragma unroll
                for (int k = 0; k < 4; ++k) lr[k] = __hip_atomic_fetch_add(lcnt + ti[k], 1u, __ATOMIC_RELAXED, __HIP_MEMORY_SCOPE_WORKGROUP);
                LDS_WAIT(); asm volatile("" ::: "memory");
                { const unsigned n = lcnt[lane]; unsigned bs = 0u; if (n) bs = __hip_atomic_fetch_add(cnt + 64 * lane, n, __ATOMIC_RELAXED, __HIP_MEMORY_SCOPE_AGENT); lcnt[32 + lane] = bs; }
                LDS_WAIT(); asm volatile("" ::: "memory");
                int ps[4];
#pragma unroll
                for (int k = 0; k < 4; ++k) { ps[k] = (int)(lcnt[32 + ti[k]] + lr[k]); ROWTOK[(size_t)ti[k] * MROWS + ps[k]] = row; }
                *(i32x4*)(TOPE + (size_t)row * 4) = (i32x4){ti[0], ti[1], ti[2], ti[3]};
                *(i32x4*)(TOPP + (size_t)row * 4) = (i32x4){ps[0], ps[1], ps[2], ps[3]};
                *(f32x4*)(TOPG + (size_t)row * 4) = (f32x4){gt[0], gt[1], gt[2], gt[3]};
            }
        }
    }
    __syncthreads();
}

__device__ __forceinline__ void build_tile_table(const unsigned* cnt, LAS int* tstart) {
    const int tid_ = opaque_tid();
    if (tid_ < 64) {
        const int lane = tid_; const int n = (lane < NEXP) ? (int)__hip_atomic_load(cnt + 64 * lane, __ATOMIC_RELAXED, __HIP_MEMORY_SCOPE_AGENT) : 0;
        const int tiles = (n + 255) >> 8; int incl = tiles;
#pragma unroll
        for (int o = 1; o < 64; o <<= 1) { const int v = __shfl_up(incl, o); if (lane >= o) incl += v; }
        if (lane <= NEXP) tstart[lane] = incl - tiles;
        if (lane < NEXP) tstart[64 + lane] = n;
    }
    LDS_WAIT(); __syncthreads();
}

struct CombRow { f32x4 z[8]; };
template <bool last>
__device__ __forceinline__ void phase_combine_ln(const PArgs& a, int layer, const LAS int* tstart, int vcu, int G, bool dummy) {
    const int tid = opaque_tid(), lane = tid & 63, wave = __builtin_amdgcn_readfirstlane(tid >> 6);
    LAS unsigned char* lds_b = (LAS unsigned char*)tstart - TBL_OFF;
    const int gw = (int)blockIdx.x * 8 + wave, NGW = G * 8;
    unsigned char* ws = a.ws;
    const bf16_t* HBin = (const bf16_t*)(ws + WS_HB); const unsigned char* YE = (const unsigned char*)(ws + WS_YEXP);
    bf16_t* HB = dummy ? (bf16_t*)(ws + WS_P) : (bf16_t*)(ws + WS_HB);
    unsigned char* H8 = ws + WS_HB8;
    const int* TOPE = (const int*)(ws + WS_TOPE); const int* TOPP = (const int*)(ws + WS_TOPP); const float* TOPG = (const float*)(ws + WS_TOPG);
    const float* g = a.in(I_LNG) + (size_t)(layer * 2 + 1) * DM; const float* bta = a.in(I_LNB) + (size_t)(layer * 2 + 1) * DM;
    float* outp = dummy ? (float*)(ws + WS_Y) : a.out();
    LAS float* gl = (LAS float*)(lds_b);
    { const int tid_ = tid; *(LAS f32x4*)(gl + 4 * tid_) = *(const f32x4*)(g + 4 * tid_); *(LAS f32x4*)(gl + 2048 + 4 * tid_) = *(const f32x4*)(bta + 4 * tid_); }
    LDS_WAIT(); __syncthreads();
#define IDX_LOAD(te_, tp_, tg_, m) do { te_ = *(const i32x4*)(TOPE + (size_t)(m) * 4); tp_ = *(const i32x4*)(TOPP + (size_t)(m) * 4); tg_ = *(const f32x4*)(TOPG + (size_t)(m) * 4); } while (0)
#define RAW_ISSUE(m, te_, tp_) do { \
        const unsigned o0_ = (unsigned)((tstart[te_[0]] * 256 + tp_[0])) , o1_ = (unsigned)((tstart[te_[1]] * 256 + tp_[1])), o2_ = (unsigned)((tstart[te_[2]] * 256 + tp_[2])), o3_ = (unsigned)((tstart[te_[3]] * 256 + tp_[3])); \
        _Pragma("unroll") for (int j = 0; j < 8; ++j) { const int c = 4 * lane + 256 * j; hwv[j] = *(const u32x2*)(HBin + (size_t)(m) * DM + c); \
            wv[j][0] = *(const unsigned*)(YE + (size_t)o0_ * DM + c); wv[j][1] = *(const unsigned*)(YE + (size_t)o1_ * DM + c); wv[j][2] = *(const unsigned*)(YE + (size_t)o2_ * DM + c); wv[j][3] = *(const unsigned*)(YE + (size_t)o3_ * DM + c); } } while (0)
#define COMB_CONVERT(R, tg_) do { _Pragma("unroll") for (int j = 0; j < 8; ++j) { const u32x2 hw_ = hwv[j]; f32x4 v_ = (f32x4){bflo(hw_.x), bfhi(hw_.x), bflo(hw_.y), bfhi(hw_.y)} * DN_ALPHA; \
            const unsigned w0_ = wv[j][0], w1_ = wv[j][1], w2_ = wv[j][2], w3_ = wv[j][3]; \
            const f32x2 a0_ = __builtin_amdgcn_cvt_pk_f32_fp8((int)w0_, false), c0_ = __builtin_amdgcn_cvt_pk_f32_fp8((int)w0_, true), a1_ = __builtin_amdgcn_cvt_pk_f32_fp8((int)w1_, false), c1_ = __builtin_amdgcn_cvt_pk_f32_fp8((int)w1_, true); \
            const f32x2 a2_ = __builtin_amdgcn_cvt_pk_f32_fp8((int)w2_, false), c2_ = __builtin_amdgcn_cvt_pk_f32_fp8((int)w2_, true), a3_ = __builtin_amdgcn_cvt_pk_f32_fp8((int)w3_, false), c3_ = __builtin_amdgcn_cvt_pk_f32_fp8((int)w3_, true); \
            v_[0] += tg_[0] * a0_[0] + tg_[1] * a1_[0] + tg_[2] * a2_[0] + tg_[3] * a3_[0]; \
            v_[1] += tg_[0] * a0_[1] + tg_[1] * a1_[1] + tg_[2] * a2_[1] + tg_[3] * a3_[1]; \
            v_[2] += tg_[0] * c0_[0] + tg_[1] * c1_[0] + tg_[2] * c2_[0] + tg_[3] * c3_[0]; \
            v_[3] += tg_[0] * c0_[1] + tg_[1] * c1_[1] + tg_[2] * c2_[1] + tg_[3] * c3_[1]; \
            (R).z[j] = v_; } } while (0)
#define COMB_FINISH(R, m) do { float s_ = 0.f; _Pragma("unroll") for (int j = 0; j < 8; ++j) s_ += ((R).z[j][0] + (R).z[j][1]) + ((R).z[j][2] + (R).z[j][3]); \
        const float mean_ = wave_sum(s_) * (1.0f / DM); float s2_ = 0.f; \
        _Pragma("unroll") for (int j = 0; j < 8; ++j) { (R).z[j] = (R).z[j] - mean_; s2_ += ((R).z[j][0] * (R).z[j][0] + (R).z[j][1] * (R).z[j][1]) + ((R).z[j][2] * (R).z[j][2] + (R).z[j][3] * (R).z[j][3]); } \
        const float rstd_ = 1.0f / sqrtf(wave_sum(s2_) * (1.0f / DM) + LN_EPS); const int b_ = (m) / NTOK, t_ = (m) % NTOK; \
        _Pragma("unroll") for (int j = 0; j < 8; ++j) { const int c = 4 * lane + 256 * j; \
            const f32x4 o_ = (R).z[j] * rstd_ * *(const LAS f32x4*)(gl + c) + *(const LAS f32x4*)(gl + 2048 + c); \
            if (!last) { u32x2 w_; w_.x = cvtpk(o_[0], o_[1]); w_.y = cvtpk(o_[2], o_[3]); *(u32x2*)(HB + (size_t)(m) * DM + c) = w_; \
                *(unsigned*)(H8 + (size_t)(m) * DM + c) = cvt4_fp8(o_[0], o_[1], o_[2], o_[3]); } \
            else if (t_ >= NMETA && t_ < NMETA + SEQ) *(f32x4*)(outp + ((size_t)b_ * SEQ + (t_ - NMETA)) * DM + c) = o_; } } while (0)
    if (gw < MROWS) {
        i32x4 teA, tpA, teB, tpB; f32x4 tgA, tgB, tgC; u32x2 hwv[8]; unsigned wv[8][4]; CombRow r;
        IDX_LOAD(teA, tpA, tgA, gw);
        RAW_ISSUE(gw, teA, tpA); tgC = tgA;
        { const int m1 = (gw + NGW < MROWS) ? gw + NGW : gw; IDX_LOAD(teB, tpB, tgB, m1); }
        int m = gw;
#define COMB_STEP(teX, tpX, tgX, teY, tpY, tgY) do { const int m1 = (m + NGW < MROWS) ? m + NGW : m, m2 = (m + 2 * NGW < MROWS) ? m + 2 * NGW : m; \
            COMB_CONVERT(r, tgC);                              \
            RAW_ISSUE(m1, teX, tpX); tgC = tgX;                \
            IDX_LOAD(teY, tpY, tgY, m2);                       \
            asm volatile("" ::: "memory"); } while (0)
        COMB_STEP(teB, tpB, tgB, teA, tpA, tgA);
        for (;;) {
            COMB_FINISH(r, m);
            m += NGW; if (m >= MROWS) break;
            COMB_STEP(teA, tpA, tgA, teB, tpB, tgB);
            COMB_FINISH(r, m);
            m += NGW; if (m >= MROWS) break;
            COMB_STEP(teB, tpB, tgB, teA, tpA, tgA);
        }
#undef COMB_STEP
    }
#undef IDX_LOAD
#undef RAW_ISSUE
#undef COMB_CONVERT
#undef COMB_FINISH
}
namespace att {
constexpr int KVBLK = 64;
constexpr int BUF_BYTES = 40960, OFF_KN = 0, OFF_KR = 16384, OFF_V = 24576, OFF_WS = 2 * BUF_BYTES, OFF_FLAG = OFF_WS + 8 * 256;
#define KSWZ(row, colB) ((row) * 256 + ((colB) ^ (((row) & 7) << 4)))
#define KRSWZ(row, colB) ((row) * 128 + ((colB) ^ (((row) & 7) << 4)))
__device__ __forceinline__ int crow(int r, int hi) { return (r & 3) + 8 * (r >> 2) + 4 * hi; }
__device__ __forceinline__ int v_st(int k, int c) { const int kk = (k & ~0xC) | ((k & 4) << 1) | ((k & 8) >> 1); return ((kk >> 3) * 4 + (c >> 5)) * 512 + ((kk & 7) * 32 + (c & 31)) * 2; }
__device__ __forceinline__ int v_rd_base(int lane) { return ((lane & 3) << 3) | (((lane >> 2) & 3) << 6) | (((lane >> 4) & 1) << 5) | (((lane >> 5) & 1) << 8); }
constexpr int v_rd_off(int d0, int ks, int half) { return d0 * 512 + ks * 4096 + half * 2048; }
template <int OFF> __device__ __forceinline__ s16x4 tr_read(int vb) { s16x4 r; asm volatile("ds_read_b64_tr_b16 %0, %1 offset:%2" : "=&v"(r) : "v"(vb), "i"(OFF) : "memory"); return r; }
template <int D0> __device__ __forceinline__ void pv_one(f32x16& od, int vb, bf16x8 pa0, bf16x8 pa1, bf16x8 pa2, bf16x8 pa3) {
    const s16x4 l0 = tr_read<v_rd_off(D0, 0, 0)>(vb), h0 = tr_read<v_rd_off(D0, 0, 1)>(vb), l1 = tr_read<v_rd_off(D0, 1, 0)>(vb), h1 = tr_read<v_rd_off(D0, 1, 1)>(vb);
    const s16x4 l2 = tr_read<v_rd_off(D0, 2, 0)>(vb), h2 = tr_read<v_rd_off(D0, 2, 1)>(vb), l3 = tr_read<v_rd_off(D0, 3, 0)>(vb), h3 = tr_read<v_rd_off(D0, 3, 1)>(vb);
    asm volatile("s_waitcnt lgkmcnt(0)" ::: "memory"); SBAR();
#define PK(L, H) (bf16x8){L[0], L[1], L[2], L[3], H[0], H[1], H[2], H[3]}
    od = __builtin_amdgcn_mfma_f32_32x32x16_bf16(pa0, PK(l0, h0), od, 0, 0, 0);
    od = __builtin_amdgcn_mfma_f32_32x32x16_bf16(pa1, PK(l1, h1), od, 0, 0, 0);
    od = __builtin_amdgcn_mfma_f32_32x32x16_bf16(pa2, PK(l2, h2), od, 0, 0, 0);
    od = __builtin_amdgcn_mfma_f32_32x32x16_bf16(pa3, PK(l3, h3), od, 0, 0, 0);
#undef PK
}
__device__ __forceinline__ void pv_d0(f32x16* o, int vb, bf16x8 pa0, bf16x8 pa1, bf16x8 pa2, bf16x8 pa3) {
    pv_one<0>(o[0], vb, pa0, pa1, pa2, pa3); pv_one<1>(o[1], vb, pa0, pa1, pa2, pa3); pv_one<2>(o[2], vb, pa0, pa1, pa2, pa3); pv_one<3>(o[3], vb, pa0, pa1, pa2, pa3);
}
__device__ __forceinline__ void pack_p(const f32x16& p0, const f32x16& p1, bf16x8& pa0, bf16x8& pa1, bf16x8& pa2, bf16x8& pa3) {
#define PK4(P, BASE, OUT) do { unsigned a0 = cvtpk(P[BASE + 0], P[BASE + 1]), a1 = cvtpk(P[BASE + 2], P[BASE + 3]);   \
    unsigned b0 = cvtpk(P[BASE + 4], P[BASE + 5]), b1 = cvtpk(P[BASE + 6], P[BASE + 7]);                              \
    auto r0 = __builtin_amdgcn_permlane32_swap(a0, b0, false, false); auto r1 = __builtin_amdgcn_permlane32_swap(a1, b1, false, false); \
    u32x4 w = {r0[0], r1[0], r0[1], r1[1]}; OUT = __builtin_bit_cast(bf16x8, w); } while (0)
    PK4(p0, 0, pa0); PK4(p0, 8, pa1); PK4(p1, 0, pa2); PK4(p1, 8, pa3);
#undef PK4
}
__device__ __forceinline__ float xhalf_max(float v) { auto rr = __builtin_amdgcn_permlane32_swap(__float_as_uint(v), __float_as_uint(v), false, false); return fmaxf(__uint_as_float(rr[0]), __uint_as_float(rr[1])); }
__device__ __forceinline__ float xhalf_sum(float v) { auto rr = __builtin_amdgcn_permlane32_swap(__float_as_uint(v), __float_as_uint(v), false, false); return __uint_as_float(rr[0]) + __uint_as_float(rr[1]); }

template <bool MLA>
__device__ __forceinline__ void attn_unit(LAS unsigned char* lds, const bf16_t* __restrict__ Qp, int ldq, const bf16_t* __restrict__ Kn, int ldk, const bf16_t* __restrict__ Kr,
                                          const bf16_t* __restrict__ Vp, int ldv, unsigned char* __restrict__ Op, int ldo, int q0) {
    constexpr int NQ = MLA ? 12 : 8, NQR = 8;
    const int tid = opaque_tid(), wid = __builtin_amdgcn_readfirstlane(tid >> 6), lane = tid & 63, r32 = lane & 31, hi = lane >> 5;
    LAS float* wsl = (LAS float*)(lds + OFF_WS) + wid * 64; LAS float* li_l = wsl; LAS float* al_l = wsl + 32;
    volatile LAS unsigned* flags = (volatile LAS unsigned*)(lds + OFF_FLAG);
    const int t = q0 + wid * 32 + r32;
    const int tq = t < NTOK ? t : NTOK - 1;
    float m_reg = -1e30f, l_reg = 0.f, R = 0.f; f32x16 o[4];
#pragma unroll
    for (int d = 0; d < 4; ++d)
#pragma unroll
        for (int r = 0; r < 16; ++r) o[d][r] = 0.f;
    bf16x8 qr[NQR];
    const bf16_t* Qw = Qp + (size_t)tq * ldq + hi * 8;
#pragma unroll
    for (int d0 = 0; d0 < NQR; ++d0) qr[d0] = *(const bf16x8*)(Qw + d0 * 16);
    const int sr = tid >> 4, sc = (tid & 15) * 8, vst0 = v_st(sr, sc), vst1 = v_st(32 + sr, sc);
    const int krr = tid >> 3, krc = (tid & 7) * 8;
    const int vb0 = (int)(uintptr_t)(lds + OFF_V) + v_rd_base(lane);
    bf16x8 vs0, vs1, ks0, ks1, kr0;
    const unsigned offV0 = (unsigned)(sr * ldv + sc) * 2u, offV1 = (unsigned)((32 + sr) * ldv + sc) * 2u, offK0 = (unsigned)(sr * ldk + sc) * 2u, offK1 = (unsigned)((32 + sr) * ldk + sc) * 2u, offR = (unsigned)(krr * 64 + krc) * 2u;
#define SLOAD(k0) do { const char* vb_ = (const char*)(Vp + (size_t)(k0) * ldv); const char* kb_ = (const char*)(Kn + (size_t)(k0) * ldk); \
    vs0 = *(const bf16x8*)(vb_ + offV0); vs1 = *(const bf16x8*)(vb_ + offV1); ks0 = *(const bf16x8*)(kb_ + offK0); ks1 = *(const bf16x8*)(kb_ + offK1); \
    if (MLA) kr0 = *(const bf16x8*)((const char*)(Kr + (size_t)(k0) * 64) + offR); } while (0)
#define SWRITE(b) do { LAS unsigned char* bb = lds + (b) * BUF_BYTES; *(LAS bf16x8*)(bb + OFF_V + vst0) = vs0; *(LAS bf16x8*)(bb + OFF_V + vst1) = vs1; \
    *(LAS bf16x8*)(bb + OFF_KN + KSWZ(sr, sc * 2)) = ks0; *(LAS bf16x8*)(bb + OFF_KN + KSWZ(32 + sr, sc * 2)) = ks1; \
    if (MLA) *(LAS bf16x8*)(bb + OFF_KR + KRSWZ(krr, krc * 2)) = kr0; } while (0)
    int NT, jfirst, jstep;
    if (MLA) { const int emax = chunk_end(q0 + 255 < NTOK ? q0 + 255 : NTOK - 1); NT = (emax + 63) / 64; if (NT > NTOK / 64) NT = NTOK / 64; jfirst = 0; jstep = 1; }
    else { int jh = (q0 + 255) / 64; if (jh > NTOK / 64 - 1) jh = NTOK / 64 - 1; NT = jh + 1; jfirst = jh; jstep = -1; }
    const int emin = MLA ? chunk_end(q0) : 0;
    const int e_t = chunk_end(tq);
    constexpr float SC = MLA ? 0.072168783648703220f : 0.088388347648318440f;
    constexpr float C = SC * 1.4426950408889634f;
    SLOAD(jfirst * KVBLK); VM_WAIT(); SWRITE(0); LDS_WAIT(); __syncthreads();
    for (int it = 0; it < NT; ++it) {
        const int j = jfirst + it * jstep; const int cb = it & 1;
        const bool more = (it + 1 < NT);
        if (more) SLOAD((j + jstep) * KVBLK);
        SBAR();
        f32x16 p0, p1;
#pragma unroll
        for (int r = 0; r < 16; ++r) { p0[r] = 0.f; p1[r] = 0.f; }
        { const LAS unsigned char* Ks = lds + cb * BUF_BYTES + OFF_KN; const LAS unsigned char* Krs = lds + cb * BUF_BYTES + OFF_KR;
#pragma unroll
          for (int d0 = 0; d0 < NQ; ++d0) {
              bf16x8 b0, b1;
              if (d0 < 8) { const int cbb = (d0 * 16 + hi * 8) * 2; b0 = *(const LAS bf16x8*)(Ks + KSWZ(r32, cbb)); b1 = *(const LAS bf16x8*)(Ks + KSWZ(32 + r32, cbb)); }
              else { const int cbb = ((d0 - 8) * 16 + hi * 8) * 2; b0 = *(const LAS bf16x8*)(Krs + KRSWZ(r32, cbb)); b1 = *(const LAS bf16x8*)(Krs + KRSWZ(32 + r32, cbb)); }
              const bf16x8 qf = (d0 < NQR) ? qr[d0 < NQR ? d0 : 0] : *(const bf16x8*)(Qw + d0 * 16);
              p0 = __builtin_amdgcn_mfma_f32_32x32x16_bf16(b0, qf, p0, 0, 0, 0);
              p1 = __builtin_amdgcn_mfma_f32_32x32x16_bf16(b1, qf, p1, 0, 0, 0); } }
        const int kbase = j * KVBLK;
        if (MLA) {
            if (kbase + KVBLK > emin) {
#pragma unroll
                for (int r = 0; r < 16; ++r) { const int k0 = kbase + crow(r, hi); p0[r] = (k0 < e_t) ? p0[r] : -1e30f; p1[r] = (k0 + 32 < e_t) ? p1[r] : -1e30f; } }
            float pmax = p0[0];
#pragma unroll
            for (int r = 1; r < 16; ++r) pmax = fmaxf(pmax, p0[r]);
#pragma unroll
            for (int r = 0; r < 16; ++r) pmax = fmaxf(pmax, p1[r]);
            pmax = xhalf_max(pmax);
            const float mn = fmaxf(m_reg, pmax); const float alpha = __builtin_amdgcn_exp2f((m_reg - mn) * C); m_reg = mn;
            const float mnC = -mn * C; float ps = 0.f;
#pragma unroll
            for (int r = 0; r < 16; ++r) { p0[r] = __builtin_amdgcn_exp2f(fmaf(p0[r], C, mnC)); p1[r] = __builtin_amdgcn_exp2f(fmaf(p1[r], C, mnC)); ps += p0[r] + p1[r]; }
            ps = xhalf_sum(ps); l_reg = l_reg * alpha + ps;
            if (__any(alpha < 1.f)) { if (hi == 0) al_l[r32] = alpha; LDS_WAIT();
#pragma unroll
                for (int d = 0; d < 4; ++d)
#pragma unroll
                    for (int r = 0; r < 16; ++r) o[d][r] *= al_l[crow(r, hi)]; }
        } else {
#define SB_LK(zz, kk) (((kk) < t) ? -(fmaxf((zz), 0.f) + 0.6931471805599453f * __builtin_amdgcn_logf(1.0f + __builtin_amdgcn_exp2f(-fabsf(zz) * 1.4426950408889634f))) : 0.f)
#pragma unroll
            for (int r = 0; r < 16; ++r) { p0[r] *= SC; p1[r] *= SC; }
            float abv[2][4]; float run = 0.f;
#pragma unroll
            for (int tt = 1; tt >= 0; --tt)
#pragma unroll
                for (int c = 3; c >= 0; --c) {
                    float mine = 0.f;
#pragma unroll
                    for (int i = 0; i < 4; ++i) { const int r = 4 * c + i; const int kk = kbase + 32 * tt + crow(r, hi); mine += SB_LK(tt ? p1[r] : p0[r], kk); }
                    const float other = __shfl_xor(mine, 32);
                    const float g_hi1 = hi ? mine : other, g_hi0 = hi ? other : mine;
                    abv[tt][c] = hi ? run : run + g_hi1;
                    run += g_hi1 + g_hi0; }
#pragma unroll
            for (int tt = 0; tt < 2; ++tt)
#pragma unroll
                for (int c = 0; c < 4; ++c) {
                    float cum = R + abv[tt][c];
#pragma unroll
                    for (int i = 3; i >= 0; --i) { const int r = 4 * c + i; const int kk = kbase + 32 * tt + crow(r, hi);
                        const float z = tt ? p1[r] : p0[r]; cum += SB_LK(z, kk);
                        const float av = (kk < t) ? __builtin_amdgcn_exp2f((z + cum) * 1.4426950408889634f) : 0.f;
                        if (tt) p1[r] = av; else p0[r] = av; } }
#undef SB_LK
            R += run;
        }
        bf16x8 pa0, pa1, pa2, pa3; pack_p(p0, p1, pa0, pa1, pa2, pa3);
        SBAR();
        pv_d0(o, vb0 + cb * BUF_BYTES, pa0, pa1, pa2, pa3);
        if (!MLA) { const bool done = __all((R < -60.f) || (t >= NTOK)); if (lane == 0) flags[(it & 1) * 8 + wid] = done ? 1u : 0u; }
        if (more) { VM_WAIT(); SWRITE(cb ^ 1); }
        LDS_WAIT(); __syncthreads();
        if (!MLA) { unsigned alld = 1u;
#pragma unroll
            for (int w = 0; w < 8; ++w) alld &= flags[(it & 1) * 8 + w];
            if (alld) break; }
    }
    float rli[16];
    if (MLA) { if (hi == 0) li_l[r32] = l_reg; LDS_WAIT();
#pragma unroll
        for (int r = 0; r < 16; ++r) rli[r] = __builtin_amdgcn_rcpf(li_l[crow(r, hi)]); }
    else {
#pragma unroll
        for (int r = 0; r < 16; ++r) rli[r] = 1.f; }
#pragma unroll
    for (int r = 0; r < 16; ++r) { const int orow = q0 + wid * 32 + crow(r, hi);
        if (orow < NTOK) {
#pragma unroll
            for (int d0 = 0; d0 < 4; ++d0) Op[(size_t)orow * ldo + d0 * 32 + r32] = om_fp8(o[d0][r] * rli[r]); } }
    __syncthreads();
#undef SLOAD
#undef SWRITE
}
#undef KSWZ
#undef KRSWZ

__device__ __forceinline__ void phase_attention(const PArgs& a, LAS unsigned char* lds, int layer) {
    unsigned char* ws = a.ws;
    unsigned* qctr = (unsigned*)(ws + WS_CTL) + CW_Q + 64 * layer;
    const bf16_t* P = (const bf16_t*)(ws + WS_P); const bf16_t* QM = (const bf16_t*)(ws + WS_QM); const bf16_t* KN = (const bf16_t*)(ws + WS_KN);
    const bf16_t* KR = (const bf16_t*)(ws + WS_KR); const bf16_t* VM = (const bf16_t*)(ws + WS_VM); unsigned char* OM = ws + WS_OM;
    volatile LAS unsigned* slot = (volatile LAS unsigned*)(lds + OFF_FLAG + 128);
    constexpr int NQB = 33, NU = 16 * NQB;
    for (;;) {
        if (opaque_tid() == 0) slot[0] = __hip_atomic_fetch_add(qctr, 1u, __ATOMIC_RELAXED, __HIP_MEMORY_SCOPE_AGENT);
        LDS_WAIT(); __syncthreads();
        const unsigned u = slot[0];
        __syncthreads();
        if (u >= 2u * NU) break;
        if (u < (unsigned)NU) {
            const int qb = NQB - 1 - (int)(u / 16), bh = (int)(u % 16), b = bh >> 2, h = bh & 3; const size_t r0 = (size_t)b * NTOK;
            attn_unit<true>(lds, QM + r0 * 768 + h * 192, 768, KN + r0 * 512 + h * 128, 512, KR + r0 * 64, VM + r0 * 512 + h * 128, 512, OM + r0 * 1024 + h * 128, 1024, qb * 256);
        } else {
            const int v = (int)u - NU; const int qb = NQB - 1 - v / 16, bh = v % 16, b = bh >> 2, h = bh & 3; const size_t r0 = (size_t)b * NTOK;
            attn_unit<false>(lds, P + r0 * EVP + EC_SBQ + h * 128, EVP, P + r0 * EVP + EC_SBK + h * 128, EVP, nullptr, P + r0 * EVP + EC_SBV + h * 128, EVP, OM + r0 * 1024 + 512 + h * 128, 1024, qb * 256);
        }
    }
}
}
namespace idx {
__device__ __forceinline__ int crow(int r, int hi) { return (r & 3) + 8 * (r >> 2) + 4 * hi; }
constexpr int KCH = 256;
constexpr int NCH = (NTOK + KCH - 1) / KCH;
constexpr int NITEMS = 17284;
constexpr int NQG = MROWS / 32;

constexpr int SPITCH = 136;
__device__ __forceinline__ unsigned short score_key(float f) { unsigned h; asm volatile("v_cvt_f16_f32 %0, %1" : "=v"(h) : "v"(f)); const int m = ((int)(h << 16)) >> 31; return (unsigned short)(h ^ ((unsigned)m | 0x8000u)); }
__device__ __forceinline__ void phase_indexer(const PArgs& a, LAS unsigned char* lds, int vcu, int G) {
    const int tid = opaque_tid(), lane = tid & 63, wave = __builtin_amdgcn_readfirstlane(tid >> 6), r32 = lane & 31, hh = lane >> 5;
    const int gw = vcu * 8 + wave, NGW = G * 8;
    unsigned char* ws = a.ws;
    const bf16_t* P = (const bf16_t*)(ws + WS_P); unsigned short* SCO = (unsigned short*)(ws + WS_BIG);
    LAS float* wtab = (LAS float*)(lds + wave * 16384);
    LAS unsigned char* stg = lds + wave * 16384 + 1024;
    const int lo = (int)((long)gw * NITEMS / NGW), hi = (int)((long)(gw + 1) * NITEMS / NGW);
    int b = lo / 4321, g = 0, ck = lo % 4321;
#pragma unroll 1
    for (;;) { const int ng_ = (g + 2) / 8 + 1; if (ck < ng_) break; ck -= ng_; ++g; }
    for (int item = lo; item < hi; ) {
        const int nchunk = (g + 2) / 8 + 1; const int take = (hi - item < nchunk - ck) ? hi - item : nchunk - ck;
        const int t0 = g * 32;
        const int lmax = chunk_end(t0 + 31) < NTOK ? chunk_end(t0 + 31) : NTOK;
        const int k0 = ck * KCH;
        const int kend = (k0 + take * KCH < lmax) ? k0 + take * KCH : lmax; const int ntile = (kend - k0 + 31) / 32;
        item += take; ck += take;
        const int b_cur = b, g_done = (ck == nchunk);
        if (g_done) { ck = 0; ++g; if (g == 257) { g = 0; ++b; } }
        const size_t qrow = (size_t)b_cur * NTOK + t0 + r32;
        bf16x8 qa[8][4];
#pragma unroll
        for (int h = 0; h < 8; ++h)
#pragma unroll
            for (int s = 0; s < 4; ++s) qa[h][s] = *(const bf16x8*)(P + qrow * ODP + OC_IQ + h * 64 + s * 16 + hh * 8);
        if (hh == 0) { const u32x4 wv = *(const u32x4*)(P + qrow * ODP + OC_IW);
            const float w8[8] = {bflo(wv.x), bfhi(wv.x), bflo(wv.y), bfhi(wv.y), bflo(wv.z), bfhi(wv.z), bflo(wv.w), bfhi(wv.w)};
#pragma unroll
            for (int h = 0; h < 8; ++h) wtab[h * 32 + r32] = w8[h] * 0.044194173824159216f; }
        LDS_WAIT(); asm volatile("" ::: "memory");
        bf16x8 kb[4], kn[4];
        { const size_t krow = (size_t)b_cur * NTOK + k0 + r32;
#pragma unroll
          for (int s = 0; s < 4; ++s) kb[s] = *(const bf16x8*)(P + krow * ODP + OC_IK + s * 16 + hh * 8); }
        for (int tl = 0; tl < ntile; ++tl) {
            asm volatile("" ::: "memory");
            const int key0 = k0 + 32 * tl;
            { const int kx = (tl + 1 < ntile) ? key0 + 32 : key0; const size_t krow = (size_t)b_cur * NTOK + kx + r32;
#pragma unroll
              for (int s = 0; s < 4; ++s) kn[s] = *(const bf16x8*)(P + krow * ODP + OC_IK + s * 16 + hh * 8); }
            float sc[16];
#pragma unroll
            for (int r = 0; r < 16; ++r) sc[r] = 0.f;
#pragma unroll
            for (int h = 0; h < 8; h += 2) {
                f32x16 xa, xb;
#pragma unroll
                for (int r = 0; r < 16; ++r) { xa[r] = 0.f; xb[r] = 0.f; }
#pragma unroll
                for (int s = 0; s < 4; ++s) { xa = __builtin_amdgcn_mfma_f32_32x32x16_bf16(qa[h][s], kb[s], xa, 0, 0, 0);
                    xb = __builtin_amdgcn_mfma_f32_32x32x16_bf16(qa[h + 1][s], kb[s], xb, 0, 0, 0); SBAR(); }
#pragma unroll
                for (int c = 0; c < 4; ++c) { const f32x4 wa4 = *(const LAS f32x4*)(wtab + h * 32 + 8 * c + 4 * hh), wb4 = *(const LAS f32x4*)(wtab + (h + 1) * 32 + 8 * c + 4 * hh);
#pragma unroll
                    for (int i = 0; i < 4; i += 2) {
                        const int a0 = __float_as_int(xa[4 * c + i]), a1 = __float_as_int(xa[4 * c + i + 1]), b0 = __float_as_int(xb[4 * c + i]), b1 = __float_as_int(xb[4 * c + i + 1]);
                        const f32x2 ra = {__int_as_float(a0 > 0 ? a0 : 0), __int_as_float(a1 > 0 ? a1 : 0)}, rb = {__int_as_float(b0 > 0 ? b0 : 0), __int_as_float(b1 > 0 ? b1 : 0)};
                        const f32x2 wa = {wa4[i], wa4[i + 1]}, wb = {wb4[i], wb4[i + 1]}; f32x2 s2 = {sc[4 * c + i], sc[4 * c + i + 1]};
                        s2 = __builtin_elementwise_fma(wa, ra, s2); s2 = __builtin_elementwise_fma(wb, rb, s2); sc[4 * c + i] = s2[0]; sc[4 * c + i + 1] = s2[1]; } }
            }
            { int cb2 = ((tl & 3) * 32 + r32 + 4 * hh * SPITCH) * 2; asm volatile("" : "+v"(cb2));
#pragma unroll
              for (int r = 0; r < 16; ++r) *(LAS unsigned short*)(stg + cb2 + ((r & 3) + 8 * (r >> 2)) * SPITCH * 2) = score_key(sc[r]); }
            if ((tl & 3) == 3 || tl == ntile - 1) {
                const int ncol = 32 * ((tl & 3) + 1);
                char* gbase = (char*)(SCO + ((size_t)b_cur * NTOK + t0) * NTOK + k0 + 128 * (tl >> 2));
                LDS_WAIT(); asm volatile("" ::: "memory");
                int ln = lane; asm volatile("" : "+v"(ln));
                const int c8 = 8 * (ln & 15); const unsigned goff = (unsigned)((ln >> 4) * NTOK + c8) * 2u; const int soff = ((ln >> 4) * SPITCH + c8) * 2;
                if (c8 < ncol) {
#pragma unroll 1
                    for (int i = 0; i < 8; ++i) { const u32x4 pv = *(const LAS u32x4*)(stg + soff + i * 4 * SPITCH * 2); *(u32x4*)(gbase + goff + (size_t)i * 4 * NTOK * 2) = pv; }
                }
                asm volatile("" ::: "memory");
            }
#pragma unroll
            for (int s = 0; s < 4; ++s) kb[s] = kn[s];
        }
        LDS_WAIT(); asm volatile("" ::: "memory");
    }
}

__device__ __forceinline__ int t5_bucket(int rel) {
    const int base = rel > 0 ? 16 : 0; const int n = rel < 0 ? -rel : rel;
    if (n < 8) return base + n;
    int large = 8 + (31 - __builtin_clz((unsigned)(n * n))) - 6; large = large < 15 ? large : 15;
    return base + large;
}
__device__ __forceinline__ unsigned ord_key(float f) { const unsigned u = __float_as_uint(f); return (u & 0x80000000u) ? ~u : (u | 0x80000000u); }

constexpr int VPITCH = 272;
template <int OFF> __device__ __forceinline__ s16x4 tr_read_i(int vb) { s16x4 r; asm volatile("ds_read_b64_tr_b16 %0, %1 offset:%2" : "=&v"(r) : "v"(vb), "i"(OFF) : "memory"); return r; }
__device__ __forceinline__ void pv_chunk(f32x4 (&oc)[8], int vb, bf16x8 pa) {
    s16x4 lo[8], hi[8];
#define PV_RD(d) lo[d] = tr_read_i<(d) * 32>(vb); hi[d] = tr_read_i<(d) * 32 + 16 * VPITCH>(vb)
    PV_RD(0); PV_RD(1); PV_RD(2); PV_RD(3); PV_RD(4); PV_RD(5); PV_RD(6); PV_RD(7);
#undef PV_RD
    asm volatile("s_waitcnt lgkmcnt(0)" ::: "memory"); SBAR();
#pragma unroll
    for (int d = 0; d < 8; ++d) { const bf16x8 vf = {lo[d][0], lo[d][1], lo[d][2], lo[d][3], hi[d][0], hi[d][1], hi[d][2], hi[d][3]};
        oc[d] = __builtin_amdgcn_mfma_f32_16x16x32_bf16(pa, vf, oc[d], 0, 0, 0); }
}
__device__ __forceinline__ void phase_select_attend(const PArgs& a, LAS unsigned char* lds, int vcu, int G) {
    const int tid = opaque_tid(), lane = tid & 63, wave = __builtin_amdgcn_readfirstlane(tid >> 6);
    const int gw = vcu * 8 + wave, NGW = G * 8;
    unsigned char* ws = a.ws;
    const bf16_t* P = (const bf16_t*)(ws + WS_P); const unsigned short* SCO = (const unsigned short*)(ws + WS_BIG); unsigned char* OM = ws + WS_OM;
    LAS unsigned char* wl = lds + wave * 16384;
    LAS unsigned* hist = (LAS unsigned*)wl;
    LAS unsigned long long* cand = (LAS unsigned long long*)wl;
    LAS unsigned* hist2 = (LAS unsigned*)(wl + 8704);
    LAS unsigned long long* cand2 = (LAS unsigned long long*)(wl + 9728);
    LAS int* bkt = (LAS int*)(wl + 13312);
    LAS float* btab = (LAS float*)(wl + 14336);
    LAS int* sel = (LAS int*)(wl + 15360);
    constexpr int CAP = 1024, CAP2 = 448;
    const unsigned long long lt_mask = (1ull << lane) - 1ull;
    const int hn = lane & 15, g4 = lane >> 4;
    const int vwr = (int)(uintptr_t)wl + (g4 * VPITCH + hn * 16);
    const int vrd = (int)(uintptr_t)wl + ((4 * g4 + (hn >> 2)) * VPITCH + (hn & 3) * 8);
    { const f32x4 tv = *(const f32x4*)(a.in(I_REL) + 4 * lane); *(LAS f32x4*)(btab + 4 * lane) = tv; }
    LDS_WAIT(); asm volatile("" ::: "memory");
#define APPEND(flag, list, count, value) do { const unsigned long long b_ = __ballot(flag); if (flag) (list)[(count) + (int)__builtin_popcountll(b_ & lt_mask)] = (value); (count) += (int)__builtin_popcountll(b_); } while (0)
#define RANK_TAKE(lst, n, nd) do { _Pragma("unroll 1") for (int j0_ = 0; j0_ < (n); j0_ += 64) { const int j_ = j0_ + lane; const bool act_ = j_ < (n); \
        const unsigned long long kj_ = act_ ? (lst)[j_] : 0ull; int rank_ = 0; \
        _Pragma("unroll 4") for (int k_ = 0; k_ < (n); ++k_) rank_ += ((lst)[k_] > kj_) ? 1 : 0; \
        const bool take_ = act_ && rank_ < (nd); APPEND(take_, sel, base, (int)(0xFFFFFFFFu - (unsigned)kj_)); } } while (0)
    const bool paired = (G % 8 == 0); const int cpx = paired ? G / 8 : 1;
    const int nwl = paired ? 16 * cpx : NGW; const int wl0 = paired ? ((vcu / cpx) & 1) * 8 * cpx + (vcu % cpx) * 8 + wave : gw;
    const int qend = paired ? NTOK : MROWS;
    for (int qq = wl0; qq < qend; qq += nwl) {
        const int qi = paired ? (vcu / (2 * cpx)) * NTOK + qq : qq;
        const int b = qi / NTOK, t = qi % NTOK; const size_t row = (size_t)b * NTOK + t;
        if (t >= NMETA + SEQ) {
            *(u32x4*)(OM + row * 1024 + 16 * lane) = (u32x4){0u, 0u, 0u, 0u}; continue; }
        const int L = chunk_end(t) < NTOK ? chunk_end(t) : NTOK;
        const bf16_t* Pb = P + (size_t)b * NTOK * ODP;
        int nsel;
        if (L <= 256) {
            nsel = L;
#pragma unroll
            for (int i = 0; i < 4; ++i) sel[64 * i + lane] = 64 * i + lane;
        } else {
            nsel = 256;
            const unsigned short* srow = SCO + row * NTOK;
            unsigned zz = 0u; asm volatile("" : "+v"(zz));
            int sh = 16; unsigned pfx = 0u; int need = 256; unsigned cbin = 0u;
#define CHUNK_LOAD(dst, c0_) do { int l8_ = 8 * lane; asm volatile("" : "+v"(l8_)); _Pragma("unroll") for (int k = 0; k < 8; ++k) { const int idx_ = (c0_) + 512 * k + l8_; dst[k] = __builtin_nontemporal_load((const u32x4*)(srow + (idx_ < L ? idx_ : 0))); } } while (0)
#define KEY16(w, c) (((c) & 1) ? ((w)[(c) >> 1] >> 16) : ((w)[(c) >> 1] & 0xffffu))
#pragma unroll 1
            for (;;) {
                const int nb = sh >= 11 ? 11 : sh; const int nsh = sh - nb; const unsigned dmask = (1u << nb) - 1u; const bool first = (sh == 16); const unsigned pv0 = first ? 0u : (pfx >> sh);
#pragma unroll 1
                for (int i = 0; i < 8; ++i) *(LAS u32x4*)(wl + i * 1024 + lane * 16) = (u32x4){zz, zz, zz, zz};
                u32x4 v[8];
                LDS_WAIT(); asm volatile("" ::: "memory");
#pragma unroll 1
                for (int c0 = 0; c0 < L; c0 += 4096) {
                    CHUNK_LOAD(v, c0); asm volatile("" ::: "memory"); SBAR();
                    int l8 = 8 * lane; asm volatile("" : "+v"(l8));
#pragma unroll
                    for (int k = 0; k < 8; ++k) { const bool ok = (c0 + 512 * k + l8) < L;
#pragma unroll
                        for (int c = 0; c < 8; ++c) { const unsigned u = KEY16(v[k], c); const bool match = ok && (first || ((u >> sh) == pv0));
                            if (match) __hip_atomic_fetch_add(hist + ((u >> nsh) & dmask), 1u, __ATOMIC_RELAXED, __HIP_MEMORY_SCOPE_WORKGROUP); } }
                }
                LDS_WAIT(); asm volatile("" ::: "memory");
                unsigned loc = 0u;
#pragma unroll
                for (int i = 0; i < 8; ++i) { const u32x4 h4 = *(const LAS u32x4*)(hist + 32 * lane + 4 * i); loc += (h4.x + h4.y) + (h4.z + h4.w); }
                unsigned above = loc;
#pragma unroll
                for (int o = 1; o < 64; o <<= 1) { const unsigned vv = __shfl_down(above, o); if (lane + o < 64) above += vv; }
                const unsigned excl = above - loc;
                const bool mine = (excl < (unsigned)need) && ((unsigned)need <= above);
                const unsigned long long bal = __ballot(mine);
                const int owner = (int)__builtin_ctzll(bal ? bal : 1ull);
                unsigned run = excl; int bsel = 0; unsigned abv = excl, cb = 0u; bool found = false;
#pragma unroll 1
                for (int i = 7; i >= 0; --i) { const u32x4 h4 = *(const LAS u32x4*)(hist + 32 * lane + 4 * i); const unsigned hv[4] = {h4.x, h4.y, h4.z, h4.w};
#pragma unroll
                    for (int k = 3; k >= 0; --k) { const unsigned nr = run + hv[k]; const bool hit = !found && (nr >= (unsigned)need); bsel = hit ? 4 * i + k : bsel; abv = hit ? run : abv; cb = hit ? hv[k] : cb; found = found || hit; run = nr; } }
                const unsigned bin = (unsigned)__shfl(32 * lane + bsel, owner); const unsigned abv_b = (unsigned)__shfl((int)abv, owner); cbin = (unsigned)__shfl((int)cb, owner);
                pfx |= bin << nsh; need -= (int)abv_b; sh = nsh;
                if (cbin <= (unsigned)CAP || sh == 0) break;
            }
            const bool alleq = (sh == 0) && (cbin > (unsigned)CAP);
            const unsigned pv = pfx >> sh;
            int base = 0, ccount = 0;
            if (!alleq) {
                { u32x4 v[8];
#pragma unroll 1
                for (int c0 = 0; c0 < L; c0 += 4096) {
                    CHUNK_LOAD(v, c0); asm volatile("" ::: "memory"); SBAR();
                    int l8 = 8 * lane; asm volatile("" : "+v"(l8));
#pragma unroll
                    for (int k = 0; k < 8; ++k) { const int idx = c0 + 512 * k + l8; const bool ok = idx < L;
#pragma unroll
                        for (int c = 0; c < 8; ++c) { const unsigned u = KEY16(v[k], c); const unsigned hi = u >> sh;
                            const bool sure = ok && hi > pv, isc = ok && hi == pv;
                            const unsigned long long bt = __ballot(sure), bc = __ballot(isc);
                            if (bt | bc) {
                                if (sure) sel[base + (int)__builtin_popcountll(bt & lt_mask)] = idx + c;
                                if (isc) cand[ccount + (int)__builtin_popcountll(bc & lt_mask)] = ((unsigned long long)u << 32) | (unsigned long long)(0xFFFFFFFFu - (unsigned)(idx + c));
                                base += (int)__builtin_popcountll(bt); ccount += (int)__builtin_popcountll(bc); } } }
                } }
                LDS_WAIT(); asm volatile("" ::: "memory");
                bool done = false;
                if (sh >= 8 && ccount > 64) {
                    *(LAS u32x4*)(hist2 + 4 * lane) = (u32x4){zz, zz, zz, zz};
                    LDS_WAIT(); asm volatile("" ::: "memory");
                    const int s2 = 32 + sh - 8;
#pragma unroll 1
                    for (int j0 = 0; j0 < ccount; j0 += 64) { const int j = j0 + lane; if (j < ccount) __hip_atomic_fetch_add(hist2 + (unsigned)((cand[j] >> s2) & 255ull), 1u, __ATOMIC_RELAXED, __HIP_MEMORY_SCOPE_WORKGROUP); }
                    LDS_WAIT(); asm volatile("" ::: "memory");
                    const u32x4 h4 = *(const LAS u32x4*)(hist2 + 4 * lane); const unsigned loc2 = (h4.x + h4.y) + (h4.z + h4.w);
                    unsigned ab2 = loc2;
#pragma unroll
                    for (int o = 1; o < 64; o <<= 1) { const unsigned vv = __shfl_down(ab2, o); if (lane + o < 64) ab2 += vv; }
                    const unsigned ex2 = ab2 - loc2; const bool mine2 = (ex2 < (unsigned)need) && ((unsigned)need <= ab2);
                    const unsigned long long bal2 = __ballot(mine2); const int own2 = (int)__builtin_ctzll(bal2 ? bal2 : 1ull);
                    unsigned run2 = ex2; int bs2 = 0; unsigned av2 = ex2, cb2 = 0u; bool f2 = false; const unsigned hv2[4] = {h4.x, h4.y, h4.z, h4.w};
#pragma unroll
                    for (int k = 3; k >= 0; --k) { const unsigned nr = run2 + hv2[k]; const bool hit = !f2 && (nr >= (unsigned)need); bs2 = hit ? k : bs2; av2 = hit ? run2 : av2; cb2 = hit ? hv2[k] : cb2; f2 = f2 || hit; run2 = nr; }
                    const unsigned bin2 = (unsigned)__shfl(4 * lane + bs2, own2); const unsigned abv2 = (unsigned)__shfl((int)av2, own2); const unsigned cnt2 = (unsigned)__shfl((int)cb2, own2);
                    if (cnt2 <= (unsigned)CAP2) {
                        int c2 = 0;
#pragma unroll 1
                        for (int j0 = 0; j0 < ccount; j0 += 64) { const int j = j0 + lane; const bool act = j < ccount; const unsigned long long kj = act ? cand[j] : 0ull;
                            const unsigned sub = (unsigned)((kj >> s2) & 255ull); const bool sure2 = act && sub > bin2, isc2 = act && sub == bin2;
                            APPEND(sure2, sel, base, (int)(0xFFFFFFFFu - (unsigned)kj));
                            APPEND(isc2, cand2, c2, kj); }
                        LDS_WAIT(); asm volatile("" ::: "memory");
                        const int need2 = need - (int)abv2;
                        RANK_TAKE(cand2, c2, need2);
                        done = true;
                    }
                }
                if (!done) RANK_TAKE(cand, ccount, need);
            } else {
#pragma unroll 2
                for (int i0 = 0; i0 < L; i0 += 64) { const int s = i0 + lane; const bool valid = s < L;
                    const unsigned u = valid ? (unsigned)srow[s < L ? s : L - 1] : 0u;
                    const bool sure = valid && u > pv, isc = valid && u == pv;
                    const unsigned long long bc = __ballot(isc); const int crank = ccount + (int)__builtin_popcountll(bc & lt_mask);
                    const bool take = sure || (isc && crank < need);
                    ccount += (int)__builtin_popcountll(bc);
                    APPEND(take, sel, base, s); }
            }
#undef CHUNK_LOAD
#undef KEY16
        }
        LDS_WAIT(); asm volatile("" ::: "memory");
#pragma unroll
        for (int i = 0; i < 4; ++i) { const int jj = 64 * i + lane; bkt[jj] = t5_bucket(((jj < nsel) ? sel[jj] : t) - t) * 8; }
        bf16x8 qb[4];
#pragma unroll
        for (int kk = 0; kk < 4; ++kk) { bf16x8 z = {0, 0, 0, 0, 0, 0, 0, 0}; qb[kk] = (hn < 8) ? *(const bf16x8*)(P + row * ODP + OC_Q + hn * 128 + kk * 32 + g4 * 8) : z; }
        f32x4 sa[16];
#pragma unroll
        for (int tb = 0; tb < 4; ++tb) {
            bf16x8 ka[4][4]; int hno = hn; asm volatile("" : "+v"(hno));
#pragma unroll
            for (int u = 0; u < 4; ++u) { const int jj = 16 * (4 * tb + u) + hno; const int key = (jj < nsel) ? sel[jj] : 0; const unsigned koff = (unsigned)(key * ODP + OC_K + g4 * 8) * 2u;
#pragma unroll
                for (int kk = 0; kk < 4; ++kk) ka[u][kk] = *(const bf16x8*)((const char*)Pb + koff + kk * 64); }
            asm volatile("" ::: "memory"); SBAR();
#pragma unroll
            for (int u = 0; u < 4; ++u) { f32x4 acc = {0.f, 0.f, 0.f, 0.f};
#pragma unroll
                for (int kk = 0; kk < 4; ++kk) acc = __builtin_amdgcn_mfma_f32_16x16x32_bf16(ka[u][kk], qb[kk], acc, 0, 0, 0);
                sa[4 * tb + u] = acc; }
            asm volatile("" ::: "memory");
        }
        bf16x8 vr0[8], vr1[8];
#define V_LOAD(dst, c) do { int g4o_ = g4; asm volatile("" : "+v"(g4o_)); _Pragma("unroll") for (int i_ = 0; i_ < 8; ++i_) { const int jj_ = 32 * (c) + g4o_ + 4 * i_; const int key_ = (jj_ < nsel) ? sel[jj_] : 0; \
            dst[i_] = *(const bf16x8*)((const char*)Pb + (unsigned)(key_ * ODP + OC_V + hn * 8) * 2u); } } while (0)
#define V_WRITE(src) do { _Pragma("unroll") for (int i_ = 0; i_ < 8; ++i_) *(LAS bf16x8*)(uintptr_t)(vwr + 4 * i_ * VPITCH) = src[i_]; } while (0)
        V_LOAD(vr0, 0); V_LOAD(vr1, 1);
        float mx = -1e30f; int g4b = 4 * g4; asm volatile("" : "+v"(g4b));
#pragma unroll
        for (int tl = 0; tl < 16; ++tl) { const i32x4 b4 = *(const LAS i32x4*)(bkt + 16 * tl + 4 * g4); const int bb[4] = {b4.x, b4.y, b4.z, b4.w};
#pragma unroll
            for (int i = 0; i < 4; ++i) { const int jj = 16 * tl + g4b + i; const bool ok = jj < nsel;
                const float bias = btab[bb[i] + (hn & 7)];
                const float s = ok ? sa[tl][i] * 0.088388347648318440f + bias : -1e30f; sa[tl][i] = s; mx = fmaxf(mx, s); } }
        mx = fmaxf(mx, __shfl_xor(mx, 16)); mx = fmaxf(mx, __shfl_xor(mx, 32));
        float sum = 0.f;
#pragma unroll
        for (int tl = 0; tl < 16; ++tl)
#pragma unroll
            for (int i = 0; i < 4; ++i) { const float p = __builtin_amdgcn_exp2f((sa[tl][i] - mx) * 1.4426950408889634f); sa[tl][i] = p; sum += p; }
        sum += __shfl_xor(sum, 16); sum += __shfl_xor(sum, 32);
        const float rs = 1.0f / sum;
        f32x4 oc[8];
#pragma unroll
        for (int d = 0; d < 8; ++d) oc[d] = (f32x4){0.f, 0.f, 0.f, 0.f};
#define PV_CHUNK(c, cur) do { \
            if ((c) + 1 < 8) asm volatile("s_waitcnt vmcnt(8)" ::: "memory"); else asm volatile("s_waitcnt vmcnt(0)" ::: "memory"); \
            V_WRITE(cur); if ((c) + 2 < 8) V_LOAD(cur, (c) + 2); \
            const f32x4 pa_ = sa[2 * (c)] * rs, pb_ = sa[2 * (c) + 1] * rs; \
            u32x4 pw; pw.x = cvtpk(pa_[0], pa_[1]); pw.y = cvtpk(pa_[2], pa_[3]); pw.z = cvtpk(pb_[0], pb_[1]); pw.w = cvtpk(pb_[2], pb_[3]); \
            const bf16x8 pf = __builtin_bit_cast(bf16x8, pw); \
            LDS_WAIT(); asm volatile("" ::: "memory"); \
            pv_chunk(oc, vrd, pf); } while (0)
        PV_CHUNK(0, vr0); PV_CHUNK(1, vr1); PV_CHUNK(2, vr0); PV_CHUNK(3, vr1); PV_CHUNK(4, vr0); PV_CHUNK(5, vr1); PV_CHUNK(6, vr0); PV_CHUNK(7, vr1);
#undef PV_CHUNK
#undef V_LOAD
#undef V_WRITE
        if (g4 < 2) {
#pragma unroll
            for (int dt = 0; dt < 8; ++dt)
#pragma unroll
                for (int i = 0; i < 4; ++i) OM[row * 1024 + (4 * g4 + i) * 128 + 16 * dt + hn] = om_fp8(oc[dt][i]);
        }
        LDS_WAIT(); asm volatile("" ::: "memory");
    }
#undef APPEND
#undef RANK_TAKE
}
}
typedef __attribute__((address_space(1))) unsigned char gu8_t;
#define PH_ARGS const KArgs& ka, unsigned lds_off
#define PH_SETUP PArgs a{ka, opaque_ws(ka.ws)}; LAS unsigned char* lds = (LAS unsigned char*)(uintptr_t)lds_off; unsigned char* ws = a.ws; (void)ws; (void)lds; \
    int G_ = gridDim.x, bx_ = blockIdx.x; asm volatile("" : "+s"(G_), "+s"(bx_)); const int G = G_, bx = bx_; const int vcu = (G % 8 == 0) ? (bx % 8) * (G / 8) + bx / 8 : bx; (void)vcu

__device__ __forceinline__ void ph_prologue(PH_ARGS) { PH_SETUP; phase_prologue(a, lds, vcu, G); }
__device__ __forceinline__ void ph_inproj(PH_ARGS, int layer) { PH_SETUP;
    const int jl = layer >> 1; const bool even = (layer & 1) == 0; const int N = even ? EVP : ODP;
    const bf16_t* Bt = even ? (const bf16_t*)(ws + WS_WINE + jl * SZ_WINE) : (const bf16_t*)(ws + WS_WINO + jl * SZ_WINO);
    pg8::DenseOrder S; S.init(MROWS, N, G, bx);
    pg8::EpiBf16 E{(bf16_t*)(ws + WS_P), N, 1.0f / FP8_WSCALE};
    pg8::gemm_phase<pg8::EpiBf16, pg8::DenseOrder, true>(lds, (const bf16_t*)(ws + WS_HB8), DM / 2, Bt, DM / 2, S, E);
}
__device__ __forceinline__ void ph_latent(PH_ARGS, int jl) { PH_SETUP; phase_latent_norm(a, jl, vcu, G); }
__device__ __forceinline__ void ph_upq(PH_ARGS, int jl) { PH_SETUP;
    pg8::DenseOrder S; S.init(MROWS, 768, G, bx);
    pg8::EpiQ E{(bf16_t*)(ws + WS_QM), (const float*)(ws + WS_ROPE)};
    pg8::gemm_phase<pg8::EpiQ, pg8::DenseOrder>(lds, (const bf16_t*)(ws + WS_QN), 512, (const bf16_t*)(ws + WS_WUQ + jl * SZ_WUQ), 512, S, E);
}
__device__ __forceinline__ void ph_upkv(PH_ARGS, int jl) { PH_SETUP;
    pg8::DenseOrder S; S.init(MROWS, 1024, G, bx);
    pg8::EpiKV E{(bf16_t*)(ws + WS_KN), (bf16_t*)(ws + WS_VM)};
    pg8::gemm_phase<pg8::EpiKV, pg8::DenseOrder>(lds, (const bf16_t*)(ws + WS_KVN), 256, (const bf16_t*)(ws + WS_WUKV + jl * SZ_WUKV), 256, S, E);
}
__device__ __forceinline__ void ph_attn(PH_ARGS, int layer) { PH_SETUP; att::phase_attention(a, lds, layer); }
__device__ __forceinline__ void ph_indexer(PH_ARGS) { PH_SETUP; idx::phase_indexer(a, lds, vcu, G); }
__device__ __forceinline__ void ph_select(PH_ARGS) { PH_SETUP; idx::phase_select_attend(a, lds, vcu, G); }
__device__ __forceinline__ void ph_outproj(PH_ARGS, int layer) { PH_SETUP;
    const int jl = layer >> 1; const bool even = (layer & 1) == 0;
    const bf16_t* Bt = even ? (const bf16_t*)(ws + WS_WOUTE + jl * SZ_WOUT) : (const bf16_t*)(ws + WS_WOUTO + jl * SZ_WOUT);
    pg8::DenseOrder S; S.init(MROWS, DM, G, bx);
    pg8::EpiOut E{(const bf16_t*)(ws + WS_HB), (bf16_t*)(ws + WS_Y), (float*)(ws + WS_STAT)};
    pg8::gemm_phase<pg8::EpiOut, pg8::DenseOrder, true>(lds, (const bf16_t*)(ws + WS_OM), 1024 / 2, Bt, 1024 / 2, S, E);
}
__device__ __forceinline__ void ph_lnroute(PH_ARGS, int layer, int cslot) { PH_SETUP; phase_ln_route(a, layer, cslot, lds, vcu, G); }
__device__ __forceinline__ void ph_expert_up(PH_ARGS, int layer) { PH_SETUP;
    const unsigned* cnt = (const unsigned*)(ws + WS_CTL) + CW_CNT + 2048 * layer; LAS int* tstart = (LAS int*)(lds + TBL_OFF);
    build_tile_table(cnt, tstart);
    pg8::MoeOrder S{tstart, cnt, (const int*)(ws + WS_ROWTOK), 4, G, vcu, true, false};
    pg8::EpiSwiglu E{(bf16_t*)(ws + WS_ACT), a.in(I_EBIN) + (size_t)layer * NEXP * 1024};
    pg8::gemm_phase<pg8::EpiSwiglu, pg8::MoeOrder, true>(lds, (const bf16_t*)(ws + WS_HB8), DM / 2, (const bf16_t*)(ws + WS_WEI + (size_t)layer * NEXP * SZ_WEI), DM / 2, S, E);
}
__device__ __forceinline__ void ph_expert_down(PH_ARGS, int layer) { PH_SETUP;
    const unsigned* cnt = (const unsigned*)(ws + WS_CTL) + CW_CNT + 2048 * layer; LAS int* tstart = (LAS int*)(lds + TBL_OFF);
    pg8::MoeOrder S{tstart, cnt, (const int*)(ws + WS_ROWTOK), 8, G, vcu, false, false};
    pg8::EpiDown E{(unsigned char*)(ws + WS_YEXP), a.in(I_EBOUT) + (size_t)layer * NEXP * DM};
    pg8::gemm_phase<pg8::EpiDown, pg8::MoeOrder, true>(lds, (const bf16_t*)(ws + WS_ACT), DFF / 2, (const bf16_t*)(ws + WS_WEO + (size_t)layer * NEXP * SZ_WEO), DFF / 2, S, E);
}
__device__ __forceinline__ void ph_combine(PH_ARGS, int layer, bool dummy) { PH_SETUP;
    if (layer == DEPTH - 1) phase_combine_ln<true>(a, layer, (const LAS int*)(lds + TBL_OFF), vcu, G, dummy); else phase_combine_ln<false>(a, layer, (const LAS int*)(lds + TBL_OFF), vcu, G, dummy); }

__global__ void __launch_bounds__(512, 2) mk_fwd(KArgs a) {
    extern __shared__ __attribute__((aligned(16))) unsigned char lds_raw[];
    LAS unsigned char* lds = (LAS unsigned char*)lds_raw;
    const int tid = threadIdx.x;
    for (int u = tid; u < (LDS_BYTES - LDS_CTL) / 4; u += 512) ((LAS unsigned*)(lds + LDS_CTL))[u] = 0u;
    __syncthreads();
    const unsigned lo = (unsigned)(uintptr_t)lds;
    gu32_t* barw = (gu32_t*)(a.ws + WS_CTL) + CW_BAR; const unsigned st_off = lo + MISC_OFF + 32;
    const unsigned xcc = xcd_barrier_post((unsigned*)barw, (volatile LAS unsigned*)(uintptr_t)st_off).x;
#define GRID_BAR() xcd_barrier(barw, xcc, st_off)

    ph_prologue(a, lo);
    GRID_BAR();
#pragma unroll 1
    for (int layer = 0; layer < DEPTH; ++layer) {
        const int jl = layer >> 1; const bool even = (layer & 1) == 0;
        ph_inproj(a, lo, layer);
        GRID_BAR();
        if (even) {
            ph_latent(a, lo, jl);
            GRID_BAR();
            ph_upq(a, lo, jl);
            ph_upkv(a, lo, jl);
            GRID_BAR();
            ph_attn(a, lo, layer);
            GRID_BAR();
        } else {
            ph_indexer(a, lo);
            GRID_BAR();
            ph_select(a, lo);
            GRID_BAR();
        }
        ph_outproj(a, lo, layer);
        GRID_BAR();
        ph_lnroute(a, lo, layer, layer);
        GRID_BAR();
        ph_expert_up(a, lo, layer);
        GRID_BAR();
        ph_expert_down(a, lo, layer);
        GRID_BAR();
        ph_combine(a, lo, layer, false);
        if (layer + 1 < DEPTH) GRID_BAR();
    }
}

extern "C" void kernel_launch(void* const* d_in, const int* in_sizes, int n_in, void* d_out, int out_size, void* d_ws, size_t ws_size, hipStream_t stream) {
    static int grid = 0;
    if (grid == 0) {
        if (n_in != 19 || ws_size < WS_END) { fprintf(stderr, "kernel_launch: n_in %d (want 19), ws %zu (need %zu)\n", n_in, ws_size, (size_t)WS_END); grid = -1; return; }
        int dev = 0, cus = 0, per_cu = 0;
        if (hipGetDevice(&dev) != hipSuccess || hipDeviceGetAttribute(&cus, hipDeviceAttributeMultiprocessorCount, dev) != hipSuccess) { grid = -1; return; }
        if (hipFuncSetAttribute((const void*)mk_fwd, hipFuncAttributeMaxDynamicSharedMemorySize, LDS_BYTES) != hipSuccess) { fprintf(stderr, "kernel_launch: hipFuncSetAttribute failed\n"); grid = -1; return; }
        if (hipOccupancyMaxActiveBlocksPerMultiprocessor(&per_cu, (const void*)mk_fwd, 512, LDS_BYTES) != hipSuccess || per_cu < 1)
            fprintf(stderr, "kernel_launch: occupancy query reports %d workgroups per CU\n", per_cu);
        (void)hipGetLastError();
        grid = cus > 0 ? cus : 256;
    }
    if (grid < 0) return;
    if (hipMemsetAsync((char*)d_ws + WS_CTL, 0, CTL_BYTES, stream) != hipSuccess) return;
    KArgs a{};
    for (int i = 0; i < 19; ++i) a.in[i] = (const float*)d_in[i];
    a.out = (float*)d_out; a.ws = (unsigned char*)d_ws;
    hipLaunchKernelGGL(mk_fwd, dim3(grid), dim3(512), LDS_BYTES, stream, a);
    (void)hipPeekAtLastError();
}
```
